# Optimizing an MI355X kernel written in HIP

```python
import jax, jax.numpy as jnp
from jax import lax
import numpy as np

D_MODEL = 1024
BATCH = 16
SEQ = 2048
DEPTH = 4
DEC_BATCH = 16
DEC_SEQ = 32
PAST_LEN = 2048

CHUNK = 64
Q_BLOCK = 128
PE_DIM = 256
N_MIXERS = 3
N_RET = (DEPTH + 2) // 3
N_MLA = (DEPTH + 1) // 3
N_FOX = DEPTH // 3
EPS = 1e-6
ROPE_THETA = 10000.0
RET_HEADS = 4
RET_DK = 256
RET_DV = 512
RET_QK = RET_HEADS * RET_DK
RET_VW = RET_HEADS * RET_DV
MLA_HEADS = 16
MLA_NOPE = 128
MLA_ROPE = 64
MLA_V = 128
MLA_Q_LORA = 512
MLA_KV_LORA = 256
FOX_HEADS = 16
FOX_DH = 64
FOX_W = FOX_HEADS * FOX_DH
D_FF = ((8 * D_MODEL + 3 * 256 - 1) // (3 * 256)) * 256

kernel_name = "hybrid_retention_mla_fox_streaming_step"


def rms_norm(x, g):
    xf = x.astype(jnp.float32)
    y = xf * lax.rsqrt(jnp.mean(xf * xf, axis=-1, keepdims=True) + EPS)
    return (y * g.astype(jnp.float32)).astype(x.dtype)


def rope(x, pos):
    half = x.shape[-1] // 2
    inv = ROPE_THETA ** (-jnp.arange(half, dtype=jnp.float32) / half)
    ang = pos.astype(jnp.float32)[:, None] * inv[None, :]
    cos = jnp.cos(ang)[None, :, None, :]
    sin = jnp.sin(ang)[None, :, None, :]
    xf = x.astype(jnp.float32)
    x1, x2 = xf[..., :half], xf[..., half:]
    return jnp.concatenate([x1 * cos - x2 * sin, x2 * cos + x1 * sin], axis=-1).astype(x.dtype)


def block_attention(q, k, v, chunk_causal, q_bias=None, k_bias=None):
    b, tq, h, dk = q.shape
    tk = k.shape[1]
    off = tk - tq
    blk = min(Q_BLOCK, tq)
    scale = dk ** -0.5
    outs = []
    for q0 in range(0, tq, blk):
        last = off + q0 + blk
        kend = min(tk, -(-last // CHUNK) * CHUNK) if chunk_causal else last
        qp = off + q0 + jnp.arange(blk)
        kp = jnp.arange(kend)
        s = jnp.einsum('bqhd,bkhd->bhqk', q[:, q0:q0 + blk], k[:, :kend]).astype(jnp.float32) * scale
        if q_bias is not None:
            s = s + q_bias[:, :, q0:q0 + blk, None] - k_bias[:, :, None, :kend]
        if chunk_causal:
            allowed = (kp[None, :] // CHUNK) <= (qp[:, None] // CHUNK)
        else:
            allowed = kp[None, :] <= qp[:, None]
        s = jnp.where(allowed[None, None], s, -jnp.inf)
        pr = jax.nn.softmax(s, axis=-1).astype(v.dtype)
        outs.append(jnp.einsum('bhqk,bkhd->bqhd', pr, v[:, :kend]))
    return jnp.concatenate(outs, axis=1)


def retention_scan(q, k, v, s0):
    b, t, h, dk = q.shape
    dv = v.shape[-1]
    L = min(CHUNK, t)
    n = t // L
    lg = jnp.log1p(-jnp.exp2(-5.0 - jnp.arange(h, dtype=jnp.float32)))
    idx = jnp.arange(L, dtype=jnp.float32)
    diff = idx[:, None] - idx[None, :]
    dmask = jnp.where(diff >= 0, jnp.exp(lg[:, None, None] * jnp.maximum(diff, 0.0)), 0.0)
    q_dec = jnp.exp(lg[:, None] * (idx + 1.0))[:, :, None]
    k_dec = jnp.exp(lg[:, None] * (L - 1.0 - idx))[:, :, None]
    c_dec = jnp.exp(lg * L)[:, None, None]

    def to_chunks(a):
        return a.astype(jnp.float32).reshape(b, n, L, h, a.shape[-1]).transpose(1, 0, 3, 2, 4)

    def step(s, inp):
        qc, kc, vc = inp
        att = jnp.einsum('bhld,bhmd->bhlm', qc, kc) * dmask
        o = jnp.einsum('bhlm,bhmv->bhlv', att, vc) + jnp.einsum('bhld,bhdv->bhlv', qc * q_dec, s)
        s = s * c_dec + jnp.einsum('bhmd,bhmv->bhdv', kc * k_dec, vc)
        return s, o

    s, o = lax.scan(step, s0.astype(jnp.float32), (to_chunks(q), to_chunks(k), to_chunks(v)))
    o = o.transpose(1, 0, 3, 2, 4).reshape(b, t, h, dv)
    return o, s


def head_group_norm(o, g):
    b, t, h, d = o.shape
    mu = jnp.mean(o, axis=-1, keepdims=True)
    var = jnp.mean(jnp.square(o - mu), axis=-1, keepdims=True)
    y = (o - mu) * lax.rsqrt(var + EPS)
    return y.reshape(b, t, h * d) * g.astype(jnp.float32)


def retention_mixer(xn, pos, s0, w_in, gn, w_out):
    b, t, _ = xn.shape
    proj = xn @ w_in
    q, k, v, g = jnp.split(proj, [RET_QK, 2 * RET_QK, 2 * RET_QK + RET_VW], axis=-1)
    q = rope(q.reshape(b, t, RET_HEADS, RET_DK), pos)
    k = rope(k.reshape(b, t, RET_HEADS, RET_DK), pos) * (RET_DK ** -0.5)
    v = v.reshape(b, t, RET_HEADS, RET_DV)
    o, s = retention_scan(q, k, v, s0)
    y = head_group_norm(o, gn).astype(xn.dtype)
    return (jax.nn.silu(g) * y) @ w_out, s.astype(xn.dtype)


def mla_mixer(xn, pos, lat_past, kr_past, w_in, q_norm, kv_norm, w_qb, w_kvb, gq_nope, gq_rope, gk_nope, gk_rope, w_out):
    b, t, _ = xn.shape
    proj = xn @ w_in
    cq, ckv, kr = jnp.split(proj, [MLA_Q_LORA, MLA_Q_LORA + MLA_KV_LORA], axis=-1)
    q = (rms_norm(cq, q_norm) @ w_qb).reshape(b, t, MLA_HEADS, MLA_NOPE + MLA_ROPE)
    q_nope = rms_norm(q[..., :MLA_NOPE], gq_nope)
    q_rope = rope(rms_norm(q[..., MLA_NOPE:], gq_rope), pos)
    lat = rms_norm(ckv, kv_norm)
    kr = rope(rms_norm(kr, gk_rope)[:, :, None, :], pos)[:, :, 0, :]
    lat_all = jnp.concatenate([lat_past, lat], axis=1)
    kr_all = jnp.concatenate([kr_past, kr], axis=1)
    tk = lat_all.shape[1]
    kv = (lat_all @ w_kvb).reshape(b, tk, MLA_HEADS, MLA_NOPE + MLA_V)
    k_nope = rms_norm(kv[..., :MLA_NOPE], gk_nope)
    v = kv[..., MLA_NOPE:]
    qf = jnp.concatenate([q_nope, q_rope], axis=-1)
    kf = jnp.concatenate([k_nope, jnp.broadcast_to(kr_all[:, :, None, :], (b, tk, MLA_HEADS, MLA_ROPE))], axis=-1)
    o = block_attention(qf, kf, v, chunk_causal=True)
    return o.reshape(b, t, MLA_HEADS * MLA_V) @ w_out, lat, kr


def fox_mixer(xn, k_past, v_past, lf_past, w_in, b_f, gq, gk, w_out):
    b, t, _ = xn.shape
    proj = xn @ w_in
    q, k, v, g, fl = jnp.split(proj, [FOX_W, 2 * FOX_W, 3 * FOX_W, 4 * FOX_W], axis=-1)
    q = rms_norm(q.reshape(b, t, FOX_HEADS, FOX_DH), gq)
    k = rms_norm(k.reshape(b, t, FOX_HEADS, FOX_DH), gk)
    v = v.reshape(b, t, FOX_HEADS, FOX_DH)
    lf = jax.nn.log_sigmoid((fl + b_f).astype(jnp.float32))
    k_all = jnp.concatenate([k_past, k], axis=1)
    v_all = jnp.concatenate([v_past, v], axis=1)
    lf_all = jnp.concatenate([lf_past.astype(jnp.float32), lf], axis=1)
    F = jnp.cumsum(lf_all, axis=1).transpose(0, 2, 1)
    o = block_attention(q, k_all, v_all, chunk_causal=False, q_bias=F[:, :, F.shape[2] - t:], k_bias=F)
    return (jax.nn.sigmoid(g) * o.reshape(b, t, FOX_W)) @ w_out, k, v, lf.astype(xn.dtype)


def swiglu(xn, wg, wu, wd):
    return (jax.nn.silu(xn @ wg) * (xn @ wu)) @ wd


def trunk(x, p, past_len, ret_states, mla_lat_past, mla_kr_past, fox_k_past, fox_v_past, fox_lf_past, w):
    t = x.shape[1]
    pos = past_len + jnp.arange(t)
    h = x
    new_ret, new_lat, new_kr, new_fk, new_fv, new_flf = [], [], [], [], [], []
    for i in range(DEPTH):
        kind, j = i % N_MIXERS, i // N_MIXERS
        xn = rms_norm(h, w['norm_mix'][i])
        if kind == 0:
            y, s = retention_mixer(xn, pos, ret_states[j], w['ret_w_in'][j], w['ret_gn'][j], w['ret_w_out'][j])
            new_ret.append(s)
        elif kind == 1:
            y, lat, kr = mla_mixer(xn, pos, mla_lat_past[j], mla_kr_past[j], w['mla_w_in'][j], w['mla_q_norm'][j],
                                   w['mla_kv_norm'][j], w['mla_w_qb'][j], w['mla_w_kvb'][j], w['mla_gq_nope'][j],
                                   w['mla_gq_rope'][j], w['mla_gk_nope'][j], w['mla_gk_rope'][j], w['mla_w_out'][j])
            new_lat.append(lat)
            new_kr.append(kr)
        else:
            y, fk, fv, flf = fox_mixer(xn, fox_k_past[j], fox_v_past[j], fox_lf_past[j], w['fox_w_in'][j],
                                       w['fox_b_f'][j], w['fox_gq'][j], w['fox_gk'][j], w['fox_w_out'][j])
            new_fk.append(fk)
            new_fv.append(fv)
            new_flf.append(flf)
        h = h + y.astype(h.dtype)
        h = h + swiglu(rms_norm(h, w['norm_ffn'][i]), w['ffn_w_gate'][i], w['ffn_w_up'][i], w['ffn_w_down'][i])
        gate = jax.nn.sigmoid(rms_norm(h, w['norm_pe'][i]) @ w['pe_w_gate'][i])
        h = h + gate * (p[i] @ w['pe_w_proj'][i])
    return (rms_norm(h, w['norm_final']), jnp.stack(new_ret), jnp.stack(new_lat), jnp.stack(new_kr),
            jnp.stack(new_fk), jnp.stack(new_fv), jnp.stack(new_flf))


def setup_inputs(seed: int = 0) -> dict:
    key = jax.random.key(seed)
    ks = iter(jax.random.split(key, 64))

    def nrm(shape, scale=1.0):
        return scale * jax.random.normal(next(ks), shape, jnp.float32)

    def gain(shape):
        return 1.0 + nrm(shape, 0.05)

    def lin(shape):
        return nrm(shape, shape[-2] ** -0.5)

    return {
        'x_prompt': nrm((BATCH, SEQ, D_MODEL)),
        'x_sample': nrm((DEC_BATCH, DEC_SEQ, D_MODEL)),
        'state_ret': nrm((N_RET, DEC_BATCH, RET_HEADS, RET_DK, RET_DV), 0.5),
        'cache_mla_latent': nrm((N_MLA, DEC_BATCH, PAST_LEN, MLA_KV_LORA)),
        'cache_mla_krope': nrm((N_MLA, DEC_BATCH, PAST_LEN, MLA_ROPE)),
        'cache_fox_k': nrm((N_FOX, DEC_BATCH, PAST_LEN, FOX_HEADS, FOX_DH)),
        'cache_fox_v': nrm((N_FOX, DEC_BATCH, PAST_LEN, FOX_HEADS, FOX_DH)),
        'cache_fox_logf': jax.nn.log_sigmoid(nrm((N_FOX, DEC_BATCH, PAST_LEN, FOX_HEADS)) + 3.0),
        'p_prompt': nrm((DEPTH, BATCH, SEQ, PE_DIM)),
        'p_sample': nrm((DEPTH, DEC_BATCH, DEC_SEQ, PE_DIM)),
        'norm_mix': gain((DEPTH, D_MODEL)),
        'norm_ffn': gain((DEPTH, D_MODEL)),
        'norm_pe': gain((DEPTH, D_MODEL)),
        'norm_final': gain((D_MODEL,)),
        'ret_w_in': lin((N_RET, D_MODEL, 2 * RET_QK + 2 * RET_VW)),
        'ret_gn': gain((N_RET, RET_VW)),
        'ret_w_out': lin((N_RET, RET_VW, D_MODEL)),
        'mla_w_in': lin((N_MLA, D_MODEL, MLA_Q_LORA + MLA_KV_LORA + MLA_ROPE)),
        'mla_q_norm': gain((N_MLA, MLA_Q_LORA)),
        'mla_kv_norm': gain((N_MLA, MLA_KV_LORA)),
        'mla_w_qb': lin((N_MLA, MLA_Q_LORA, MLA_HEADS * (MLA_NOPE + MLA_ROPE))),
        'mla_w_kvb': lin((N_MLA, MLA_KV_LORA, MLA_HEADS * (MLA_NOPE + MLA_V))),
        'mla_gq_nope': gain((N_MLA, MLA_NOPE)),
        'mla_gq_rope': gain((N_MLA, MLA_ROPE)),
        'mla_gk_nope': gain((N_MLA, MLA_NOPE)),
        'mla_gk_rope': gain((N_MLA, MLA_ROPE)),
        'mla_w_out': lin((N_MLA, MLA_HEADS * MLA_V, D_MODEL)),
        'fox_w_in': lin((N_FOX, D_MODEL, 4 * FOX_W + FOX_HEADS)),
        'fox_b_f': jnp.linspace(1.0, 6.0, FOX_HEADS, dtype=jnp.float32)[None, :] + nrm((N_FOX, FOX_HEADS), 0.1),
        'fox_gq': gain((N_FOX, FOX_DH)),
        'fox_gk': gain((N_FOX, FOX_DH)),
        'fox_w_out': lin((N_FOX, FOX_W, D_MODEL)),
        'ffn_w_gate': lin((DEPTH, D_MODEL, D_FF)),
        'ffn_w_up': lin((DEPTH, D_MODEL, D_FF)),
        'ffn_w_down': lin((DEPTH, D_FF, D_MODEL)),
        'pe_w_proj': lin((DEPTH, PE_DIM, D_MODEL)),
        'pe_w_gate': lin((DEPTH, D_MODEL, D_MODEL)),
    }


def reference(x_prompt, x_sample, state_ret, cache_mla_latent, cache_mla_krope, cache_fox_k, cache_fox_v,
              cache_fox_logf, p_prompt, p_sample, norm_mix, norm_ffn, norm_pe, norm_final, ret_w_in, ret_gn,
              ret_w_out, mla_w_in, mla_q_norm, mla_kv_norm, mla_w_qb, mla_w_kvb, mla_gq_nope, mla_gq_rope,
              mla_gk_nope, mla_gk_rope, mla_w_out, fox_w_in, fox_b_f, fox_gq, fox_gk, fox_w_out, ffn_w_gate,
              ffn_w_up, ffn_w_down, pe_w_proj, pe_w_gate):
    w = dict(norm_mix=norm_mix, norm_ffn=norm_ffn, norm_pe=norm_pe, norm_final=norm_final,
             ret_w_in=ret_w_in, ret_gn=ret_gn, ret_w_out=ret_w_out,
             mla_w_in=mla_w_in, mla_q_norm=mla_q_norm, mla_kv_norm=mla_kv_norm, mla_w_qb=mla_w_qb,
             mla_w_kvb=mla_w_kvb, mla_gq_nope=mla_gq_nope, mla_gq_rope=mla_gq_rope, mla_gk_nope=mla_gk_nope,
             mla_gk_rope=mla_gk_rope, mla_w_out=mla_w_out,
             fox_w_in=fox_w_in, fox_b_f=fox_b_f, fox_gq=fox_gq, fox_gk=fox_gk, fox_w_out=fox_w_out,
             ffn_w_gate=ffn_w_gate, ffn_w_up=ffn_w_up, ffn_w_down=ffn_w_down,
             pe_w_proj=pe_w_proj, pe_w_gate=pe_w_gate)
    bp = x_prompt.shape[0]
    dt = x_prompt.dtype
    y_prompt, ret_p, lat_p, kr_p, fk_p, fv_p, flf_p = trunk(
        x_prompt, p_prompt, 0,
        jnp.zeros((N_RET, bp, RET_HEADS, RET_DK, RET_DV), dt),
        jnp.zeros((N_MLA, bp, 0, MLA_KV_LORA), dt), jnp.zeros((N_MLA, bp, 0, MLA_ROPE), dt),
        jnp.zeros((N_FOX, bp, 0, FOX_HEADS, FOX_DH), dt), jnp.zeros((N_FOX, bp, 0, FOX_HEADS, FOX_DH), dt),
        jnp.zeros((N_FOX, bp, 0, FOX_HEADS), dt), w)
    y_sample, ret_s, lat_s, kr_s, fk_s, fv_s, flf_s = trunk(
        x_sample, p_sample, cache_mla_latent.shape[2], state_ret, cache_mla_latent, cache_mla_krope,
        cache_fox_k, cache_fox_v, cache_fox_logf, w)
    return (y_prompt, y_sample, ret_p, ret_s, lat_p, kr_p, lat_s, kr_s, fk_p, fv_p, flf_p, fk_s, fv_s, flf_s)
```

```cpp
#include <hip/hip_runtime.h>
#include <hip/hip_cooperative_groups.h>
#include <cstdio>
#include <cstdint>
namespace cg = cooperative_groups;
namespace pg8 {
#define PG8_LAS __attribute__((address_space(3)))
typedef unsigned short bf16_t;
typedef short bf16x8 __attribute__((ext_vector_type(8)));
typedef float f32x4 __attribute__((ext_vector_type(4)));
typedef unsigned u32x4 __attribute__((ext_vector_type(4)));
constexpr int BM = 256, BK = 64, HALF = 128, HTB = HALF * BK * 2  , STAGE_BYTES = 8 * HTB, NXCD = 8, WGM = 8;

__host__ __device__ __forceinline__ int lds_byte(int r, int c) { const int st = (r >> 4) * 2 + (c >> 5), rr = r & 15, cc = c & 31, ob = rr * 64 + cc * 2; return st * 1024 + (ob ^ (((ob >> 9) & 1) << 5)); }
__host__ __device__ __forceinline__ void stage_rc(int b, int& R, int& C) { const int st = b / 1024, sb = b % 1024, swz = sb ^ (((sb >> 9) & 1) << 5); R = (st >> 1) * 16 + swz / 64; C = (st & 1) * 32 + (swz % 64) / 2; }
__host__ __device__ __forceinline__ int perm32(int rho) { const int n = rho >> 4, i = rho & 15; return 8 * (i >> 2) + 4 * n + (i & 3); }

struct Unit { int pm, pn; };
struct Gemm { const bf16_t* A; const bf16_t* Bt; int M, N, K; };

struct StaticOrder {
    int nM, nN, nwg, G, c;
    __host__ __device__ void init(int M, int N, int G_, int c_) { nM = M / BM; nN = N / BM; nwg = nM * nN; G = G_; c = c_; }
    __host__ __device__ bool next(int i, Unit& u) const {
        const long L = (long)i * G + c; if (L >= nwg) return false;
        int wgid = (int)L; { const int q = nwg / NXCD, r = nwg % NXCD, xcd = wgid % NXCD, off = wgid / NXCD; wgid = (xcd < r ? xcd * (q + 1) : r * (q + 1) + (xcd - r) * q) + off; }
        const int nig = WGM * nN, gid = wgid / nig, fm = gid * WGM, gsz = (nM - fm) < WGM ? (nM - fm) : WGM;
        u.pm = fm + ((wgid % nig) % gsz); u.pn = (wgid % nig) / gsz; return true;
    }
    __device__ __forceinline__ void a_ready(const Unit&) const {}
    __device__ __forceinline__ void done(const Unit&) const {}
};

typedef float f32x2 __attribute__((ext_vector_type(2)));
template <class Epi, class Sched, bool ALIGN_EPI = false, bool SP2 = false>
__device__ __forceinline__ void gemm_phase(PG8_LAS unsigned char* lds, const Gemm g, const Sched& S, const Epi& E) {
    int tid_o = threadIdx.x; asm volatile("" : "+v"(tid_o)); const int tid = tid_o, wid = __builtin_amdgcn_readfirstlane(tid >> 6), lane = tid & 63, wr = wid >> 2, wc = wid & 3, fr = lane & 15, fq = lane >> 4;
    const int K = g.K, nt = K / BK;
    unsigned voffA[2], voffB[2];
#pragma unroll
    for (int i = 0; i < 2; ++i) { int R, C; stage_rc(tid * 16 + i * 8192, R, C); const int Rb = Epi::PERM ? ((R & ~31) + perm32(R & 31)) : R;
        voffA[i] = (unsigned)(R * K + C) * 2u; voffB[i] = (unsigned)(Rb * K + C) * 2u; }
    const size_t kstep = (size_t)(BK * 2);
    const size_t hstep = (size_t)HALF * K * 2;
    const size_t tstep = 2 * hstep;
    const unsigned ldsw = (unsigned)wid * 1024u;
    const int aoff = lds_byte(wr * 64 + fr, fq * 8), boff = lds_byte(wc * 32 + fr, fq * 8);
#define PG8_SA(b, h) (((b) * 2 + (h)) * HTB)
#define PG8_SB(b, h) ((4 + (b) * 2 + (h)) * HTB)
#define PG8_STAGE(bufoff, gbase, voff) do { _Pragma("unroll") for (int _i = 0; _i < 2; ++_i) \
        __builtin_amdgcn_global_load_lds((const unsigned*)((const char*)(gbase) + (voff)[_i]), (PG8_LAS unsigned*)(lds + (bufoff) + ldsw + _i * 8192), 16, 0, 0); } while (0)
#define PG8_LDA(dst, b, h) do { _Pragma("unroll") for (int m = 0; m < 4; ++m) _Pragma("unroll") for (int k = 0; k < 2; ++k) dst[m][k] = *(const PG8_LAS bf16x8*)(lds + PG8_SA(b, h) + aoff + m * 2048 + k * 1024); } while (0)
#define PG8_LDB(dst, b, h) do { _Pragma("unroll") for (int n = 0; n < 2; ++n) _Pragma("unroll") for (int k = 0; k < 2; ++k) dst[n][k] = *(const PG8_LAS bf16x8*)(lds + PG8_SB(b, h) + boff + n * 2048 + k * 1024); } while (0)
#define PG8_MMA(ai, bj, At, Bt) do { __builtin_amdgcn_s_setprio(1); _Pragma("unroll") for (int m = 0; m < 4; ++m) _Pragma("unroll") for (int n = 0; n < 2; ++n) _Pragma("unroll") for (int k = 0; k < 2; ++k) \
        acc[ai][bj][m][n] = __builtin_amdgcn_mfma_f32_16x16x32_bf16(Bt[n][k], At[m][k], acc[ai][bj][m][n], 0, 0, 0); __builtin_amdgcn_s_setprio(0); } while (0)
#define PG8_WAIT_V(n) asm volatile("s_waitcnt vmcnt(" #n ")" ::: "memory")
#define PG8_WAIT_L(n) asm volatile("s_waitcnt lgkmcnt(" #n ")" ::: "memory")
#define PG8_BAR __builtin_amdgcn_s_barrier()
#define PG8_SCHED __builtin_amdgcn_sched_barrier(0)
    Unit cur, nxt; int ui = 0;
    if (!S.next(0, cur)) return;
    f32x4 acc[2][2][4][2];
#pragma unroll
    for (int a = 0; a < 2; ++a)
#pragma unroll
        for (int b = 0; b < 2; ++b)
#pragma unroll
            for (int m = 0; m < 4; ++m)
#pragma unroll
                for (int n = 0; n < 2; ++n) acc[a][b][m][n] = (f32x4){0.f, 0.f, 0.f, 0.f};
    bf16x8 At[4][2], B0[2][2], B1[2][2];
    const char* cA = (const char*)g.A + (size_t)cur.pm * tstep; const char* cB = (const char*)g.Bt + (size_t)cur.pn * tstep;
    S.a_ready(cur);
    if constexpr (SP2) {
        PG8_STAGE(PG8_SB(0, 0), cB, voffB); PG8_STAGE(PG8_SB(0, 1), cB + hstep, voffB); PG8_STAGE(PG8_SA(0, 0), cA, voffA); PG8_STAGE(PG8_SA(0, 1), cA + hstep, voffA);
        if (wr == 1) PG8_BAR;
        PG8_WAIT_V(2); PG8_BAR;
        PG8_STAGE(PG8_SB(1, 0), cB + kstep, voffB); PG8_STAGE(PG8_SA(1, 0), cA + kstep, voffA); PG8_STAGE(PG8_SB(1, 1), cB + hstep + kstep, voffB);
        PG8_WAIT_V(6); PG8_BAR;
    } else {
        PG8_STAGE(PG8_SB(0, 0), cB, voffB); PG8_STAGE(PG8_SA(0, 0), cA, voffA); PG8_STAGE(PG8_SB(0, 1), cB + hstep, voffB); PG8_STAGE(PG8_SA(0, 1), cA + hstep, voffA);
        if (wr == 1) PG8_BAR;
        PG8_WAIT_V(4); PG8_BAR;
        PG8_STAGE(PG8_SB(1, 0), cB + kstep, voffB); PG8_STAGE(PG8_SA(1, 0), cA + kstep, voffA); PG8_STAGE(PG8_SB(1, 1), cB + hstep + kstep, voffB);
        PG8_WAIT_V(6); PG8_BAR;
    }
    for (;;) {
        const bool has_next = S.next(ui + 1, nxt);
        const char* nA = has_next ? (const char*)g.A + (size_t)nxt.pm * tstep : cA; const char* nB = has_next ? (const char*)g.Bt + (size_t)nxt.pn * tstep : cB;
        for (int t = 0; t < nt; t += 2) {
            const bool last = (t == nt - 2);
            const char* a1 = cA + (size_t)(t + 1) * kstep;
            const char* a2 = last ? nA : cA + (size_t)(t + 2) * kstep; const char* b2 = last ? nB : cB + (size_t)(t + 2) * kstep;
            const char* a3 = a2 + kstep; const char* b3 = b2 + kstep;
            if (last && has_next) S.a_ready(nxt);
            if constexpr (SP2) {
            PG8_LDB(B0, 0, 0); PG8_LDB(B1, 0, 1); PG8_SCHED; PG8_LDA(At, 0, 0); PG8_STAGE(PG8_SA(1, 1), a1 + hstep, voffA);
            PG8_WAIT_V(8); PG8_WAIT_L(0); PG8_BAR; PG8_MMA(0, 0, At, B0); PG8_MMA(0, 1, At, B1); PG8_BAR; PG8_SCHED;
            PG8_LDA(At, 0, 1); PG8_STAGE(PG8_SB(0, 0), b2, voffB); PG8_STAGE(PG8_SB(0, 1), b2 + hstep, voffB); PG8_STAGE(PG8_SA(0, 0), a2, voffA);
            PG8_WAIT_V(8); PG8_WAIT_L(0); PG8_BAR; PG8_MMA(1, 0, At, B0); PG8_MMA(1, 1, At, B1); PG8_BAR; PG8_SCHED;
            PG8_LDB(B0, 1, 0); PG8_LDB(B1, 1, 1); PG8_SCHED; PG8_LDA(At, 1, 0); PG8_STAGE(PG8_SA(0, 1), a2 + hstep, voffA);
            PG8_WAIT_V(8); PG8_WAIT_L(0); PG8_BAR; PG8_MMA(0, 0, At, B0); PG8_MMA(0, 1, At, B1); PG8_BAR; PG8_SCHED;
            PG8_LDA(At, 1, 1); PG8_STAGE(PG8_SB(1, 0), b3, voffB); PG8_STAGE(PG8_SB(1, 1), b3 + hstep, voffB); PG8_STAGE(PG8_SA(1, 0), a3, voffA);
            PG8_WAIT_V(8); PG8_WAIT_L(0); PG8_BAR; PG8_MMA(1, 0, At, B0); PG8_MMA(1, 1, At, B1); PG8_BAR; PG8_SCHED;
            } else {
            PG8_LDB(B0, 0, 0); PG8_SCHED; PG8_LDA(At, 0, 0); PG8_STAGE(PG8_SA(1, 1), a1 + hstep, voffA);
            PG8_WAIT_L(8); PG8_BAR; PG8_WAIT_L(0); PG8_MMA(0, 0, At, B0); PG8_BAR; PG8_SCHED;
            PG8_LDB(B1, 0, 1); PG8_STAGE(PG8_SB(0, 0), b2, voffB);
            PG8_BAR; PG8_WAIT_L(0); PG8_MMA(0, 1, At, B1); PG8_BAR;
            PG8_LDA(At, 0, 1); PG8_STAGE(PG8_SA(0, 0), a2, voffA);
            PG8_BAR; PG8_WAIT_L(0); PG8_MMA(1, 0, At, B0); PG8_BAR; PG8_SCHED;
            PG8_STAGE(PG8_SB(0, 1), b2 + hstep, voffB);
            PG8_WAIT_V(6); PG8_BAR; PG8_MMA(1, 1, At, B1); PG8_BAR;
            PG8_LDB(B0, 1, 0); PG8_SCHED; PG8_LDA(At, 1, 0); PG8_STAGE(PG8_SA(0, 1), a2 + hstep, voffA);
            PG8_WAIT_L(8); PG8_BAR; PG8_WAIT_L(0); PG8_MMA(0, 0, At, B0); PG8_BAR; PG8_SCHED;
            PG8_LDB(B1, 1, 1); PG8_STAGE(PG8_SB(1, 0), b3, voffB);
            PG8_BAR; PG8_WAIT_L(0); PG8_MMA(0, 1, At, B1); PG8_BAR;
            PG8_LDA(At, 1, 1); PG8_STAGE(PG8_SA(1, 0), a3, voffA);
            PG8_BAR; PG8_WAIT_L(0); PG8_MMA(1, 0, At, B0); PG8_BAR; PG8_SCHED;
            PG8_STAGE(PG8_SB(1, 1), b3 + hstep, voffB);
            PG8_WAIT_V(6); PG8_BAR; PG8_MMA(1, 1, At, B1); PG8_BAR;
            }
        }
        if constexpr (ALIGN_EPI) { if (wr == 0) PG8_BAR; }
        if constexpr (!Epi::AFTER_DRAIN) { E(acc, cur, wr, wc, fr, fq); S.done(cur); }
        if (!has_next) break;
#pragma unroll
        for (int a = 0; a < 2; ++a)
#pragma unroll
            for (int b = 0; b < 2; ++b)
#pragma unroll
                for (int m = 0; m < 4; ++m)
#pragma unroll
                    for (int n = 0; n < 2; ++n) acc[a][b][m][n] = (f32x4){0.f, 0.f, 0.f, 0.f};
        cur = nxt; cA = nA; cB = nB; ++ui;
        if constexpr (ALIGN_EPI) { if (wr == 1) PG8_BAR; }
    }
    PG8_WAIT_V(0);
    if constexpr (!ALIGN_EPI) { if (wr == 0) PG8_BAR; }
    PG8_BAR;
    if constexpr (Epi::AFTER_DRAIN) { E.fused(acc, cur, wr, wc, fr, fq, lds, wid, lane); S.done(cur); }
#undef PG8_SA
#undef PG8_SB
#undef PG8_STAGE
#undef PG8_LDA
#undef PG8_LDB
#undef PG8_MMA
#undef PG8_WAIT_V
#undef PG8_WAIT_L
#undef PG8_BAR
#undef PG8_SCHED
}
}

using pg8::bf16_t; using pg8::bf16x8; using pg8::f32x4; using pg8::u32x4; using pg8::Unit;
#define LAS __attribute__((address_space(3)))
typedef unsigned u32x2 __attribute__((ext_vector_type(2)));
typedef short s16x4 __attribute__((ext_vector_type(4)));

constexpr float EPS = 1e-6f;
constexpr float LOG2E = 1.4426950408889634f;
constexpr int D = 1024, MP = 32768, MS = 512, MT = 33280, SEQ = 2048, DEC = 32, TKS = 2080, KVR = 66048, DFF = 2816;
constexpr size_t O_Y = 0;
constexpr size_t O_RSP = (size_t)MT * D;
constexpr size_t RS_ONE = (size_t)16 * 4 * 256 * 512;
constexpr size_t O_RSS = O_RSP + 2 * RS_ONE;
constexpr size_t O_LATP = O_RSS + 2 * RS_ONE;
constexpr size_t O_KRP = O_LATP + (size_t)MP * 256;
constexpr size_t O_LATS = O_KRP + (size_t)MP * 64;
constexpr size_t O_KRS = O_LATS + (size_t)MS * 256;
constexpr size_t O_FKP = O_KRS + (size_t)MS * 64;
constexpr size_t O_FVP = O_FKP + (size_t)MP * 1024;
constexpr size_t O_FLP = O_FVP + (size_t)MP * 1024;
constexpr size_t O_FKS = O_FLP + (size_t)MP * 16;
constexpr size_t O_FVS = O_FKS + (size_t)MS * 1024;
constexpr size_t O_FLS = O_FVS + (size_t)MS * 1024;
constexpr size_t O_END = O_FLS + (size_t)MS * 16;
constexpr size_t MiB = (size_t)1 << 20;
constexpr size_t WS_W = 0, WS_HBA = 140 * MiB, WS_SSQ = 206 * MiB, WS_CQSS = 211 * MiB, WS_ROPE = 213 * MiB, WS_ROPEM = 216 * MiB, WS_FP = 217 * MiB, WS_FS = 219 * MiB + 512 * 1024, WS_POOL = 222 * MiB;
constexpr size_t WS_HBB = WS_POOL + 400 * MiB;
constexpr size_t WS_NEED = WS_POOL + 628 * MiB;
constexpr size_t PL_RPROJ = WS_POOL, PL_ROBUF = WS_POOL + 470 * MiB;
constexpr size_t PL_ACT = WS_POOL, PL_PB = WS_POOL + 180 * MiB, PL_PP = WS_POOL + 200 * MiB;
constexpr size_t PL_LATB = WS_POOL, PL_KRB = WS_POOL + 33 * MiB, PL_MQ = WS_POOL + 42 * MiB, PL_KVH = WS_POOL + 238 * MiB, PL_MO = WS_POOL + 496 * MiB, PL_CQB = WS_POOL + 496 * MiB;
constexpr size_t PL_FPROJ = WS_POOL, PL_FKALL = WS_POOL + 260 * MiB, PL_FVALL = WS_POOL + 325 * MiB, PL_FO = WS_POOL + 470 * MiB;
constexpr size_t W_RI = 0, SZ_RI = (size_t)6144 * 1024;
constexpr size_t W_RO = W_RI + 2 * SZ_RI, SZ_RO = (size_t)1024 * 2048;
constexpr size_t W_MI = W_RO + 2 * SZ_RO;
constexpr size_t W_QB = W_MI + (size_t)1024 * 1024;
constexpr size_t W_KVB = W_QB + (size_t)3072 * 512;
constexpr size_t W_MO = W_KVB + (size_t)4096 * 256;
constexpr size_t W_FI = W_MO + (size_t)1024 * 2048;
constexpr size_t W_FO = W_FI + (size_t)4352 * 1024;
constexpr size_t W_GU = W_FO + (size_t)1024 * 1024, SZ_GU = (size_t)5632 * 1024;
constexpr size_t W_DN = W_GU + 4 * SZ_GU, SZ_DN = (size_t)1024 * 2816;
constexpr size_t W_PG = W_DN + 4 * SZ_DN, SZ_PG = (size_t)1024 * 1024;
constexpr size_t W_PP = W_PG + 4 * SZ_PG, SZ_PP = (size_t)1024 * 256;
constexpr size_t W_END = W_PP + 4 * SZ_PP;
static_assert(W_END * 2 <= 140 * MiB, "weights region");
constexpr int LDS_BYTES = 163840;
constexpr int XR_OFF = 131072;

struct Params { const float* in[37]; float* out; unsigned char* ws; int ph_lo, ph_hi; };
typedef const __attribute__((address_space(4))) Params* KP;
__device__ __forceinline__ KP kp() { KP p = (KP)__builtin_amdgcn_kernarg_segment_ptr(); asm volatile("" : "+s"(p)); return p; }
#define PIN(k) (kp()->in[k])
#define POUT (kp()->out)
#define PWS (kp()->ws)

__device__ __forceinline__ unsigned f2bf(float f) { unsigned u = __builtin_bit_cast(unsigned, f); return (u + 0x7fffu + ((u >> 16) & 1u)) >> 16; }
__device__ __forceinline__ unsigned pk2(float lo, float hi) { return f2bf(lo) | (f2bf(hi) << 16); }
__device__ __forceinline__ float bf2f(unsigned short h) { return __builtin_bit_cast(float, (unsigned)h << 16); }
__device__ __forceinline__ float bflo(unsigned u) { return __builtin_bit_cast(float, u << 16); }
__device__ __forceinline__ float bfhi(unsigned u) { return __builtin_bit_cast(float, u & 0xffff0000u); }
__device__ __forceinline__ u32x2 pk4(f32x4 v) { u32x2 r; r.x = pk2(v[0], v[1]); r.y = pk2(v[2], v[3]); return r; }
__device__ __forceinline__ float wave_sum(float v) {
#pragma unroll
    for (int o = 1; o < 64; o <<= 1) v += __shfl_xor(v, o);
    return v;
}
__device__ __forceinline__ float fq_sum(float v) { v += __shfl_xor(v, 16); v += __shfl_xor(v, 32); return v; }
__device__ __forceinline__ float sigmoidf_(float x) { return 1.f / (1.f + __expf(-x)); }
__device__ __forceinline__ float dot4(f32x4 v) { return (v[0] * v[0] + v[1] * v[1]) + (v[2] * v[2] + v[3] * v[3]); }
__device__ __forceinline__ void lds_barrier() { asm volatile("s_waitcnt lgkmcnt(0)" ::: "memory"); __builtin_amdgcn_s_barrier(); asm volatile("" ::: "memory"); }
__device__ __forceinline__ int tok_pos(int r) { return r < MP ? (r & (SEQ - 1)) : SEQ + ((r - MP) & (DEC - 1)); }
__device__ __forceinline__ int kv_row(int r) { return r < MP ? r : MP + ((r - MP) >> 5) * TKS + SEQ + ((r - MP) & 31); }
__device__ __forceinline__ float row_rstd(const float* ssq, int row, float invdim) {
    const f32x4 v = *(const f32x4*)(ssq + (size_t)row * 4);
    return rsqrtf(((v[0] + v[1]) + (v[2] + v[3])) * invdim + EPS);
}
#define EROW(u, ai, wr, m, fr) ((u).pm * 256 + (ai) * 128 + (wr) * 64 + (m) * 16 + (fr))
#define LROW(ai, wr, m, fr) ((ai) * 128 + (wr) * 64 + (m) * 16 + (fr))
#define ECOL(bj, wc, n, fq) ((bj) * 128 + (wc) * 32 + (n) * 16 + (fq) * 4)
typedef const f32x4 (&AccRef)[2][2][4][2];
#define EFENCE asm volatile("" ::: "memory")
#define RSV(ai, m) row_rstd(ssq, EROW(u, ai, wr, m, fr), 1.f / 1024.f)

struct EpiRetIn {
    static constexpr bool PERM = false, AFTER_DRAIN = false;
    const float* ssq; bf16_t* proj; const float* rope;
    __device__ __forceinline__ void operator()(AccRef acc, const Unit& u, int wr, int wc, int fr, int fq) const {
        const int pn = u.pn;
#pragma unroll
        for (int ai = 0; ai < 2; ++ai)
#pragma unroll
            for (int m = 0; m < 4; ++m) {
                const int r = EROW(u, ai, wr, m, fr); const float rs = row_rstd(ssq, r, 1.f / 1024.f);
                bf16_t* orow = proj + (size_t)r * 6144 + pn * 256 + wc * 32 + fq * 4;
                if (pn < 8) {
                    const float* tb = rope + (size_t)tok_pos(r) * 256 + wc * 32 + fq * 4; const float sc = pn >= 4 ? 0.0625f : 1.f;
#pragma unroll
                    for (int n = 0; n < 2; ++n) { const f32x4 c = *(const f32x4*)(tb + n * 16), s = *(const f32x4*)(tb + 128 + n * 16);
                        const f32x4 x1 = acc[ai][0][m][n] * rs, x2 = acc[ai][1][m][n] * rs;
                        *(u32x2*)(orow + n * 16) = pk4((x1 * c - x2 * s) * sc); *(u32x2*)(orow + 128 + n * 16) = pk4((x2 * c + x1 * s) * sc); }
                } else {
#pragma unroll
                    for (int bj = 0; bj < 2; ++bj)
#pragma unroll
                        for (int n = 0; n < 2; ++n) { f32x4 v = acc[ai][bj][m][n] * rs;
                            if (pn >= 16) { v[0] *= sigmoidf_(v[0]); v[1] *= sigmoidf_(v[1]); v[2] *= sigmoidf_(v[2]); v[3] *= sigmoidf_(v[3]); }
                            *(u32x2*)(orow + bj * 128 + n * 16) = pk4(v); }
                }
            }
    }
};
struct EpiRes {
    static constexpr bool PERM = false, AFTER_DRAIN = false;
    float* h; bf16_t* hb; float* ssqw; LAS float* xr;
    __device__ __forceinline__ void operator()(AccRef acc, const Unit& u, int wr, int wc, int fr, int fq) const {
        LAS float* const xq = xr + (wr * 64 + fr) * 4; LAS float* const xw = xq + wc;
#pragma unroll
        for (int ai = 0; ai < 2; ++ai)
#pragma unroll
            for (int m = 0; m < 4; ++m) {
                const int r = EROW(u, ai, wr, m, fr); const size_t off = (size_t)r * D + u.pn * 256 + wc * 32 + fq * 4; float ss = 0.f;
#pragma unroll
                for (int bj = 0; bj < 2; ++bj)
#pragma unroll
                    for (int n = 0; n < 2; ++n) { const size_t o = off + bj * 128 + n * 16; const f32x4 v = *(const f32x4*)(h + o) + acc[ai][bj][m][n];
                        *(f32x4*)(h + o) = v; *(u32x2*)(hb + o) = pk4(v); ss += dot4(v); }
                ss = fq_sum(ss); if (fq == 0) xw[(ai * 128 + m * 16) * 4] = ss;
            }
        lds_barrier();
        if (wc == 0 && fq == 0) {
#pragma unroll
            for (int ai = 0; ai < 2; ++ai)
#pragma unroll
                for (int m = 0; m < 4; ++m) { const f32x4 t = *(const LAS f32x4*)(xq + (ai * 128 + m * 16) * 4); ssqw[(size_t)EROW(u, ai, wr, m, fr) * 4 + u.pn] = (t[0] + t[1]) + (t[2] + t[3]); }
        }
    }
};
struct EpiGU {
    static constexpr bool PERM = false, AFTER_DRAIN = false;
    const float* ssq; bf16_t* act;
    __device__ __forceinline__ void operator()(AccRef acc, const Unit& u, int wr, int wc, int fr, int fq) const {
#pragma unroll
        for (int ai = 0; ai < 2; ++ai)
#pragma unroll
            for (int m = 0; m < 4; ++m) {
                const int r = EROW(u, ai, wr, m, fr); const float rs = row_rstd(ssq, r, 1.f / 1024.f);
                bf16_t* orow = act + (size_t)r * DFF + u.pn * 128 + wc * 32 + fq * 4;
#pragma unroll
                for (int n = 0; n < 2; ++n) { const f32x4 g = acc[ai][0][m][n] * rs, up = acc[ai][1][m][n] * rs; f32x4 v;
                    v[0] = g[0] * sigmoidf_(g[0]) * up[0]; v[1] = g[1] * sigmoidf_(g[1]) * up[1]; v[2] = g[2] * sigmoidf_(g[2]) * up[2]; v[3] = g[3] * sigmoidf_(g[3]) * up[3];
                    *(u32x2*)(orow + n * 16) = pk4(v); }
            }
    }
};
struct EpiPlain {
    static constexpr bool PERM = false, AFTER_DRAIN = false;
    bf16_t* out; int ldc; const float* ssq; float invdim;
    __device__ __forceinline__ void operator()(AccRef acc, const Unit& u, int wr, int wc, int fr, int fq) const {
#pragma unroll
        for (int ai = 0; ai < 2; ++ai)
#pragma unroll
            for (int m = 0; m < 4; ++m) {
                const int r = EROW(u, ai, wr, m, fr); const float rs = ssq ? row_rstd(ssq, r, invdim) : 1.f;
                bf16_t* orow = out + (size_t)r * ldc + u.pn * 256 + wc * 32 + fq * 4;
#pragma unroll
                for (int bj = 0; bj < 2; ++bj)
#pragma unroll
                    for (int n = 0; n < 2; ++n) *(u32x2*)(orow + bj * 128 + n * 16) = pk4(acc[ai][bj][m][n] * rs);
            }
    }
};
struct EpiPE {
    static constexpr bool PERM = false, AFTER_DRAIN = false;
    float* h; const bf16_t* pp; bf16_t* hb; const float* ssq; float* ssqw; LAS float* xr;
    __device__ __forceinline__ void operator()(AccRef acc, const Unit& u, int wr, int wc, int fr, int fq) const {
        LAS float* const xq = xr + (wr * 64 + fr) * 4; LAS float* const xw = xq + wc;
#pragma unroll
        for (int ai = 0; ai < 2; ++ai)
#pragma unroll
            for (int m = 0; m < 4; ++m) {
                const int r = EROW(u, ai, wr, m, fr); const float rs = row_rstd(ssq, r, 1.f / 1024.f);
                const size_t off = (size_t)r * D + u.pn * 256 + wc * 32 + fq * 4; float ss = 0.f;
#pragma unroll
                for (int bj = 0; bj < 2; ++bj)
#pragma unroll
                    for (int n = 0; n < 2; ++n) { const size_t o = off + bj * 128 + n * 16; const f32x4 a = acc[ai][bj][m][n] * rs; const u32x2 pw = *(const u32x2*)(pp + o);
                        f32x4 v = *(const f32x4*)(h + o);
                        v[0] += sigmoidf_(a[0]) * bflo(pw.x); v[1] += sigmoidf_(a[1]) * bfhi(pw.x); v[2] += sigmoidf_(a[2]) * bflo(pw.y); v[3] += sigmoidf_(a[3]) * bfhi(pw.y);
                        *(f32x4*)(h + o) = v; *(u32x2*)(hb + o) = pk4(v); ss += dot4(v); }
                ss = fq_sum(ss); if (fq == 0) xw[(ai * 128 + m * 16) * 4] = ss;
            }
        lds_barrier();
        if (wc == 0 && fq == 0) {
#pragma unroll
            for (int ai = 0; ai < 2; ++ai)
#pragma unroll
                for (int m = 0; m < 4; ++m) { const f32x4 t = *(const LAS f32x4*)(xq + (ai * 128 + m * 16) * 4); ssqw[(size_t)EROW(u, ai, wr, m, fr) * 4 + u.pn] = (t[0] + t[1]) + (t[2] + t[3]); }
        }
    }
};
struct EpiMlaIn {
    static constexpr bool PERM = false, AFTER_DRAIN = false;
    const float* ssq; unsigned char* ws; float* out; const float* kvn; const float* gkr; LAS float* xr;
    __device__ __forceinline__ void operator()(AccRef acc, const Unit& u, int wr, int wc, int fr, int fq) const {
        LAS float* const xq = xr + (wr * 64 + fr) * 4; LAS float* const xw = xq + wc;
        const int pn = u.pn;
        bf16_t* const cqb = (bf16_t*)(ws + PL_CQB); float* const cqss = (float*)(ws + WS_CQSS); bf16_t* const latb = (bf16_t*)(ws + PL_LATB); bf16_t* const krb = (bf16_t*)(ws + PL_KRB); const float* const ropem = (const float*)(ws + WS_ROPEM);
        if (pn < 2) {
#pragma unroll
            for (int ai = 0; ai < 2; ++ai)
#pragma unroll
                for (int m = 0; m < 4; ++m) { const int r = EROW(u, ai, wr, m, fr); bf16_t* orow = cqb + (size_t)r * 512 + pn * 256 + wc * 32 + fq * 4; float ss = 0.f;
#pragma unroll
                    for (int bj = 0; bj < 2; ++bj)
#pragma unroll
                        for (int n = 0; n < 2; ++n) { const f32x4 v = acc[ai][bj][m][n] * RSV(ai, m); ss += dot4(v); *(u32x2*)(orow + bj * 128 + n * 16) = pk4(v); }
                    ss = fq_sum(ss); if (fq == 0) xw[(ai * 128 + m * 16) * 4] = ss; EFENCE; }
            lds_barrier();
            if (wc == 0 && fq == 0) {
#pragma unroll
                for (int ai = 0; ai < 2; ++ai)
#pragma unroll
                    for (int m = 0; m < 4; ++m) { const f32x4 t = *(const LAS f32x4*)(xq + (ai * 128 + m * 16) * 4); float* cp = cqss + (size_t)EROW(u, ai, wr, m, fr) * 4; cp[pn] = (t[0] + t[1]) + (t[2] + t[3]); cp[2 + pn] = 0.f; }
            }
        } else if (pn == 2) {
#pragma unroll
            for (int ai = 0; ai < 2; ++ai)
#pragma unroll
                for (int m = 0; m < 4; ++m) { float ss = 0.f;
#pragma unroll
                    for (int bj = 0; bj < 2; ++bj)
#pragma unroll
                        for (int n = 0; n < 2; ++n) ss += dot4(acc[ai][bj][m][n] * RSV(ai, m));
                    ss = fq_sum(ss); if (fq == 0) xw[(ai * 128 + m * 16) * 4] = ss; EFENCE; }
            lds_barrier();
#pragma unroll
            for (int ai = 0; ai < 2; ++ai)
#pragma unroll
                for (int m = 0; m < 4; ++m) { const int r = EROW(u, ai, wr, m, fr); const f32x4 t = *(const LAS f32x4*)(xq + (ai * 128 + m * 16) * 4);
                    const float rk = rsqrtf(((t[0] + t[1]) + (t[2] + t[3])) * (1.f / 256.f) + EPS) * RSV(ai, m);
                    float* o32 = (r < MP ? out + O_LATP + (size_t)r * 256 : out + O_LATS + (size_t)(r - MP) * 256) + wc * 32 + fq * 4;
                    bf16_t* o16 = latb + (size_t)kv_row(r) * 256 + wc * 32 + fq * 4;
#pragma unroll
                    for (int bj = 0; bj < 2; ++bj)
#pragma unroll
                        for (int n = 0; n < 2; ++n) { const f32x4 g = *(const f32x4*)(kvn + ECOL(bj, wc, n, fq)); const f32x4 v = acc[ai][bj][m][n] * rk * g;
                            *(f32x4*)(o32 + bj * 128 + n * 16) = v; *(u32x2*)(o16 + bj * 128 + n * 16) = pk4(v); } EFENCE; }
        } else if (wc == 0) {
#pragma unroll
            for (int ai = 0; ai < 2; ++ai)
#pragma unroll
                for (int m = 0; m < 4; ++m) { const int r = EROW(u, ai, wr, m, fr); float ss = 0.f;
#pragma unroll
                    for (int n = 0; n < 2; ++n) ss += dot4(acc[ai][0][m][n] * RSV(ai, m)) + dot4(acc[ai][1][m][n] * RSV(ai, m));
                    ss = fq_sum(ss); const float rk = rsqrtf(ss * (1.f / 64.f) + EPS) * RSV(ai, m);
                    const float* tb = ropem + (size_t)tok_pos(r) * 64 + fq * 4;
                    float* o32 = (r < MP ? out + O_KRP + (size_t)r * 64 : out + O_KRS + (size_t)(r - MP) * 64) + fq * 4;
                    bf16_t* o16 = krb + (size_t)kv_row(r) * 64 + fq * 4;
#pragma unroll
                    for (int n = 0; n < 2; ++n) { const f32x4 g1 = *(const f32x4*)(gkr + n * 16 + fq * 4), g2 = *(const f32x4*)(gkr + 32 + n * 16 + fq * 4);
                        const f32x4 c = *(const f32x4*)(tb + n * 16), s = *(const f32x4*)(tb + 32 + n * 16);
                        const f32x4 y1 = acc[ai][0][m][n] * rk * g1, y2 = acc[ai][1][m][n] * rk * g2; const f32x4 z1 = y1 * c - y2 * s, z2 = y2 * c + y1 * s;
                        *(f32x4*)(o32 + n * 16) = z1; *(f32x4*)(o32 + 32 + n * 16) = z2; *(u32x2*)(o16 + n * 16) = pk4(z1); *(u32x2*)(o16 + 32 + n * 16) = pk4(z2); } EFENCE; }
        }
    }
};
struct EpiKV {
    static constexpr bool PERM = false, AFTER_DRAIN = false;
    bf16_t* kvh; LAS float* xr;
    __device__ __forceinline__ void operator()(AccRef acc, const Unit& u, int wr, int wc, int fr, int fq) const {
        LAS float* const xq = xr + (wr * 64 + fr) * 4; LAS float* const xw = xq + wc;
#pragma unroll
        for (int ai = 0; ai < 2; ++ai)
#pragma unroll
            for (int m = 0; m < 4; ++m) { float ss = dot4(acc[ai][0][m][0]) + dot4(acc[ai][0][m][1]); ss = fq_sum(ss); if (fq == 0) xw[(ai * 128 + m * 16) * 4] = ss; EFENCE; }
        lds_barrier();
#pragma unroll
        for (int ai = 0; ai < 2; ++ai)
#pragma unroll
            for (int m = 0; m < 4; ++m) { const int r = EROW(u, ai, wr, m, fr); const f32x4 t = *(const LAS f32x4*)(xq + (ai * 128 + m * 16) * 4);
                const float rk = rsqrtf(((t[0] + t[1]) + (t[2] + t[3])) * (1.f / 128.f) + EPS);
                bf16_t* orow = kvh + (size_t)r * 2048 + u.pn * 256 + wc * 32 + fq * 4;
#pragma unroll
                for (int n = 0; n < 2; ++n) { *(u32x2*)(orow + n * 16) = pk4(acc[ai][0][m][n] * rk); *(u32x2*)(orow + 128 + n * 16) = pk4(acc[ai][1][m][n]); } }
    }
};
struct EpiFoxIn {
    static constexpr bool PERM = false, AFTER_DRAIN = false;
    const float* ssq; unsigned char* ws; float* out; const float* gq; const float* gk; const float* bf; LAS float* xr;
    __device__ __forceinline__ void operator()(AccRef acc, const Unit& u, int wr, int wc, int fr, int fq) const {
        LAS float* const xq = xr + (wr * 64 + fr) * 4; LAS float* const xw = xq + wc;
        const int pn = u.pn;
        bf16_t* const proj = (bf16_t*)(ws + PL_FPROJ); bf16_t* const kall = (bf16_t*)(ws + PL_FKALL); bf16_t* const vall = (bf16_t*)(ws + PL_FVALL);
        if (pn < 8) {
#pragma unroll
            for (int ai = 0; ai < 2; ++ai)
#pragma unroll
                for (int m = 0; m < 4; ++m)
#pragma unroll
                    for (int bj = 0; bj < 2; ++bj) { float ss = dot4(acc[ai][bj][m][0] * RSV(ai, m)) + dot4(acc[ai][bj][m][1] * RSV(ai, m)); ss = fq_sum(ss);
                        if (fq == 0) xw[bj * 1024 + (ai * 128 + m * 16) * 4] = ss; EFENCE; }
            lds_barrier();
            const float* gg = pn < 4 ? gq : gk;
#pragma unroll
            for (int ai = 0; ai < 2; ++ai)
#pragma unroll
                for (int m = 0; m < 4; ++m) { const int r = EROW(u, ai, wr, m, fr);
#pragma unroll
                    for (int bj = 0; bj < 2; ++bj) { const f32x4 t = *(const LAS f32x4*)(xq + bj * 1024 + (ai * 128 + m * 16) * 4);
                        const float hs = wc < 2 ? t[0] + t[1] : t[2] + t[3]; const float rk = rsqrtf(hs * (1.f / 64.f) + EPS) * RSV(ai, m);
#pragma unroll
                        for (int n = 0; n < 2; ++n) { const f32x4 g = *(const f32x4*)(gg + (wc & 1) * 32 + n * 16 + fq * 4); const f32x4 v = acc[ai][bj][m][n] * rk * g;
                            const int ct = pn * 256 + ECOL(bj, wc, n, fq);
                            if (pn < 4) *(u32x2*)(proj + (size_t)r * 4096 + ct) = pk4(v);
                            else { const int ck = ct - 1024;
                                if (r < MP) { *(f32x4*)(out + O_FKP + (size_t)r * 1024 + ck) = v; *(u32x2*)(proj + (size_t)r * 4096 + ct) = pk4(v); }
                                else { const int rsm = r - MP; *(f32x4*)(out + O_FKS + (size_t)rsm * 1024 + ck) = v; *(u32x2*)(kall + ((size_t)(rsm >> 5) * TKS + SEQ + (rsm & 31)) * 1024 + ck) = pk4(v); } } } EFENCE; } }
        } else if (pn < 16) {
#pragma unroll
            for (int ai = 0; ai < 2; ++ai)
#pragma unroll
                for (int m = 0; m < 4; ++m) { const int r = EROW(u, ai, wr, m, fr);
#pragma unroll
                    for (int bj = 0; bj < 2; ++bj)
#pragma unroll
                        for (int n = 0; n < 2; ++n) { f32x4 v = acc[ai][bj][m][n] * RSV(ai, m); const int ct = pn * 256 + ECOL(bj, wc, n, fq);
                            if (pn < 12) { const int cv = ct - 2048;
                                if (r < MP) { *(f32x4*)(out + O_FVP + (size_t)r * 1024 + cv) = v; *(u32x2*)(proj + (size_t)r * 4096 + ct) = pk4(v); }
                                else { const int rsm = r - MP; *(f32x4*)(out + O_FVS + (size_t)rsm * 1024 + cv) = v; *(u32x2*)(vall + ((size_t)(rsm >> 5) * TKS + SEQ + (rsm & 31)) * 1024 + cv) = pk4(v); } }
                            else { v[0] = sigmoidf_(v[0]); v[1] = sigmoidf_(v[1]); v[2] = sigmoidf_(v[2]); v[3] = sigmoidf_(v[3]); *(u32x2*)(proj + (size_t)r * 4096 + ct) = pk4(v); } } EFENCE; }
        } else if (wc == 0) {
            const f32x4 b = *(const f32x4*)(bf + fq * 4);
#pragma unroll
            for (int ai = 0; ai < 2; ++ai)
#pragma unroll
                for (int m = 0; m < 4; ++m) { const int r = EROW(u, ai, wr, m, fr); const f32x4 x = acc[ai][0][m][0] * RSV(ai, m) + b; f32x4 v;
#pragma unroll
                    for (int e = 0; e < 4; ++e) v[e] = fminf(x[e], 0.f) - log1pf(__expf(-fabsf(x[e])));
                    float* o = (r < MP ? out + O_FLP + (size_t)r * 16 : out + O_FLS + (size_t)(r - MP) * 16) + fq * 4; *(f32x4*)o = v; }
        }
    }
};

struct WJob { const float* src; const float* src2; const float* gain; bf16_t* dst; int K, Nsrc, Ndst, map; };
__device__ __forceinline__ WJob get_job(int j) {
    bf16_t* W = (bf16_t*)(PWS + WS_W); WJob J; J.src2 = nullptr; J.gain = nullptr; J.map = 0;
    if (j < 2)       { J.src = PIN(14) + (size_t)j * 1024 * 6144; J.gain = PIN(10) + (size_t)(3 * j) * 1024; J.K = 1024; J.Nsrc = 6144; J.Ndst = 6144; J.dst = W + W_RI + j * SZ_RI; }
    else if (j < 4)  { const int i = j - 2; J.src = PIN(16) + (size_t)i * 2048 * 1024; J.K = 2048; J.Nsrc = 1024; J.Ndst = 1024; J.dst = W + W_RO + i * SZ_RO; }
    else if (j == 4) { J.src = PIN(17); J.gain = PIN(10) + 1024; J.K = 1024; J.Nsrc = 832; J.Ndst = 1024; J.map = 1; J.dst = W + W_MI; }
    else if (j == 5) { J.src = PIN(20); J.gain = PIN(18); J.K = 512; J.Nsrc = 3072; J.Ndst = 3072; J.dst = W + W_QB; }
    else if (j == 6) { J.src = PIN(21); J.K = 256; J.Nsrc = 4096; J.Ndst = 4096; J.dst = W + W_KVB; }
    else if (j == 7) { J.src = PIN(26); J.K = 2048; J.Nsrc = 1024; J.Ndst = 1024; J.dst = W + W_MO; }
    else if (j == 8) { J.src = PIN(27); J.gain = PIN(10) + 2048; J.K = 1024; J.Nsrc = 4112; J.Ndst = 4352; J.dst = W + W_FI; }
    else if (j == 9) { J.src = PIN(31); J.K = 1024; J.Nsrc = 1024; J.Ndst = 1024; J.dst = W + W_FO; }
    else if (j < 14) { const int i = j - 10; J.src = PIN(32) + (size_t)i * 1024 * DFF; J.src2 = PIN(33) + (size_t)i * 1024 * DFF; J.gain = PIN(11) + (size_t)i * 1024; J.K = 1024; J.Nsrc = DFF; J.Ndst = 5632; J.map = 2; J.dst = W + W_GU + i * SZ_GU; }
    else if (j < 18) { const int i = j - 14; J.src = PIN(34) + (size_t)i * DFF * 1024; J.K = DFF; J.Nsrc = 1024; J.Ndst = 1024; J.dst = W + W_DN + i * SZ_DN; }
    else if (j < 22) { const int i = j - 18; J.src = PIN(36) + (size_t)i * 1024 * 1024; J.gain = PIN(12) + (size_t)i * 1024; J.K = 1024; J.Nsrc = 1024; J.Ndst = 1024; J.dst = W + W_PG + i * SZ_PG; }
    else             { const int i = j - 22; J.src = PIN(35) + (size_t)i * 256 * 1024; J.K = 256; J.Nsrc = 1024; J.Ndst = 1024; J.dst = W + W_PP + i * SZ_PP; }
    return J;
}
__device__ __forceinline__ void wt_item(const WJob& J, LAS float* scr, int item, int lane) {
    const int nblk = J.Ndst / 32, kb = item / nblk, nb = item % nblk, k0 = 64 * kb, n0 = 32 * nb;
    const int n = n0 + (lane & 31); const float* sp = nullptr; int col = 0;
    if (J.map == 0) { if (n < J.Nsrc) { sp = J.src; col = n; } }
    else if (J.map == 1) { if (n < 768) { sp = J.src; col = n; } else { const int c = n - 768; if (c < 32) { sp = J.src; col = 768 + c; } else if (c >= 128 && c < 160) { sp = J.src; col = 800 + (c - 128); } } }
    else { const int pn = n >> 8, c = n & 255; if (c < 128) { sp = J.src; col = pn * 128 + c; } else { sp = J.src2; col = pn * 128 + c - 128; } }
#pragma unroll 8
    for (int i = 0; i < 32; ++i) { const int kk = 2 * i + (lane >> 5); float v = sp ? sp[(size_t)(k0 + kk) * J.Nsrc + col] : 0.f; if (J.gain) v *= J.gain[k0 + kk]; scr[kk * 33 + (lane & 31)] = v; }
    asm volatile("s_waitcnt lgkmcnt(0)" ::: "memory");
    const int c = lane & 7;
#pragma unroll
    for (int j = 0; j < 4; ++j) { const int nn = (lane >> 3) + 8 * j; const LAS float* s = scr + (8 * c) * 33 + nn;
        u32x4 o; o.x = pk2(s[0 * 33], s[1 * 33]); o.y = pk2(s[2 * 33], s[3 * 33]); o.z = pk2(s[4 * 33], s[5 * 33]); o.w = pk2(s[6 * 33], s[7 * 33]);
        *(u32x4*)(J.dst + (size_t)(n0 + nn) * J.K + k0 + 8 * c) = o; }
    asm volatile("s_waitcnt lgkmcnt(0)" ::: "memory");
}
__device__ __forceinline__ void phase_prologue(LAS unsigned char* lds) {
    int tid_o = threadIdx.x; asm volatile("" : "+v"(tid_o)); const int tid = tid_o, lane = tid & 63, wave = __builtin_amdgcn_readfirstlane(tid >> 6);
    const int gw = blockIdx.x * 8 + wave, NGW = gridDim.x * 8;
    LAS float* scr = (LAS float*)(lds + wave * 8704);
    int base = 0;
    for (int j = 0; j < 26; ++j) { const WJob J = get_job(j); const int cnt = (J.K / 64) * (J.Ndst / 32);
        int first = (gw - base) % NGW; if (first < 0) first += NGW;
        for (int it = first; it < cnt; it += NGW) wt_item(J, scr, it, lane);
        base += cnt; }
    { float* tr = (float*)(PWS + WS_ROPE); float* tm = (float*)(PWS + WS_ROPEM); const int gt = blockIdx.x * 512 + tid, NT = gridDim.x * 512;
        for (int i = gt; i < TKS * 128 + TKS * 32; i += NT) {
            int pos, j, half; if (i < TKS * 128) { pos = i >> 7; j = i & 127; half = 128; } else { const int k = i - TKS * 128; pos = k >> 5; j = k & 31; half = 32; }
            const float inv = exp2f(-(float)j / (float)half * 13.287712379549449f);
            const float ang = (float)pos * inv; double rev = (double)ang * 0.15915494309189535; rev -= floor(rev); const float rf = (float)rev;
            const float c = __builtin_amdgcn_cosf(rf), s = __builtin_amdgcn_sinf(rf);
            if (half == 128) { tr[(size_t)pos * 256 + j] = c; tr[(size_t)pos * 256 + 128 + j] = s; } else { tm[(size_t)pos * 64 + j] = c; tm[(size_t)pos * 64 + 32 + j] = s; } } }
    { bf16_t* hb = (bf16_t*)(PWS + WS_HBB); float* ssq = (float*)(PWS + WS_SSQ);
        for (int r = gw; r < MT; r += NGW) { const float* x = r < MP ? PIN(0) + (size_t)r * D : PIN(1) + (size_t)(r - MP) * D; float* h = POUT + O_Y + (size_t)r * D; float s = 0.f;
#pragma unroll
            for (int j = 0; j < 4; ++j) { const f32x4 v = *(const f32x4*)(x + (lane + 64 * j) * 4); *(f32x4*)(h + (lane + 64 * j) * 4) = v; *(u32x2*)(hb + (size_t)r * D + (lane + 64 * j) * 4) = pk4(v); s += dot4(v); }
            s = wave_sum(s); if (lane < 4) ssq[(size_t)r * 4 + lane] = lane == 0 ? s : 0.f; } }
}
__device__ __forceinline__ void cvt_chunks(const float* src, bf16_t* dst, size_t n8) {
    int tid_o = threadIdx.x; asm volatile("" : "+v"(tid_o)); const size_t gt = (size_t)blockIdx.x * 512 + tid_o, NT = (size_t)gridDim.x * 512;
    for (size_t i = gt; i < n8; i += NT) { const f32x4 a = *(const f32x4*)(src + i * 8), b = *(const f32x4*)(src + i * 8 + 4); u32x4 o; o.x = pk2(a[0], a[1]); o.y = pk2(a[2], a[3]); o.z = pk2(b[0], b[1]); o.w = pk2(b[2], b[3]); *(u32x4*)(dst + i * 8) = o; }
}
__device__ __forceinline__ void cvt_cache(const float* src, bf16_t* dst, int width) {
    const int cpr = width / 8; const size_t n8 = (size_t)16 * 2048 * cpr;
    int tid_o = threadIdx.x; asm volatile("" : "+v"(tid_o)); const size_t gt = (size_t)blockIdx.x * 512 + tid_o, NT = (size_t)gridDim.x * 512;
    for (size_t i = gt; i < n8; i += NT) { const size_t row = i / cpr; const int ch = (int)(i % cpr); const size_t b = row >> 11, t = row & 2047;
        const float* s = src + row * width + ch * 8; const f32x4 a = *(const f32x4*)s, c = *(const f32x4*)(s + 4); u32x4 o; o.x = pk2(a[0], a[1]); o.y = pk2(a[2], a[3]); o.z = pk2(c[0], c[1]); o.w = pk2(c[2], c[3]);
        *(u32x4*)(dst + (b * TKS + t) * width + ch * 8) = o; }
}

struct AU { const bf16_t* Q; int qs; const bf16_t* K1; int k1s; const bf16_t* K2; int k2s; const bf16_t* V; int vs; bf16_t* O; int os; const bf16_t* G; int gs; const float* Fk;
            int q0, nq, off, Tk; };
struct MlaQ { const float* gqn; const float* gkn; const float* gqr; const float* ropem; };
template <int DK, int DV, int MODE>
__device__ __forceinline__ void attn_unit(LAS unsigned char* lds, const AU& a, const MlaQ& mq) {
    constexpr int KS = (DK + 8) * 2, VS = (DV + 8) * 2, NS = DK / 32, NDB = DV / 16, KC = DK / 8, VC = DV / 8, KCH = 64 * KC / 512, VCH = 64 * VC / 512;
    constexpr int VOFF = 64 * KS, FOFF = VOFF + 64 * VS;
    int tid_o = threadIdx.x; asm volatile("" : "+v"(tid_o)); const int tid = tid_o, w = __builtin_amdgcn_readfirstlane(tid >> 6), lane = tid & 63, li = lane & 15, g = lane >> 4;
    const float cs = (MODE == 0 ? 0.07216878364870322f : 0.125f) * LOG2E;
    const bool active = 32 * w < a.nq;
    const int wq0 = a.q0 + 32 * w, rmax = a.q0 + a.nq - 1;
    bf16x8 qf[2][NS];
#pragma unroll
    for (int blk = 0; blk < 2; ++blk) { int row = wq0 + 16 * blk + li; row = row < rmax ? row : rmax; const bf16_t* qp = a.Q + (size_t)row * a.qs + 8 * g;
#pragma unroll
        for (int s = 0; s < NS; ++s) qf[blk][s] = *(const bf16x8*)(qp + 32 * s);
        if (MODE == 0) {
            float x[NS][8];
#pragma unroll
            for (int s = 0; s < NS; ++s)
#pragma unroll
                for (int j = 0; j < 8; ++j) x[s][j] = bf2f((unsigned short)qf[blk][s][j]);
            float ss = 0.f;
#pragma unroll
            for (int s = 0; s < 4; ++s)
#pragma unroll
                for (int j = 0; j < 8; ++j) ss += x[s][j] * x[s][j];
            ss = fq_sum(ss); const float rn = rsqrtf(ss * (1.f / 128.f) + EPS);
#pragma unroll
            for (int s = 0; s < 4; ++s)
#pragma unroll
                for (int j = 0; j < 8; ++j) { const int d = 32 * s + 8 * g + j; x[s][j] *= rn * mq.gqn[d] * mq.gkn[d]; }
            float sr = 0.f;
#pragma unroll
            for (int j = 0; j < 8; ++j) sr += x[4][j] * x[4][j] + x[5][j] * x[5][j];
            sr = fq_sum(sr); const float rr = rsqrtf(sr * (1.f / 64.f) + EPS);
            const float* tb = mq.ropem + (size_t)(a.off + row) * 64;
#pragma unroll
            for (int j = 0; j < 8; ++j) { const int dj = 8 * g + j; const float y1 = x[4][j] * rr * mq.gqr[dj], y2 = x[5][j] * rr * mq.gqr[32 + dj]; const float c = tb[dj], s = tb[32 + dj];
                x[4][j] = y1 * c - y2 * s; x[5][j] = y2 * c + y1 * s; }
#pragma unroll
            for (int s = 0; s < NS; ++s)
#pragma unroll
                for (int j = 0; j < 8; ++j) qf[blk][s][j] = (short)f2bf(x[s][j]);
        }
    }
    constexpr int QOFF = ((FOFF + 256 + 15) / 16) * 16;
    LAS unsigned char* qlds = lds + QOFF + w * (2 * NS * 1024) + lane * 16;
    if (MODE == 0) {
#pragma unroll
        for (int blk = 0; blk < 2; ++blk)
#pragma unroll
            for (int s = 0; s < NS; ++s) *(LAS bf16x8*)(qlds + (blk * NS + s) * 1024) = qf[blk][s];
    }
    const int last_pos = a.off + a.q0 + a.nq - 1;
    const int kend = MODE == 0 ? (((last_pos >> 6) + 1) * 64 < a.Tk ? ((last_pos >> 6) + 1) * 64 : a.Tk) : last_pos + 1;
    const int nt = (kend + 63) >> 6;
    f32x4 o[2][NDB]; float mrow[2], lrow[2];
#pragma unroll
    for (int blk = 0; blk < 2; ++blk) { mrow[blk] = -INFINITY; lrow[blk] = 0.f;
#pragma unroll
        for (int db = 0; db < NDB; ++db) o[blk][db] = (f32x4){0.f, 0.f, 0.f, 0.f}; }
    u32x4 kreg[KCH], vreg[VCH]; float freg = 0.f;
#define ATT_PREFETCH(t) do { \
        _Pragma("unroll") for (int c_ = 0; c_ < KCH; ++c_) { const int id = tid + 512 * c_, key = id / KC, ch = id % KC; int kr_ = 64 * (t) + key; kr_ = kr_ < a.Tk ? kr_ : a.Tk - 1; \
            const bf16_t* p_ = (MODE == 0 && ch >= 16) ? a.K2 + (size_t)kr_ * a.k2s + (ch - 16) * 8 : a.K1 + (size_t)kr_ * a.k1s + ch * 8; kreg[c_] = *(const u32x4*)p_; } \
        _Pragma("unroll") for (int c_ = 0; c_ < VCH; ++c_) { const int id = tid + 512 * c_, key = id / VC, ch = id % VC; int kr_ = 64 * (t) + key; kr_ = kr_ < a.Tk ? kr_ : a.Tk - 1; \
            vreg[c_] = *(const u32x4*)(a.V + (size_t)kr_ * a.vs + ch * 8); } \
        if (MODE == 1) { int kr_ = 64 * (t) + (tid & 63); kr_ = kr_ < a.Tk ? kr_ : a.Tk - 1; freg = a.Fk[kr_]; } } while (0)
    ATT_PREFETCH(0);
    const int wlo = a.off + wq0, whi = wlo + 31;
    for (int t = 0; t < nt; ++t) {
        lds_barrier();
#pragma unroll
        for (int c_ = 0; c_ < KCH; ++c_) { const int id = tid + 512 * c_, key = id / KC, ch = id % KC; *(LAS u32x4*)(lds + key * KS + ch * 16) = kreg[c_]; }
#pragma unroll
        for (int c_ = 0; c_ < VCH; ++c_) { const int id = tid + 512 * c_, key = id / VC, ch = id % VC; *(LAS u32x4*)(lds + VOFF + key * VS + ch * 16) = vreg[c_]; }
        if (MODE == 1 && tid < 64) *(LAS float*)(lds + FOFF + tid * 4) = freg;
        lds_barrier();
        if (t + 1 < nt) ATT_PREFETCH(t + 1);
        const bool skip = !active || (MODE == 0 ? (t > (whi >> 6)) : (64 * t > whi));
        if (!skip) {
            const bool needmask = (MODE == 1 && 64 * t + 63 > wlo) || (64 * t + 63 >= a.Tk);
            f32x4 sa[2][4];
#pragma unroll
            for (int blk = 0; blk < 2; ++blk)
#pragma unroll
                for (int kb = 0; kb < 4; ++kb) sa[blk][kb] = (f32x4){0.f, 0.f, 0.f, 0.f};
            if (MODE == 0) {
#pragma unroll
                for (int s = 0; s < NS; ++s) { const bf16x8 q0 = *(const LAS bf16x8*)(qlds + s * 1024), q1 = *(const LAS bf16x8*)(qlds + (NS + s) * 1024);
#pragma unroll
                    for (int kb = 0; kb < 4; ++kb) { const bf16x8 kf = *(const LAS bf16x8*)(lds + (16 * kb + li) * KS + (32 * s + 8 * g) * 2);
                        sa[0][kb] = __builtin_amdgcn_mfma_f32_16x16x32_bf16(kf, q0, sa[0][kb], 0, 0, 0);
                        sa[1][kb] = __builtin_amdgcn_mfma_f32_16x16x32_bf16(kf, q1, sa[1][kb], 0, 0, 0); }
                    __builtin_amdgcn_sched_barrier(0); }
            } else {
#pragma unroll
                for (int kb = 0; kb < 4; ++kb)
#pragma unroll
                    for (int s = 0; s < NS; ++s) { const bf16x8 kf = *(const LAS bf16x8*)(lds + (16 * kb + li) * KS + (32 * s + 8 * g) * 2);
                        sa[0][kb] = __builtin_amdgcn_mfma_f32_16x16x32_bf16(kf, qf[0][s], sa[0][kb], 0, 0, 0);
                        sa[1][kb] = __builtin_amdgcn_mfma_f32_16x16x32_bf16(kf, qf[1][s], sa[1][kb], 0, 0, 0); if (s == NS - 1) __builtin_amdgcn_sched_barrier(0); }
            }
            bf16x8 pf[2][2];
#pragma unroll
            for (int blk = 0; blk < 2; ++blk) {
                float mx = -INFINITY; const int pos = wlo + 16 * blk + li;
#pragma unroll
                for (int kb = 0; kb < 4; ++kb) { f32x4 fk = (f32x4){0.f, 0.f, 0.f, 0.f}; if (MODE == 1) fk = *(const LAS f32x4*)(lds + FOFF + (16 * kb + 4 * g) * 4);
#pragma unroll
                    for (int i = 0; i < 4; ++i) { float v = sa[blk][kb][i] * cs - fk[i];
                        if (needmask) { const int key = 64 * t + 16 * kb + 4 * g + i; const bool ok = key < a.Tk && (MODE == 0 ? ((key >> 6) <= (pos >> 6)) : (key <= pos)); v = ok ? v : -INFINITY; }
                        sa[blk][kb][i] = v; mx = fmaxf(mx, v); } }
                mx = fmaxf(mx, __shfl_xor(mx, 16)); mx = fmaxf(mx, __shfl_xor(mx, 32));
                const float mnew = fmaxf(mrow[blk], mx); const float alpha = __builtin_amdgcn_exp2f(mrow[blk] - mnew); mrow[blk] = mnew; float rsum = 0.f;
#pragma unroll
                for (int kb = 0; kb < 4; ++kb)
#pragma unroll
                    for (int i = 0; i < 4; ++i) { const float p = __builtin_amdgcn_exp2f(sa[blk][kb][i] - mnew); sa[blk][kb][i] = p; rsum += p; }
                lrow[blk] = lrow[blk] * alpha + rsum;
#pragma unroll
                for (int db = 0; db < NDB; ++db) o[blk][db] = o[blk][db] * alpha;
#pragma unroll
                for (int kk = 0; kk < 2; ++kk) { const f32x4 p0 = sa[blk][2 * kk], p1 = sa[blk][2 * kk + 1]; u32x4 pw; pw.x = pk2(p0[0], p0[1]); pw.y = pk2(p0[2], p0[3]); pw.z = pk2(p1[0], p1[1]); pw.w = pk2(p1[2], p1[3]);
                    pf[blk][kk] = __builtin_bit_cast(bf16x8, pw); }
            }
#pragma unroll
            for (int kk = 0; kk < 2; ++kk)
#pragma unroll
                for (int db = 0; db < NDB; ++db) {
                    const unsigned ad = VOFF + (32 * kk + 4 * g + (li >> 2)) * VS + (16 * db + 4 * (li & 3)) * 2;
                    const s16x4 v0 = __builtin_amdgcn_ds_read_tr16_b64_v4i16((LAS s16x4*)(lds + ad)), v1 = __builtin_amdgcn_ds_read_tr16_b64_v4i16((LAS s16x4*)(lds + ad + 16 * VS));
                    bf16x8 vf; vf[0] = v0[0]; vf[1] = v0[1]; vf[2] = v0[2]; vf[3] = v0[3]; vf[4] = v1[0]; vf[5] = v1[1]; vf[6] = v1[2]; vf[7] = v1[3];
                    o[0][db] = __builtin_amdgcn_mfma_f32_16x16x32_bf16(vf, pf[0][kk], o[0][db], 0, 0, 0);
                    o[1][db] = __builtin_amdgcn_mfma_f32_16x16x32_bf16(vf, pf[1][kk], o[1][db], 0, 0, 0);  if ((db & 1) == 1) __builtin_amdgcn_sched_barrier(0); }
        }
    }
#undef ATT_PREFETCH
    if (active) {
#pragma unroll
        for (int blk = 0; blk < 2; ++blk) { const int rl = 32 * w + 16 * blk + li; const float inv = 1.f / fq_sum(lrow[blk]);
            if (rl < a.nq) { const size_t row = (size_t)(a.q0 + rl);
#pragma unroll
                for (int db = 0; db < NDB; ++db) { f32x4 v = o[blk][db] * inv;
                    if (MODE == 1) { const u32x2 gw = *(const u32x2*)(a.G + row * a.gs + 16 * db + 4 * g); v[0] *= bflo(gw.x); v[1] *= bfhi(gw.x); v[2] *= bflo(gw.y); v[3] *= bfhi(gw.y); }
                    *(u32x2*)(a.O + row * a.os + 16 * db + 4 * g) = pk4(v); } } }
    }
}

constexpr int R_QS = 528, R_VS = 272, R_AS = 144, R_SS = 528;
constexpr int R_QOFF = 0, R_KOFF = 64 * R_QS, R_VOFF = 2 * 64 * R_QS, R_AOFF = R_VOFF + 64 * R_VS, R_SOFF = R_AOFF + 64 * R_AS, R_END = R_SOFF + 8 * 16 * R_SS;
static_assert(R_END <= LDS_BYTES, "retention LDS");
__device__ __forceinline__ void ret_unit(LAS unsigned char* lds, const bf16_t* proj, bf16_t* obuf, int row0, int L, int nchunks, int h, int sl, const float* s0, float* sout) {
    int tid_o = threadIdx.x; asm volatile("" : "+v"(tid_o)); const int tid = tid_o, w = __builtin_amdgcn_readfirstlane(tid >> 6), lane = tid & 63, li = lane & 15, g = lane >> 4;
    const int NLB = L >> 4, KM = L >> 5;
    const float lg2 = log2f(1.f - exp2f(-5.f - (float)h));
    const float cdec = exp2f(lg2 * (float)L);
    LAS unsigned char* sst = lds + R_SOFF + w * (16 * R_SS);
    f32x4 S[16];
#pragma unroll
    for (int blk = 0; blk < 16; ++blk) {
        if (s0) {
#pragma unroll
            for (int i = 0; i < 4; ++i) S[blk][i] = s0[(size_t)(16 * blk + 4 * g + i) * 512 + sl * 128 + 16 * w + li];
        } else S[blk] = (f32x4){0.f, 0.f, 0.f, 0.f};
        *(LAS u32x2*)(sst + li * R_SS + (16 * blk + 4 * g) * 2) = pk4(S[blk]);
    }
    const bf16_t* qb = proj + (size_t)row0 * 6144 + h * 256, *kb = qb + 1024, *vb = proj + (size_t)row0 * 6144 + 2048 + h * 512 + sl * 128;
    u32x4 qr[4], kr[4], vr[2];
#define RET_PREFETCH(c) do { const size_t rb = (size_t)(c) * L; \
        _Pragma("unroll") for (int i_ = 0; i_ < 4; ++i_) { const int id = tid + 512 * i_, r_ = id >> 5, ch = id & 31; const int rr = r_ < L ? r_ : L - 1; \
            qr[i_] = *(const u32x4*)(qb + (rb + rr) * 6144 + ch * 8); kr[i_] = *(const u32x4*)(kb + (rb + rr) * 6144 + ch * 8); } \
        _Pragma("unroll") for (int i_ = 0; i_ < 2; ++i_) { const int id = tid + 512 * i_, r_ = id >> 4, ch = id & 15; const int rr = r_ < L ? r_ : L - 1; \
            vr[i_] = *(const u32x4*)(vb + (rb + rr) * 6144 + ch * 8); } } while (0)
    RET_PREFETCH(0);
    for (int c = 0; c < nchunks; ++c) {
        lds_barrier();
#pragma unroll
        for (int i_ = 0; i_ < 4; ++i_) { const int id = tid + 512 * i_, r_ = id >> 5, ch = id & 31; *(LAS u32x4*)(lds + R_QOFF + r_ * R_QS + ch * 16) = qr[i_]; *(LAS u32x4*)(lds + R_KOFF + r_ * R_QS + ch * 16) = kr[i_]; }
#pragma unroll
        for (int i_ = 0; i_ < 2; ++i_) { const int id = tid + 512 * i_, r_ = id >> 4, ch = id & 15; *(LAS u32x4*)(lds + R_VOFF + r_ * R_VS + ch * 16) = vr[i_]; }
        lds_barrier();
        if (c + 1 < nchunks) RET_PREFETCH(c + 1);
        { const int lb = w >> 1;
#pragma unroll
            for (int mbi = 0; mbi < 2; ++mbi) { const int mb = 2 * (w & 1) + mbi;
                if (lb < NLB && mb < NLB) { f32x4 av = (f32x4){0.f, 0.f, 0.f, 0.f};
                    if (mb <= lb) {
#pragma unroll
                        for (int s = 0; s < 8; ++s) { const bf16x8 af = *(const LAS bf16x8*)(lds + R_QOFF + (16 * lb + li) * R_QS + (32 * s + 8 * g) * 2), bf = *(const LAS bf16x8*)(lds + R_KOFF + (16 * mb + li) * R_QS + (32 * s + 8 * g) * 2);
                            av = __builtin_amdgcn_mfma_f32_16x16x32_bf16(af, bf, av, 0, 0, 0); }
                    }
#pragma unroll
                    for (int i = 0; i < 4; ++i) { const int l = 16 * lb + 4 * g + i, mm = 16 * mb + li; const float dm = l >= mm ? exp2f(lg2 * (float)(l - mm)) : 0.f;
                        *(LAS unsigned short*)(lds + R_AOFF + l * R_AS + mm * 2) = (unsigned short)f2bf(av[i] * dm); } } } }
        lds_barrier();
        __builtin_amdgcn_sched_barrier(0);
        bf16x8 vf[2];
#pragma unroll
        for (int kk = 0; kk < 2; ++kk) { if (kk < KM) { const unsigned ad = R_VOFF + (32 * kk + 4 * g + (li >> 2)) * R_VS + (16 * w + 4 * (li & 3)) * 2;
                const s16x4 v0 = __builtin_amdgcn_ds_read_tr16_b64_v4i16((LAS s16x4*)(lds + ad)), v1 = __builtin_amdgcn_ds_read_tr16_b64_v4i16((LAS s16x4*)(lds + ad + 16 * R_VS));
                vf[kk][0] = v0[0]; vf[kk][1] = v0[1]; vf[kk][2] = v0[2]; vf[kk][3] = v0[3]; vf[kk][4] = v1[0]; vf[kk][5] = v1[1]; vf[kk][6] = v1[2]; vf[kk][7] = v1[3]; }
            else vf[kk] = (bf16x8){0, 0, 0, 0, 0, 0, 0, 0}; }
        f32x4 a1[4], a2[4];
#pragma unroll
        for (int lb = 0; lb < 4; ++lb) { a1[lb] = (f32x4){0.f, 0.f, 0.f, 0.f}; a2[lb] = (f32x4){0.f, 0.f, 0.f, 0.f}; }
#pragma unroll
        for (int kk = 0; kk < 2; ++kk) if (kk < KM) {
#pragma unroll
            for (int lb = 0; lb < 4; ++lb) if (lb < NLB) { const LAS unsigned char* ap = lds + R_AOFF + (16 * lb + li) * R_AS + (32 * kk + 4 * g) * 2;
                const u32x2 t0 = *(const LAS u32x2*)ap, t1 = *(const LAS u32x2*)(ap + 32); u32x4 tw; tw.x = t0.x; tw.y = t0.y; tw.z = t1.x; tw.w = t1.y;
                a1[lb] = __builtin_amdgcn_mfma_f32_16x16x32_bf16(vf[kk], __builtin_bit_cast(bf16x8, tw), a1[lb], 0, 0, 0); } }
#pragma unroll
        for (int s = 0; s < 8; ++s) { const bf16x8 sfr = *(const LAS bf16x8*)(sst + li * R_SS + (32 * s + 8 * g) * 2);
#pragma unroll
            for (int lb = 0; lb < 4; ++lb) if (lb < NLB) { const bf16x8 qf = *(const LAS bf16x8*)(lds + R_QOFF + (16 * lb + li) * R_QS + (32 * s + 8 * g) * 2);
                a2[lb] = __builtin_amdgcn_mfma_f32_16x16x32_bf16(sfr, qf, a2[lb], 0, 0, 0); } }
#pragma unroll
        for (int lb = 0; lb < 4; ++lb) if (lb < NLB) { const int l = 16 * lb + li; const float qd = exp2f(lg2 * (float)(l + 1));
            *(u32x2*)(obuf + ((size_t)row0 + (size_t)c * L + l) * 2048 + h * 512 + sl * 128 + 16 * w + 4 * g) = pk4(a1[lb] + a2[lb] * qd); }
        __builtin_amdgcn_sched_barrier(0);
        bf16x8 vd[2];
#pragma unroll
        for (int kk = 0; kk < 2; ++kk) {
#pragma unroll
            for (int j = 0; j < 8; ++j) { const int mm = 32 * kk + (j < 4 ? 4 * g + j : 16 + 4 * g + (j - 4)); const float kd = exp2f(lg2 * (float)(L - 1 - mm));
                vd[kk][j] = (short)f2bf(bf2f((unsigned short)vf[kk][j]) * kd); } }
#pragma unroll
        for (int blk = 0; blk < 16; ++blk) { f32x4 sv = S[blk] * cdec;
#pragma unroll
            for (int kk = 0; kk < 2; ++kk) if (kk < KM) { const unsigned ad = R_KOFF + (32 * kk + 4 * g + (li >> 2)) * R_QS + (16 * blk + 4 * (li & 3)) * 2;
                const s16x4 k0 = __builtin_amdgcn_ds_read_tr16_b64_v4i16((LAS s16x4*)(lds + ad)), k1 = __builtin_amdgcn_ds_read_tr16_b64_v4i16((LAS s16x4*)(lds + ad + 16 * R_QS));
                bf16x8 kf; kf[0] = k0[0]; kf[1] = k0[1]; kf[2] = k0[2]; kf[3] = k0[3]; kf[4] = k1[0]; kf[5] = k1[1]; kf[6] = k1[2]; kf[7] = k1[3];
                sv = __builtin_amdgcn_mfma_f32_16x16x32_bf16(kf, vd[kk], sv, 0, 0, 0); }
            S[blk] = sv;
            *(LAS u32x2*)(sst + li * R_SS + (16 * blk + 4 * g) * 2) = pk4(sv);
            if ((blk & 1) == 1) __builtin_amdgcn_sched_barrier(0); }
    }
#undef RET_PREFETCH
#pragma unroll
    for (int blk = 0; blk < 16; ++blk)
#pragma unroll
        for (int i = 0; i < 4; ++i) sout[(size_t)(16 * blk + 4 * g + i) * 512 + sl * 128 + 16 * w + li] = S[blk][i];
}
__device__ __forceinline__ void phase_ret_ln(int j) {
    int tid_o = threadIdx.x; asm volatile("" : "+v"(tid_o)); const int tid = tid_o, lane = tid & 63, wave = tid >> 6, gw = blockIdx.x * 8 + wave, NGW = gridDim.x * 8;
    bf16_t* obuf = (bf16_t*)(PWS + PL_ROBUF); const bf16_t* proj = (const bf16_t*)(PWS + PL_RPROJ); const float* gn = PIN(15) + (size_t)j * 2048;
    for (int it = gw; it < MT * 4; it += NGW) { const int r = it >> 2, h = it & 3; bf16_t* op = obuf + (size_t)r * 2048 + h * 512 + lane * 8;
        const u32x4 ow = *(const u32x4*)op, gwd = *(const u32x4*)(proj + (size_t)r * 6144 + 4096 + h * 512 + lane * 8);
        float x[8] = {bflo(ow.x), bfhi(ow.x), bflo(ow.y), bfhi(ow.y), bflo(ow.z), bfhi(ow.z), bflo(ow.w), bfhi(ow.w)};
        const float sg[8] = {bflo(gwd.x), bfhi(gwd.x), bflo(gwd.y), bfhi(gwd.y), bflo(gwd.z), bfhi(gwd.z), bflo(gwd.w), bfhi(gwd.w)};
        float s = 0.f;
#pragma unroll
        for (int e = 0; e < 8; ++e) s += x[e];
        const float mu = wave_sum(s) * (1.f / 512.f); float q = 0.f;
#pragma unroll
        for (int e = 0; e < 8; ++e) { x[e] -= mu; q += x[e] * x[e]; }
        const float rstd = rsqrtf(wave_sum(q) * (1.f / 512.f) + EPS);
        const f32x4 g0 = *(const f32x4*)(gn + h * 512 + lane * 8), g1 = *(const f32x4*)(gn + h * 512 + lane * 8 + 4);
        u32x4 o; o.x = pk2(x[0] * rstd * g0[0] * sg[0], x[1] * rstd * g0[1] * sg[1]); o.y = pk2(x[2] * rstd * g0[2] * sg[2], x[3] * rstd * g0[3] * sg[3]);
        o.z = pk2(x[4] * rstd * g1[0] * sg[4], x[5] * rstd * g1[1] * sg[5]); o.w = pk2(x[6] * rstd * g1[2] * sg[6], x[7] * rstd * g1[3] * sg[7]);
        *(u32x4*)op = o; }
}
__device__ __forceinline__ void phase_fox_scan() {
    int tid_o = threadIdx.x; asm volatile("" : "+v"(tid_o)); const int tid = tid_o, lane = tid & 63, wave = tid >> 6, gw = blockIdx.x * 8 + wave, NGW = gridDim.x * 8;
    for (int it = gw; it < 512; it += NGW) { const int grp = it >> 8, bh = it & 255, b = bh >> 4, h = bh & 15; const int T = grp ? TKS : SEQ, per = grp ? 33 : 32;
        float* F = grp ? (float*)(PWS + WS_FS) + (size_t)bh * TKS : (float*)(PWS + WS_FP) + (size_t)bh * SEQ;
        const int t0 = lane * per, t1 = (t0 + per) < T ? (t0 + per) : T; float s = 0.f;
        for (int t = t0; t < t1; ++t) { const float v = !grp ? POUT[O_FLP + ((size_t)b * SEQ + t) * 16 + h] : (t < SEQ ? PIN(7)[((size_t)b * SEQ + t) * 16 + h] : POUT[O_FLS + ((size_t)b * DEC + (t - SEQ)) * 16 + h]); s += v; }
        float inc = s;
#pragma unroll
        for (int o = 1; o < 64; o <<= 1) { const float n = __shfl_up(inc, o); if (lane >= o) inc += n; }
        float run = inc - s;
        for (int t = t0; t < t1; ++t) { const float v = !grp ? POUT[O_FLP + ((size_t)b * SEQ + t) * 16 + h] : (t < SEQ ? PIN(7)[((size_t)b * SEQ + t) * 16 + h] : POUT[O_FLS + ((size_t)b * DEC + (t - SEQ)) * 16 + h]); run += v; F[t] = run * LOG2E; } }
}
__device__ __forceinline__ void phase_final() {
    int tid_o = threadIdx.x; asm volatile("" : "+v"(tid_o)); const int tid = tid_o, lane = tid & 63, wave = tid >> 6, gw = blockIdx.x * 8 + wave, NGW = gridDim.x * 8; const float* gf = PIN(13);
    for (int r = gw; r < MT; r += NGW) { float* h = POUT + O_Y + (size_t)r * D; f32x4 v[4]; float s = 0.f;
#pragma unroll
        for (int j = 0; j < 4; ++j) { v[j] = *(const f32x4*)(h + (lane + 64 * j) * 4); s += dot4(v[j]); }
        const float rstd = rsqrtf(wave_sum(s) * (1.f / 1024.f) + EPS);
#pragma unroll
        for (int j = 0; j < 4; ++j) *(f32x4*)(h + (lane + 64 * j) * 4) = v[j] * rstd * *(const f32x4*)(gf + (lane + 64 * j) * 4); }
}

typedef pg8::StaticOrder SO;
#define GEMM(EpiT, A_, Bt_, M_, N_, K_, E_) do { pg8::Gemm g_{(const bf16_t*)(A_), (const bf16_t*)(Bt_), (M_), (N_), (K_)}; SO S_; S_.init((M_), (N_), (int)gridDim.x, (int)blockIdx.x); \
        pg8::gemm_phase<EpiT, SO, true, true>(lds, g_, S_, (E_)); } while (0)

__global__ void __launch_bounds__(512, 2) trunk_fwd(Params P) {
    extern __shared__ __attribute__((aligned(16))) unsigned char lds_raw[];
    LAS unsigned char* lds = (LAS unsigned char*)lds_raw;
    cg::grid_group grid = cg::this_grid();
    const int lo = kp()->ph_lo, hi = kp()->ph_hi; int pc = 0;
#define RUN (pc >= lo && pc < hi)
#ifndef ONLY
#define EN(k) true
#else
#define EN(k) ((k) == ONLY)
#endif
#define SEAM() do { if (pc >= lo && pc + 1 < hi) grid.sync(); ++pc; } while (0)
#define WB ((bf16_t*)(PWS + WS_W))
#define HBA ((bf16_t*)(PWS + WS_HBA))
#define HBB ((bf16_t*)(PWS + WS_HBB))
#define SSQ0 ((float*)(PWS + WS_SSQ))
#define SSQ1 ((float*)(PWS + WS_SSQ) + (size_t)MT * 4)
#define HRES (POUT + O_Y)
#define ROPE_ ((const float*)(PWS + WS_ROPE))
#define ROPEM_ ((const float*)(PWS + WS_ROPEM))
    LAS float* xr = (LAS float*)(lds + XR_OFF);
    int sp = 0;
#define SSQ_CUR (sp ? SSQ1 : SSQ0)
#define SSQ_NXT (sp ? SSQ0 : SSQ1)

    if (EN(1) && RUN) phase_prologue(lds);
    SEAM();

    for (int layer = 0; layer < 4; ++layer) {
        const int kind = layer % 3, j = layer / 3;
        if (kind == 0) {
            bf16_t* proj = (bf16_t*)(PWS + PL_RPROJ); bf16_t* obuf = (bf16_t*)(PWS + PL_ROBUF);
            if (EN(2) && RUN) { EpiRetIn E{SSQ_CUR, proj, ROPE_}; GEMM(EpiRetIn, HBB, WB + W_RI + j * SZ_RI, MT, 6144, 1024, E); }
            SEAM();
            if (EN(3) && RUN) {
                for (int u = blockIdx.x; u < 512; u += gridDim.x) { const int grp = u >> 8, c = u & 255, b = c >> 4, h = (c >> 2) & 3, sl = c & 3;
                    const size_t so = ((size_t)(j * 16 + b) * 4 + h) * 131072;
                    if (!grp) ret_unit(lds, proj, obuf, b * SEQ, 64, 32, h, sl, nullptr, POUT + O_RSP + so);
                    else ret_unit(lds, proj, obuf, MP + b * DEC, 32, 1, h, sl, PIN(2) + so, POUT + O_RSS + so);
                    lds_barrier(); }
            }
            SEAM();
            if (EN(4) && RUN) phase_ret_ln(j);
            SEAM();
            if (EN(5) && RUN) { EpiRes E{HRES, HBA, SSQ_NXT, xr}; GEMM(EpiRes, obuf, WB + W_RO + j * SZ_RO, MT, 1024, 2048, E); }
            sp ^= 1; SEAM();
        } else if (kind == 1) {
            bf16_t* cqb = (bf16_t*)(PWS + PL_CQB); float* cqss = (float*)(PWS + WS_CQSS); bf16_t* latb = (bf16_t*)(PWS + PL_LATB); bf16_t* krb = (bf16_t*)(PWS + PL_KRB);
            bf16_t* mq = (bf16_t*)(PWS + PL_MQ); bf16_t* kvh = (bf16_t*)(PWS + PL_KVH); bf16_t* mo = (bf16_t*)(PWS + PL_MO);
            if (EN(6) && RUN) {
                cvt_cache(PIN(3), latb + (size_t)MP * 256, 256); cvt_cache(PIN(4), krb + (size_t)MP * 64, 64);
                EpiMlaIn E{SSQ_CUR, PWS, POUT, PIN(19), PIN(25), xr}; GEMM(EpiMlaIn, HBB, WB + W_MI, MT, 1024, 1024, E); }
            SEAM();
            for (int hh = 0; hh < 2; ++hh) {
                if (EN(7) && RUN) {
                    if (hh == 0) { EpiPlain E{mq, 3072, cqss, 1.f / 512.f}; GEMM(EpiPlain, cqb, WB + W_QB, MT, 3072, 512, E); }
                    EpiKV E2{kvh, xr}; GEMM(EpiKV, latb, WB + W_KVB + (size_t)hh * 2048 * 256, KVR, 2048, 256, E2); }
                SEAM();
                if (EN(8) && RUN) {
                    const MlaQ q4{PIN(22), PIN(24), PIN(23), ROPEM_};
                    for (int u = blockIdx.x; u < 1024 + 128; u += gridDim.x) { AU a;
                        if (u < 1024) { const int i = u >> 8, c = u & 255, bh = c >> 1, b = bh >> 3, hl = bh & 7, hd = hh * 8 + hl; const int qb = (c & 1) ? ((i == 0) ? 1 : (i == 1) ? 2 : (i == 2) ? 5 : 6) : ((i == 0) ? 0 : (i == 1) ? 3 : (i == 2) ? 4 : 7);
                            const size_t r0 = (size_t)b * SEQ;
                            a.Q = mq + r0 * 3072 + hd * 192; a.qs = 3072; a.K1 = kvh + r0 * 2048 + hl * 256; a.k1s = 2048; a.K2 = krb + r0 * 64; a.k2s = 64; a.V = kvh + r0 * 2048 + hl * 256 + 128; a.vs = 2048;
                            a.O = mo + r0 * 2048 + hd * 128; a.os = 2048; a.G = nullptr; a.gs = 0; a.Fk = nullptr; a.q0 = qb * 256; a.nq = 256; a.off = 0; a.Tk = SEQ; }
                        else { const int c = u - 1024, b = c >> 3, hl = c & 7, hd = hh * 8 + hl; const size_t rq = (size_t)MP + (size_t)b * DEC, rk = (size_t)MP + (size_t)b * TKS;
                            a.Q = mq + rq * 3072 + hd * 192; a.qs = 3072; a.K1 = kvh + rk * 2048 + hl * 256; a.k1s = 2048; a.K2 = krb + rk * 64; a.k2s = 64; a.V = kvh + rk * 2048 + hl * 256 + 128; a.vs = 2048;
                            a.O = mo + rq * 2048 + hd * 128; a.os = 2048; a.G = nullptr; a.gs = 0; a.Fk = nullptr; a.q0 = 0; a.nq = DEC; a.off = SEQ; a.Tk = TKS; }
                        attn_unit<192, 128, 0>(lds, a, q4); }
                    lds_barrier();
                }
                SEAM();
            }
            if (EN(9) && RUN) { EpiRes E{HRES, HBA, SSQ_NXT, xr}; GEMM(EpiRes, mo, WB + W_MO, MT, 1024, 2048, E); }
            sp ^= 1; SEAM();
        } else {
            bf16_t* proj = (bf16_t*)(PWS + PL_FPROJ); bf16_t* kall = (bf16_t*)(PWS + PL_FKALL); bf16_t* vall = (bf16_t*)(PWS + PL_FVALL); bf16_t* fo = (bf16_t*)(PWS + PL_FO);
            if (EN(10) && RUN) {
                cvt_cache(PIN(5), kall, 1024); cvt_cache(PIN(6), vall, 1024);
                EpiFoxIn E{SSQ_CUR, PWS, POUT, PIN(29), PIN(30), PIN(28), xr}; GEMM(EpiFoxIn, HBB, WB + W_FI, MT, 4352, 1024, E); }
            SEAM();
            if (EN(11) && RUN) phase_fox_scan();
            SEAM();
            if (EN(12) && RUN) {
                const MlaQ q4{nullptr, nullptr, nullptr, nullptr};
                for (int u = blockIdx.x; u < 2048 + 256; u += gridDim.x) { AU a; a.K2 = nullptr; a.k2s = 0;
                    if (u < 2048) { const int qb = u >> 8, bh = u & 255, b = bh >> 4, hd = bh & 15; const size_t r0 = (size_t)b * SEQ;
                        a.Q = proj + r0 * 4096 + hd * 64; a.qs = 4096; a.K1 = proj + r0 * 4096 + 1024 + hd * 64; a.k1s = 4096; a.V = proj + r0 * 4096 + 2048 + hd * 64; a.vs = 4096;
                        a.O = fo + r0 * 1024 + hd * 64; a.os = 1024; a.G = proj + r0 * 4096 + 3072 + hd * 64; a.gs = 4096; a.Fk = (const float*)(PWS + WS_FP) + (size_t)bh * SEQ; a.q0 = qb * 256; a.nq = 256; a.off = 0; a.Tk = SEQ; }
                    else { const int bh = u - 2048, b = bh >> 4, hd = bh & 15; const size_t rq = (size_t)MP + (size_t)b * DEC, rk = (size_t)b * TKS;
                        a.Q = proj + rq * 4096 + hd * 64; a.qs = 4096; a.K1 = kall + rk * 1024 + hd * 64; a.k1s = 1024; a.V = vall + rk * 1024 + hd * 64; a.vs = 1024;
                        a.O = fo + rq * 1024 + hd * 64; a.os = 1024; a.G = proj + rq * 4096 + 3072 + hd * 64; a.gs = 4096; a.Fk = (const float*)(PWS + WS_FS) + (size_t)bh * TKS; a.q0 = 0; a.nq = DEC; a.off = SEQ; a.Tk = TKS; }
                    attn_unit<64, 64, 1>(lds, a, q4); }
                lds_barrier();
            }
            SEAM();
            if (EN(13) && RUN) { EpiRes E{HRES, HBA, SSQ_NXT, xr}; GEMM(EpiRes, fo, WB + W_FO, MT, 1024, 1024, E); }
            sp ^= 1; SEAM();
        }
        bf16_t* act = (bf16_t*)(PWS + PL_ACT); bf16_t* pb = (bf16_t*)(PWS + PL_PB); bf16_t* pp = (bf16_t*)(PWS + PL_PP);
        if (EN(14) && RUN) {
            cvt_chunks(PIN(8) + (size_t)layer * MP * 256, pb, (size_t)MP * 32); cvt_chunks(PIN(9) + (size_t)layer * MS * 256, pb + (size_t)MP * 256, (size_t)MS * 32);
            EpiGU E{SSQ_CUR, act}; GEMM(EpiGU, HBA, WB + W_GU + layer * SZ_GU, MT, 5632, 1024, E); }
        SEAM();
        if (EN(15) && RUN) {
            { EpiRes E{HRES, HBA, SSQ_NXT, xr}; GEMM(EpiRes, act, WB + W_DN + layer * SZ_DN, MT, 1024, DFF, E); }
            { EpiPlain E{pp, 1024, nullptr, 0.f}; GEMM(EpiPlain, pb, WB + W_PP + layer * SZ_PP, MT, 1024, 256, E); } }
        sp ^= 1; SEAM();
        if (EN(16) && RUN) { EpiPE E{HRES, pp, HBB, SSQ_CUR, SSQ_NXT, xr}; GEMM(EpiPE, HBA, WB + W_PG + layer * SZ_PG, MT, 1024, 1024, E); }
        sp ^= 1; SEAM();
    }
    if (EN(17) && RUN) phase_final();
}

extern "C" void kernel_launch(void* const* d_in, const int* in_sizes, int n_in, void* d_out, int out_size, void* d_ws, size_t ws_size, hipStream_t stream) {
    static int grid = 0;
    if (grid == 0) {
        if (n_in != 37 || (size_t)out_size != O_END || ws_size < WS_NEED) { fprintf(stderr, "kernel_launch: unexpected sizes n_in %d out %d ws %zu (need %zu)\n", n_in, out_size, ws_size, (size_t)WS_NEED); grid = -1; return; }
        int dev = 0, cus = 0, per_cu = 0;
        if (hipGetDevice(&dev) != hipSuccess || hipDeviceGetAttribute(&cus, hipDeviceAttributeMultiprocessorCount, dev) != hipSuccess) { grid = -1; return; }
        if (hipFuncSetAttribute((const void*)trunk_fwd, hipFuncAttributeMaxDynamicSharedMemorySize, LDS_BYTES) != hipSuccess) { fprintf(stderr, "kernel_launch: hipFuncSetAttribute failed\n"); grid = -1; return; }
        if (hipOccupancyMaxActiveBlocksPerMultiprocessor(&per_cu, (const void*)trunk_fwd, 512, LDS_BYTES) != hipSuccess || per_cu < 1) { fprintf(stderr, "kernel_launch: occupancy query says %d\n", per_cu); per_cu = 1; }
        (void)hipGetLastError();
        grid = cus * per_cu;
    }
    if (grid < 0) return;
    Params p{};
    for (int i = 0; i < 37; ++i) p.in[i] = (const float*)d_in[i];
    p.out = (float*)d_out; p.ws = (unsigned char*)d_ws; p.ph_lo = 0; p.ph_hi = 1000;
    void* args[] = {&p};
    hipError_t e = hipLaunchCooperativeKernel((const void*)trunk_fwd, dim3(grid), dim3(512), args, LDS_BYTES, stream);
    if (e != hipSuccess) fprintf(stderr, "cooperative launch failed: %s (grid %d)\n", hipGetErrorString(e), grid);
}
```

```cpp
#include <hip/hip_runtime.h>
#include <hip/hip_cooperative_groups.h>
#include <cstdio>
#include <cstdint>
namespace cg = cooperative_groups;
namespace pg8 {
#define PG8_LAS __attribute__((address_space(3)))
typedef unsigned short bf16_t;
typedef short bf16x8 __attribute__((ext_vector_type(8)));
typedef float f32x4 __attribute__((ext_vector_type(4)));
typedef unsigned u32x4 __attribute__((ext_vector_type(4)));
constexpr int BM = 256, BK = 64, HALF = 128, HTB = HALF * BK * 2  , STAGE_BYTES = 8 * HTB, NXCD = 8, WGM = 8;

__host__ __device__ __forceinline__ int lds_byte(int r, int c) { const int st = (r >> 4) * 2 + (c >> 5), rr = r & 15, cc = c & 31, ob = rr * 64 + cc * 2; return st * 1024 + (ob ^ (((ob >> 9) & 1) << 5)); }
__host__ __device__ __forceinline__ void stage_rc(int b, int& R, int& C) { const int st = b / 1024, sb = b % 1024, swz = sb ^ (((sb >> 9) & 1) << 5); R = (st >> 1) * 16 + swz / 64; C = (st & 1) * 32 + (swz % 64) / 2; }
__host__ __device__ __forceinline__ int perm32(int rho) { const int n = rho >> 4, i = rho & 15; return 8 * (i >> 2) + 4 * n + (i & 3); }

struct Unit { int pm, pn; };
struct Gemm { const bf16_t* A; const bf16_t* Bt; int M, N, K; };

struct StaticOrder {
    int nM, nN, nwg, G, c;
    __host__ __device__ void init(int M, int N, int G_, int c_) { nM = M / BM; nN = N / BM; nwg = nM * nN; G = G_; c = c_; }
    __host__ __device__ bool next(int i, Unit& u) const {
        const long L = (long)i * G + c; if (L >= nwg) return false;
        int wgid = (int)L; { const int q = nwg / NXCD, r = nwg % NXCD, xcd = wgid % NXCD, off = wgid / NXCD; wgid = (xcd < r ? xcd * (q + 1) : r * (q + 1) + (xcd - r) * q) + off; }
        const int nig = WGM * nN, gid = wgid / nig, fm = gid * WGM, gsz = (nM - fm) < WGM ? (nM - fm) : WGM;
        u.pm = fm + ((wgid % nig) % gsz); u.pn = (wgid % nig) / gsz; return true;
    }
    __device__ __forceinline__ void a_ready(const Unit&) const {}
    __device__ __forceinline__ void done(const Unit&) const {}
};

typedef float f32x2 __attribute__((ext_vector_type(2)));
template <class Epi, class Sched, bool ALIGN_EPI = false, bool SP2 = false>
__device__ __forceinline__ void gemm_phase(PG8_LAS unsigned char* lds, const Gemm g, const Sched& S, const Epi& E) {
    int tid_o = threadIdx.x; asm volatile("" : "+v"(tid_o)); const int tid = tid_o, wid = __builtin_amdgcn_readfirstlane(tid >> 6), lane = tid & 63, wr = wid >> 2, wc = wid & 3, fr = lane & 15, fq = lane >> 4;
    const int K = g.K, nt = K / BK;
    unsigned voffA[2], voffB[2];
#pragma unroll
    for (int i = 0; i < 2; ++i) { int R, C; stage_rc(tid * 16 + i * 8192, R, C); const int Rb = Epi::PERM ? ((R & ~31) + perm32(R & 31)) : R;
        voffA[i] = (unsigned)(R * K + C) * 2u; voffB[i] = (unsigned)(Rb * K + C) * 2u; }
    const size_t kstep = (size_t)(BK * 2);
    const size_t hstep = (size_t)HALF * K * 2;
    const size_t tstep = 2 * hstep;
    const unsigned ldsw = (unsigned)wid * 1024u;
    const int aoff = lds_byte(wr * 64 + fr, fq * 8), boff = lds_byte(wc * 32 + fr, fq * 8);
#define PG8_SA(b, h) (((b) * 2 + (h)) * HTB)
#define PG8_SB(b, h) ((4 + (b) * 2 + (h)) * HTB)
#define PG8_STAGE(bufoff, gbase, voff) do { _Pragma("unroll") for (int _i = 0; _i < 2; ++_i) \
        __builtin_amdgcn_global_load_lds((const unsigned*)((const char*)(gbase) + (voff)[_i]), (PG8_LAS unsigned*)(lds + (bufoff) + ldsw + _i * 8192), 16, 0, 0); } while (0)
#define PG8_LDA(dst, b, h) do { _Pragma("unroll") for (int m = 0; m < 4; ++m) _Pragma("unroll") for (int k = 0; k < 2; ++k) dst[m][k] = *(const PG8_LAS bf16x8*)(lds + PG8_SA(b, h) + aoff + m * 2048 + k * 1024); } while (0)
#define PG8_LDB(dst, b, h) do { _Pragma("unroll") for (int n = 0; n < 2; ++n) _Pragma("unroll") for (int k = 0; k < 2; ++k) dst[n][k] = *(const PG8_LAS bf16x8*)(lds + PG8_SB(b, h) + boff + n * 2048 + k * 1024); } while (0)
#define PG8_MMA(ai, bj, At, Bt) do { __builtin_amdgcn_s_setprio(1); _Pragma("unroll") for (int m = 0; m < 4; ++m) _Pragma("unroll") for (int n = 0; n < 2; ++n) _Pragma("unroll") for (int k = 0; k < 2; ++k) \
        acc[ai][bj][m][n] = __builtin_amdgcn_mfma_f32_16x16x32_bf16(Bt[n][k], At[m][k], acc[ai][bj][m][n], 0, 0, 0); __builtin_amdgcn_s_setprio(0); } while (0)
#define PG8_WAIT_V(n) asm volatile("s_waitcnt vmcnt(" #n ")" ::: "memory")
#define PG8_WAIT_L(n) asm volatile("s_waitcnt lgkmcnt(" #n ")" ::: "memory")
#define PG8_BAR __builtin_amdgcn_s_barrier()
#define PG8_SCHED __builtin_amdgcn_sched_barrier(0)
    Unit cur, nxt; int ui = 0;
    if (!S.next(0, cur)) return;
    f32x4 acc[2][2][4][2];
#pragma unroll
    for (int a = 0; a < 2; ++a)
#pragma unroll
        for (int b = 0; b < 2; ++b)
#pragma unroll
            for (int m = 0; m < 4; ++m)
#pragma unroll
                for (int n = 0; n < 2; ++n) acc[a][b][m][n] = (f32x4){0.f, 0.f, 0.f, 0.f};
    bf16x8 At[4][2], B0[2][2], B1[2][2];
    const char* cA = (const char*)g.A + (size_t)cur.pm * tstep; const char* cB = (const char*)g.Bt + (size_t)cur.pn * tstep;
    S.a_ready(cur);
    if constexpr (SP2) {
        PG8_STAGE(PG8_SB(0, 0), cB, voffB); PG8_STAGE(PG8_SB(0, 1), cB + hstep, voffB); PG8_STAGE(PG8_SA(0, 0), cA, voffA); PG8_STAGE(PG8_SA(0, 1), cA + hstep, voffA);
        if (wr == 1) PG8_BAR;
        PG8_WAIT_V(2); PG8_BAR;
        PG8_STAGE(PG8_SB(1, 0), cB + kstep, voffB); PG8_STAGE(PG8_SA(1, 0), cA + kstep, voffA); PG8_STAGE(PG8_SB(1, 1), cB + hstep + kstep, voffB);
        PG8_WAIT_V(6); PG8_BAR;
    } else {
        PG8_STAGE(PG8_SB(0, 0), cB, voffB); PG8_STAGE(PG8_SA(0, 0), cA, voffA); PG8_STAGE(PG8_SB(0, 1), cB + hstep, voffB); PG8_STAGE(PG8_SA(0, 1), cA + hstep, voffA);
        if (wr == 1) PG8_BAR;
        PG8_WAIT_V(4); PG8_BAR;
        PG8_STAGE(PG8_SB(1, 0), cB + kstep, voffB); PG8_STAGE(PG8_SA(1, 0), cA + kstep, voffA); PG8_STAGE(PG8_SB(1, 1), cB + hstep + kstep, voffB);
        PG8_WAIT_V(6); PG8_BAR;
    }
    for (;;) {
        const bool has_next = S.next(ui + 1, nxt);
        const char* nA = has_next ? (const char*)g.A + (size_t)nxt.pm * tstep : cA; const char* nB = has_next ? (const char*)g.Bt + (size_t)nxt.pn * tstep : cB;
        for (int t = 0; t < nt; t += 2) {
            const bool last = (t == nt - 2);
            const char* a1 = cA + (size_t)(t + 1) * kstep;
            const char* a2 = last ? nA : cA + (size_t)(t + 2) * kstep; const char* b2 = last ? nB : cB + (size_t)(t + 2) * kstep;
            const char* a3 = a2 + kstep; const char* b3 = b2 + kstep;
            if (last && has_next) S.a_ready(nxt);
            if constexpr (SP2) {
            PG8_LDB(B0, 0, 0); PG8_LDB(B1, 0, 1); PG8_SCHED; PG8_LDA(At, 0, 0); PG8_STAGE(PG8_SA(1, 1), a1 + hstep, voffA);
            PG8_WAIT_V(8); PG8_WAIT_L(0); PG8_BAR; PG8_MMA(0, 0, At, B0); PG8_MMA(0, 1, At, B1); PG8_BAR; PG8_SCHED;
            PG8_LDA(At, 0, 1); PG8_STAGE(PG8_SB(0, 0), b2, voffB); PG8_STAGE(PG8_SB(0, 1), b2 + hstep, voffB); PG8_STAGE(PG8_SA(0, 0), a2, voffA);
            PG8_WAIT_V(8); PG8_WAIT_L(0); PG8_BAR; PG8_MMA(1, 0, At, B0); PG8_MMA(1, 1, At, B1); PG8_BAR; PG8_SCHED;
            PG8_LDB(B0, 1, 0); PG8_LDB(B1, 1, 1); PG8_SCHED; PG8_LDA(At, 1, 0); PG8_STAGE(PG8_SA(0, 1), a2 + hstep, voffA);
            PG8_WAIT_V(8); PG8_WAIT_L(0); PG8_BAR; PG8_MMA(0, 0, At, B0); PG8_MMA(0, 1, At, B1); PG8_BAR; PG8_SCHED;
            PG8_LDA(At, 1, 1); PG8_STAGE(PG8_SB(1, 0), b3, voffB); PG8_STAGE(PG8_SB(1, 1), b3 + hstep, voffB); PG8_STAGE(PG8_SA(1, 0), a3, voffA);
            PG8_WAIT_V(8); PG8_WAIT_L(0); PG8_BAR; PG8_MMA(1, 0, At, B0); PG8_MMA(1, 1, At, B1); PG8_BAR; PG8_SCHED;
            } else {
            PG8_LDB(B0, 0, 0); PG8_SCHED; PG8_LDA(At, 0, 0); PG8_STAGE(PG8_SA(1, 1), a1 + hstep, voffA);
            PG8_WAIT_L(8); PG8_BAR; PG8_WAIT_L(0); PG8_MMA(0, 0, At, B0); PG8_BAR; PG8_SCHED;
            PG8_LDB(B1, 0, 1); PG8_STAGE(PG8_SB(0, 0), b2, voffB);
            PG8_BAR; PG8_WAIT_L(0); PG8_MMA(0, 1, At, B1); PG8_BAR;
            PG8_LDA(At, 0, 1); PG8_STAGE(PG8_SA(0, 0), a2, voffA);
            PG8_BAR; PG8_WAIT_L(0); PG8_MMA(1, 0, At, B0); PG8_BAR; PG8_SCHED;
            PG8_STAGE(PG8_SB(0, 1), b2 + hstep, voffB);
            PG8_WAIT_V(6); PG8_BAR; PG8_MMA(1, 1, At, B1); PG8_BAR;
            PG8_LDB(B0, 1, 0); PG8_SCHED; PG8_LDA(At, 1, 0); PG8_STAGE(PG8_SA(0, 1), a2 + hstep, voffA);
            PG8_WAIT_L(8); PG8_BAR; PG8_WAIT_L(0); PG8_MMA(0, 0, At, B0); PG8_BAR; PG8_SCHED;
            PG8_LDB(B1, 1, 1); PG8_STAGE(PG8_SB(1, 0), b3, voffB);
            PG8_BAR; PG8_WAIT_L(0); PG8_MMA(0, 1, At, B1); PG8_BAR;
            PG8_LDA(At, 1, 1); PG8_STAGE(PG8_SA(1, 0), a3, voffA);
            PG8_BAR; PG8_WAIT_L(0); PG8_MMA(1, 0, At, B0); PG8_BAR; PG8_SCHED;
            PG8_STAGE(PG8_SB(1, 1), b3 + hstep, voffB);
            PG8_WAIT_V(6); PG8_BAR; PG8_MMA(1, 1, At, B1); PG8_BAR;
            }
        }
        if constexpr (ALIGN_EPI) { if (wr == 0) PG8_BAR; }
        if constexpr (!Epi::AFTER_DRAIN) { E(acc, cur, wr, wc, fr, fq); S.done(cur); }
        if (!has_next) break;
#pragma unroll
        for (int a = 0; a < 2; ++a)
#pragma unroll
            for (int b = 0; b < 2; ++b)
#pragma unroll
                for (int m = 0; m < 4; ++m)
#pragma unroll
                    for (int n = 0; n < 2; ++n) acc[a][b][m][n] = (f32x4){0.f, 0.f, 0.f, 0.f};
        cur = nxt; cA = nA; cB = nB; ++ui;
        if constexpr (ALIGN_EPI) { if (wr == 1) PG8_BAR; }
    }
    PG8_WAIT_V(0);
    if constexpr (!ALIGN_EPI) { if (wr == 0) PG8_BAR; }
    PG8_BAR;
    if constexpr (Epi::AFTER_DRAIN) { E.fused(acc, cur, wr, wc, fr, fq, lds, wid, lane); S.done(cur); }
#undef PG8_SA
#undef PG8_SB
#undef PG8_STAGE
#undef PG8_LDA
#undef PG8_LDB
#undef PG8_MMA
#undef PG8_WAIT_V
#undef PG8_WAIT_L
#undef PG8_BAR
#undef PG8_SCHED
}
}

using pg8::bf16_t; using pg8::bf16x8; using pg8::f32x4; using pg8::u32x4; using pg8::Unit;
#define LAS __attribute__((address_space(3)))
typedef unsigned u32x2 __attribute__((ext_vector_type(2)));
typedef short s16x4 __attribute__((ext_vector_type(4)));

constexpr float EPS = 1e-6f;
constexpr float LOG2E = 1.4426950408889634f;
constexpr int D = 1024, MP = 32768, MS = 512, MT = 33280, SEQ = 2048, DEC = 32, TKS = 2080, KVR = 66048, DFF = 2816;
constexpr size_t O_Y = 0;
constexpr size_t O_RSP = (size_t)MT * D;
constexpr size_t RS_ONE = (size_t)16 * 4 * 256 * 512;
constexpr size_t O_RSS = O_RSP + 2 * RS_ONE;
constexpr size_t O_LATP = O_RSS + 2 * RS_ONE;
constexpr size_t O_KRP = O_LATP + (size_t)MP * 256;
constexpr size_t O_LATS = O_KRP + (size_t)MP * 64;
constexpr size_t O_KRS = O_LATS + (size_t)MS * 256;
constexpr size_t O_FKP = O_KRS + (size_t)MS * 64;
constexpr size_t O_FVP = O_FKP + (size_t)MP * 1024;
constexpr size_t O_FLP = O_FVP + (size_t)MP * 1024;
constexpr size_t O_FKS = O_FLP + (size_t)MP * 16;
constexpr size_t O_FVS = O_FKS + (size_t)MS * 1024;
constexpr size_t O_FLS = O_FVS + (size_t)MS * 1024;
constexpr size_t O_END = O_FLS + (size_t)MS * 16;
constexpr size_t MiB = (size_t)1 << 20;
constexpr size_t WS_W = 0, WS_HBA = 140 * MiB, WS_SSQ = 206 * MiB, WS_CQSS = 211 * MiB, WS_ROPE = 213 * MiB, WS_ROPEM = 216 * MiB, WS_FP = 217 * MiB, WS_FS = 219 * MiB + 512 * 1024, WS_POOL = 222 * MiB;
constexpr size_t WS_HBB = WS_POOL + 400 * MiB;
constexpr size_t WS_BAR = 212 * MiB;
constexpr size_t WS_NEED = WS_POOL + 628 * MiB;
constexpr size_t PL_RPROJ = WS_POOL, PL_ROBUF = WS_POOL + 470 * MiB;
constexpr size_t PL_ACT = WS_POOL, PL_PB = WS_POOL + 180 * MiB, PL_PP = WS_POOL + 200 * MiB;
constexpr size_t PL_LATB = WS_POOL, PL_KRB = WS_POOL + 33 * MiB, PL_CQB = WS_POOL + 42 * MiB, PL_KVH = WS_POOL + 76 * MiB, PL_MO = WS_POOL + 470 * MiB;
constexpr size_t PL_FPROJ = WS_POOL, PL_FKALL = WS_POOL + 260 * MiB, PL_FVALL = WS_POOL + 325 * MiB, PL_FO = WS_POOL + 470 * MiB;
constexpr size_t W_RI = 0, SZ_RI = (size_t)6144 * 1024;
constexpr size_t W_RO = W_RI + 2 * SZ_RI, SZ_RO = (size_t)1024 * 2048;
constexpr size_t W_MI = W_RO + 2 * SZ_RO;
constexpr size_t W_QB = W_MI + (size_t)1024 * 1024;
constexpr size_t W_KVB = W_QB + (size_t)3072 * 512;
constexpr size_t W_MO = W_KVB + (size_t)4096 * 256;
constexpr size_t W_FI = W_MO + (size_t)1024 * 2048;
constexpr size_t W_FO = W_FI + (size_t)4352 * 1024;
constexpr size_t W_GU = W_FO + (size_t)1024 * 1024, SZ_GU = (size_t)5632 * 1024;
constexpr size_t W_DN = W_GU + 4 * SZ_GU, SZ_DN = (size_t)1024 * 2816;
constexpr size_t W_PG = W_DN + 4 * SZ_DN, SZ_PG = (size_t)1024 * 1024;
constexpr size_t W_PP = W_PG + 4 * SZ_PG, SZ_PP = (size_t)1024 * 256;
constexpr size_t W_END = W_PP + 4 * SZ_PP;
static_assert(W_END * 2 <= 140 * MiB, "weights region");
constexpr int LDS_BYTES = 163840;
constexpr int XR_OFF = 131072;

struct Params { const float* in[37]; float* out; unsigned char* ws; int ph_lo, ph_hi; };
typedef const __attribute__((address_space(4))) Params* KP;
__device__ __forceinline__ KP kp() { KP p = (KP)__builtin_amdgcn_kernarg_segment_ptr(); asm volatile("" : "+s"(p)); return p; }
#define PIN(k) (kp()->in[k])
#define POUT (kp()->out)
#define PWS (kp()->ws)

typedef float f32x2 __attribute__((ext_vector_type(2)));
typedef __bf16 bf16x2n __attribute__((ext_vector_type(2)));
__device__ __forceinline__ unsigned pk2(float lo, float hi) { const f32x2 v = {lo, hi}; return __builtin_bit_cast(unsigned, __builtin_convertvector(v, bf16x2n)); }
__device__ __forceinline__ unsigned f2bf(float f) { return pk2(f, 0.f) & 0xffffu; }
__device__ __forceinline__ float bf2f(unsigned short h) { return __builtin_bit_cast(float, (unsigned)h << 16); }
__device__ __forceinline__ float bflo(unsigned u) { return __builtin_bit_cast(float, u << 16); }
__device__ __forceinline__ float bfhi(unsigned u) { return __builtin_bit_cast(float, u & 0xffff0000u); }
__device__ __forceinline__ u32x2 pk4(f32x4 v) { u32x2 r; r.x = pk2(v[0], v[1]); r.y = pk2(v[2], v[3]); return r; }
__device__ __forceinline__ f32x4 up4(u32x2 w) { return (f32x4){bflo(w.x), bfhi(w.x), bflo(w.y), bfhi(w.y)}; }
__device__ __forceinline__ float wave_sum(float v) {
#pragma unroll
    for (int o = 1; o < 64; o <<= 1) v += __shfl_xor(v, o);
    return v;
}
__device__ __forceinline__ float fq_sum(float v) { v += __shfl_xor(v, 16); v += __shfl_xor(v, 32); return v; }
__device__ __forceinline__ float sigmoidf_(float x) { return __builtin_amdgcn_rcpf(1.f + __expf(-x)); }
__device__ __forceinline__ float dot4(f32x4 v) { return (v[0] * v[0] + v[1] * v[1]) + (v[2] * v[2] + v[3] * v[3]); }
__device__ __forceinline__ void lds_barrier() { asm volatile("s_waitcnt lgkmcnt(0)" ::: "memory"); __builtin_amdgcn_s_barrier(); asm volatile("" ::: "memory"); }
__device__ __forceinline__ int tok_pos(int r) { return r < MP ? (r & (SEQ - 1)) : SEQ + ((r - MP) & (DEC - 1)); }
__device__ __forceinline__ int kv_row(int r) { return r < MP ? r : MP + ((r - MP) >> 5) * TKS + SEQ + ((r - MP) & 31); }
__device__ __forceinline__ float row_rstd(const float* ssq, int row, float invdim) {
    const f32x4 v = *(const f32x4*)(ssq + (size_t)row * 4);
    return rsqrtf(((v[0] + v[1]) + (v[2] + v[3])) * invdim + EPS);
}
#define EROW(u, ai, wr, m, fr) ((u).pm * 256 + (ai) * 128 + (wr) * 64 + (m) * 16 + (fr))
#define LROW(ai, wr, m, fr) ((ai) * 128 + (wr) * 64 + (m) * 16 + (fr))
#define ECOL(bj, wc, n, fq) ((bj) * 128 + (wc) * 32 + (n) * 16 + (fq) * 4)
typedef const f32x4 (&AccRef)[2][2][4][2];
#define EFENCE asm volatile("" ::: "memory")
#define RSV(ai, m) row_rstd(ssq, EROW(u, ai, wr, m, fr), 1.f / 1024.f)

struct EpiRetIn {
    static constexpr bool PERM = false, AFTER_DRAIN = false;
    const float* ssq; bf16_t* proj; const float* rope;
    __device__ __forceinline__ void operator()(AccRef acc, const Unit& u, int wr, int wc, int fr, int fq) const {
        float rs8[2][4];
#pragma unroll
        for (int ai = 0; ai < 2; ++ai)
#pragma unroll
            for (int m = 0; m < 4; ++m) rs8[ai][m] = row_rstd(ssq, EROW(u, ai, wr, m, fr), 1.f / 1024.f);
        const int pn = u.pn;
#pragma unroll
        for (int ai = 0; ai < 2; ++ai)
#pragma unroll
            for (int m = 0; m < 4; ++m) {
                const int r = EROW(u, ai, wr, m, fr); const float rs = rs8[ai][m];
                bf16_t* orow = proj + (size_t)r * 6144 + pn * 256 + wc * 32 + fq * 4;
                if (pn < 8) {
                    const float* tb = rope + (size_t)tok_pos(r) * 256 + wc * 32 + fq * 4; const float sc = pn >= 4 ? 0.0625f : 1.f;
#pragma unroll
                    for (int n = 0; n < 2; ++n) { const f32x4 c = *(const f32x4*)(tb + n * 16), s = *(const f32x4*)(tb + 128 + n * 16);
                        const f32x4 x1 = acc[ai][0][m][n] * rs, x2 = acc[ai][1][m][n] * rs;
                        *(u32x2*)(orow + n * 16) = pk4((x1 * c - x2 * s) * sc); *(u32x2*)(orow + 128 + n * 16) = pk4((x2 * c + x1 * s) * sc); }
                } else {
#pragma unroll
                    for (int bj = 0; bj < 2; ++bj)
#pragma unroll
                        for (int n = 0; n < 2; ++n) { f32x4 v = acc[ai][bj][m][n] * rs;
                            if (pn >= 16) { v[0] *= sigmoidf_(v[0]); v[1] *= sigmoidf_(v[1]); v[2] *= sigmoidf_(v[2]); v[3] *= sigmoidf_(v[3]); }
                            *(u32x2*)(orow + bj * 128 + n * 16) = pk4(v); }
                }
            }
    }
};
struct EpiRes {
    static constexpr bool PERM = false, AFTER_DRAIN = false;
    const bf16_t* hin; bf16_t* hout; float* ssqw; LAS float* xr;
    __device__ __forceinline__ void operator()(AccRef acc, const Unit& u, int wr, int wc, int fr, int fq) const {
        LAS float* const xq = xr + (wr * 64 + fr) * 4; LAS float* const xw = xq + wc;
#pragma unroll
        for (int ai = 0; ai < 2; ++ai) {
            u32x2 hv[4][2][2];
#pragma unroll
            for (int m = 0; m < 4; ++m) { const size_t off = (size_t)EROW(u, ai, wr, m, fr) * D + u.pn * 256 + wc * 32 + fq * 4;
#pragma unroll
                for (int bj = 0; bj < 2; ++bj)
#pragma unroll
                    for (int n = 0; n < 2; ++n) hv[m][bj][n] = *(const u32x2*)(hin + off + bj * 128 + n * 16); }
#pragma unroll
            for (int m = 0; m < 4; ++m) {
                const int r = EROW(u, ai, wr, m, fr); const size_t off = (size_t)r * D + u.pn * 256 + wc * 32 + fq * 4; float ss = 0.f;
#pragma unroll
                for (int bj = 0; bj < 2; ++bj)
#pragma unroll
                    for (int n = 0; n < 2; ++n) { const size_t o = off + bj * 128 + n * 16; const f32x4 v = up4(hv[m][bj][n]) + acc[ai][bj][m][n];
                        const u32x2 pw = pk4(v); *(u32x2*)(hout + o) = pw; ss += dot4(up4(pw)); }
                ss = fq_sum(ss); if (fq == 0) xw[(ai * 128 + m * 16) * 4] = ss; EFENCE;
            }
        }
        lds_barrier();
        if (wc == 0 && fq == 0) {
#pragma unroll
            for (int ai = 0; ai < 2; ++ai)
#pragma unroll
                for (int m = 0; m < 4; ++m) { const f32x4 t = *(const LAS f32x4*)(xq + (ai * 128 + m * 16) * 4); ssqw[(size_t)EROW(u, ai, wr, m, fr) * 4 + u.pn] = (t[0] + t[1]) + (t[2] + t[3]); }
        }
    }
};
struct EpiGU {
    static constexpr bool PERM = false, AFTER_DRAIN = false;
    const float* ssq; bf16_t* act;
    __device__ __forceinline__ void operator()(AccRef acc, const Unit& u, int wr, int wc, int fr, int fq) const {
        float rs8[2][4];
#pragma unroll
        for (int ai = 0; ai < 2; ++ai)
#pragma unroll
            for (int m = 0; m < 4; ++m) rs8[ai][m] = row_rstd(ssq, EROW(u, ai, wr, m, fr), 1.f / 1024.f);
#pragma unroll
        for (int ai = 0; ai < 2; ++ai)
#pragma unroll
            for (int m = 0; m < 4; ++m) {
                const int r = EROW(u, ai, wr, m, fr); const float rs = rs8[ai][m];
                bf16_t* orow = act + (size_t)r * DFF + u.pn * 128 + wc * 32 + fq * 4;
#pragma unroll
                for (int n = 0; n < 2; ++n) { const f32x4 g = acc[ai][0][m][n] * rs, up = acc[ai][1][m][n] * rs; f32x4 v;
                    v[0] = g[0] * sigmoidf_(g[0]) * up[0]; v[1] = g[1] * sigmoidf_(g[1]) * up[1]; v[2] = g[2] * sigmoidf_(g[2]) * up[2]; v[3] = g[3] * sigmoidf_(g[3]) * up[3];
                    *(u32x2*)(orow + n * 16) = pk4(v); }
            }
    }
};
struct EpiPlain {
    static constexpr bool PERM = false, AFTER_DRAIN = false;
    bf16_t* out; int ldc; const float* ssq; float invdim;
    __device__ __forceinline__ void operator()(AccRef acc, const Unit& u, int wr, int wc, int fr, int fq) const {
#pragma unroll
        for (int ai = 0; ai < 2; ++ai)
#pragma unroll
            for (int m = 0; m < 4; ++m) {
                const int r = EROW(u, ai, wr, m, fr); const float rs = ssq ? row_rstd(ssq, r, invdim) : 1.f;
                bf16_t* orow = out + (size_t)r * ldc + u.pn * 256 + wc * 32 + fq * 4;
#pragma unroll
                for (int bj = 0; bj < 2; ++bj)
#pragma unroll
                    for (int n = 0; n < 2; ++n) *(u32x2*)(orow + bj * 128 + n * 16) = pk4(acc[ai][bj][m][n] * rs);
            }
    }
};
struct EpiPE {
    static constexpr bool PERM = false, AFTER_DRAIN = false;
    const bf16_t* hin; const bf16_t* pp; bf16_t* hout; const float* ssq; float* ssqw; LAS float* xr;
    __device__ __forceinline__ void operator()(AccRef acc, const Unit& u, int wr, int wc, int fr, int fq) const {
        LAS float* const xq = xr + (wr * 64 + fr) * 4; LAS float* const xw = xq + wc;
        float rs8[2][4];
#pragma unroll
        for (int ai = 0; ai < 2; ++ai)
#pragma unroll
            for (int m = 0; m < 4; ++m) rs8[ai][m] = row_rstd(ssq, EROW(u, ai, wr, m, fr), 1.f / 1024.f);
#pragma unroll
        for (int ai = 0; ai < 2; ++ai)
#pragma unroll
            for (int mp = 0; mp < 2; ++mp) {
                u32x2 hv[2][2][2], pv[2][2][2];
#pragma unroll
                for (int mm = 0; mm < 2; ++mm) { const size_t off = (size_t)EROW(u, ai, wr, 2 * mp + mm, fr) * D + u.pn * 256 + wc * 32 + fq * 4;
#pragma unroll
                    for (int bj = 0; bj < 2; ++bj)
#pragma unroll
                        for (int n = 0; n < 2; ++n) { hv[mm][bj][n] = *(const u32x2*)(hin + off + bj * 128 + n * 16); pv[mm][bj][n] = *(const u32x2*)(pp + off + bj * 128 + n * 16); } }
#pragma unroll
                for (int mm = 0; mm < 2; ++mm) { const int m = 2 * mp + mm; const int r = EROW(u, ai, wr, m, fr); const float rs = rs8[ai][m];
                    const size_t off = (size_t)r * D + u.pn * 256 + wc * 32 + fq * 4; float ss = 0.f;
#pragma unroll
                    for (int bj = 0; bj < 2; ++bj)
#pragma unroll
                        for (int n = 0; n < 2; ++n) { const size_t o = off + bj * 128 + n * 16; const f32x4 a = acc[ai][bj][m][n] * rs; const u32x2 pw = pv[mm][bj][n];
                            f32x4 v = up4(hv[mm][bj][n]);
                            v[0] += sigmoidf_(a[0]) * bflo(pw.x); v[1] += sigmoidf_(a[1]) * bfhi(pw.x); v[2] += sigmoidf_(a[2]) * bflo(pw.y); v[3] += sigmoidf_(a[3]) * bfhi(pw.y);
                            const u32x2 ow = pk4(v); *(u32x2*)(hout + o) = ow; ss += dot4(up4(ow)); }
                    ss = fq_sum(ss); if (fq == 0) xw[(ai * 128 + m * 16) * 4] = ss; EFENCE; }
            }
        lds_barrier();
        if (wc == 0 && fq == 0) {
#pragma unroll
            for (int ai = 0; ai < 2; ++ai)
#pragma unroll
                for (int m = 0; m < 4; ++m) { const f32x4 t = *(const LAS f32x4*)(xq + (ai * 128 + m * 16) * 4); ssqw[(size_t)EROW(u, ai, wr, m, fr) * 4 + u.pn] = (t[0] + t[1]) + (t[2] + t[3]); }
        }
    }
};
struct EpiMlaIn {
    static constexpr bool PERM = false, AFTER_DRAIN = false;
    const float* ssq; unsigned char* ws; float* out; const float* kvn; const float* gkr; LAS float* xr;
    __device__ __forceinline__ void operator()(AccRef acc, const Unit& u, int wr, int wc, int fr, int fq) const {
        LAS float* const xq = xr + (wr * 64 + fr) * 4; LAS float* const xw = xq + wc;
        const int pn = u.pn;
        float rs8[2][4];
#pragma unroll
        for (int ai = 0; ai < 2; ++ai)
#pragma unroll
            for (int m = 0; m < 4; ++m) rs8[ai][m] = row_rstd(ssq, EROW(u, ai, wr, m, fr), 1.f / 1024.f);
        bf16_t* const cqb = (bf16_t*)(ws + PL_CQB); float* const cqss = (float*)(ws + WS_CQSS); bf16_t* const latb = (bf16_t*)(ws + PL_LATB); bf16_t* const krb = (bf16_t*)(ws + PL_KRB); const float* const ropem = (const float*)(ws + WS_ROPEM);
        if (pn < 2) {
#pragma unroll
            for (int ai = 0; ai < 2; ++ai)
#pragma unroll
                for (int m = 0; m < 4; ++m) { const int r = EROW(u, ai, wr, m, fr); bf16_t* orow = cqb + (size_t)r * 512 + pn * 256 + wc * 32 + fq * 4; float ss = 0.f;
#pragma unroll
                    for (int bj = 0; bj < 2; ++bj)
#pragma unroll
                        for (int n = 0; n < 2; ++n) { const f32x4 v = acc[ai][bj][m][n] * rs8[ai][m]; ss += dot4(v); *(u32x2*)(orow + bj * 128 + n * 16) = pk4(v); }
                    ss = fq_sum(ss); if (fq == 0) xw[(ai * 128 + m * 16) * 4] = ss; EFENCE; }
            lds_barrier();
            if (wc == 0 && fq == 0) {
#pragma unroll
                for (int ai = 0; ai < 2; ++ai)
#pragma unroll
                    for (int m = 0; m < 4; ++m) { const f32x4 t = *(const LAS f32x4*)(xq + (ai * 128 + m * 16) * 4); float* cp = cqss + (size_t)EROW(u, ai, wr, m, fr) * 4; cp[pn] = (t[0] + t[1]) + (t[2] + t[3]); cp[2 + pn] = 0.f; }
            }
        } else if (pn == 2) {
#pragma unroll
            for (int ai = 0; ai < 2; ++ai)
#pragma unroll
                for (int m = 0; m < 4; ++m) { float ss = 0.f;
#pragma unroll
                    for (int bj = 0; bj < 2; ++bj)
#pragma unroll
                        for (int n = 0; n < 2; ++n) ss += dot4(acc[ai][bj][m][n] * rs8[ai][m]);
                    ss = fq_sum(ss); if (fq == 0) xw[(ai * 128 + m * 16) * 4] = ss; EFENCE; }
            lds_barrier();
#pragma unroll
            for (int ai = 0; ai < 2; ++ai)
#pragma unroll
                for (int m = 0; m < 4; ++m) { const int r = EROW(u, ai, wr, m, fr); const f32x4 t = *(const LAS f32x4*)(xq + (ai * 128 + m * 16) * 4);
                    const float rk = rsqrtf(((t[0] + t[1]) + (t[2] + t[3])) * (1.f / 256.f) + EPS) * rs8[ai][m];
                    float* o32 = (r < MP ? out + O_LATP + (size_t)r * 256 : out + O_LATS + (size_t)(r - MP) * 256) + wc * 32 + fq * 4;
                    bf16_t* o16 = latb + (size_t)kv_row(r) * 256 + wc * 32 + fq * 4;
#pragma unroll
                    for (int bj = 0; bj < 2; ++bj)
#pragma unroll
                        for (int n = 0; n < 2; ++n) { const f32x4 g = *(const f32x4*)(kvn + ECOL(bj, wc, n, fq)); const f32x4 v = acc[ai][bj][m][n] * rk * g;
                            *(f32x4*)(o32 + bj * 128 + n * 16) = v; *(u32x2*)(o16 + bj * 128 + n * 16) = pk4(v); } EFENCE; }
        } else if (wc == 0) {
#pragma unroll
            for (int ai = 0; ai < 2; ++ai)
#pragma unroll
                for (int m = 0; m < 4; ++m) { const int r = EROW(u, ai, wr, m, fr); float ss = 0.f;
#pragma unroll
                    for (int n = 0; n < 2; ++n) ss += dot4(acc[ai][0][m][n] * rs8[ai][m]) + dot4(acc[ai][1][m][n] * rs8[ai][m]);
                    ss = fq_sum(ss); const float rk = rsqrtf(ss * (1.f / 64.f) + EPS) * rs8[ai][m];
                    const float* tb = ropem + (size_t)tok_pos(r) * 64 + fq * 4;
                    float* o32 = (r < MP ? out + O_KRP + (size_t)r * 64 : out + O_KRS + (size_t)(r - MP) * 64) + fq * 4;
                    bf16_t* o16 = krb + (size_t)kv_row(r) * 64 + fq * 4;
#pragma unroll
                    for (int n = 0; n < 2; ++n) { const f32x4 g1 = *(const f32x4*)(gkr + n * 16 + fq * 4), g2 = *(const f32x4*)(gkr + 32 + n * 16 + fq * 4);
                        const f32x4 c = *(const f32x4*)(tb + n * 16), s = *(const f32x4*)(tb + 32 + n * 16);
                        const f32x4 y1 = acc[ai][0][m][n] * rk * g1, y2 = acc[ai][1][m][n] * rk * g2; const f32x4 z1 = y1 * c - y2 * s, z2 = y2 * c + y1 * s;
                        *(f32x4*)(o32 + n * 16) = z1; *(f32x4*)(o32 + 32 + n * 16) = z2; *(u32x2*)(o16 + n * 16) = pk4(z1); *(u32x2*)(o16 + 32 + n * 16) = pk4(z2); } EFENCE; }
        }
    }
};
struct EpiKV {
    static constexpr bool PERM = false, AFTER_DRAIN = false;
    bf16_t* kvh; LAS float* xr;
    __device__ __forceinline__ void operator()(AccRef acc, const Unit& u, int wr, int wc, int fr, int fq) const {
        LAS float* const xq = xr + (wr * 64 + fr) * 4; LAS float* const xw = xq + wc;
#pragma unroll
        for (int ai = 0; ai < 2; ++ai)
#pragma unroll
            for (int m = 0; m < 4; ++m) { float ss = dot4(acc[ai][0][m][0]) + dot4(acc[ai][0][m][1]); ss = fq_sum(ss); if (fq == 0) xw[(ai * 128 + m * 16) * 4] = ss; EFENCE; }
        lds_barrier();
#pragma unroll
        for (int ai = 0; ai < 2; ++ai)
#pragma unroll
            for (int m = 0; m < 4; ++m) { const int r = EROW(u, ai, wr, m, fr); const f32x4 t = *(const LAS f32x4*)(xq + (ai * 128 + m * 16) * 4);
                const float rk = rsqrtf(((t[0] + t[1]) + (t[2] + t[3])) * (1.f / 128.f) + EPS);
                bf16_t* orow = kvh + (size_t)r * 2048 + u.pn * 256 + wc * 32 + fq * 4;
#pragma unroll
                for (int n = 0; n < 2; ++n) { *(u32x2*)(orow + n * 16) = pk4(acc[ai][0][m][n] * rk); *(u32x2*)(orow + 128 + n * 16) = pk4(acc[ai][1][m][n]); } }
    }
};
struct EpiFoxIn {
    static constexpr bool PERM = false, AFTER_DRAIN = false;
    const float* ssq; unsigned char* ws; float* out; const float* gq; const float* gk; const float* bf; LAS float* xr;
    __device__ __forceinline__ void operator()(AccRef acc, const Unit& u, int wr, int wc, int fr, int fq) const {
        LAS float* const xq = xr + (wr * 64 + fr) * 4; LAS float* const xw = xq + wc;
        const int pn = u.pn;
        float rs8[2][4];
#pragma unroll
        for (int ai = 0; ai < 2; ++ai)
#pragma unroll
            for (int m = 0; m < 4; ++m) rs8[ai][m] = row_rstd(ssq, EROW(u, ai, wr, m, fr), 1.f / 1024.f);
        bf16_t* const proj = (bf16_t*)(ws + PL_FPROJ); bf16_t* const kall = (bf16_t*)(ws + PL_FKALL); bf16_t* const vall = (bf16_t*)(ws + PL_FVALL);
        if (pn < 8) {
#pragma unroll
            for (int ai = 0; ai < 2; ++ai)
#pragma unroll
                for (int m = 0; m < 4; ++m)
#pragma unroll
                    for (int bj = 0; bj < 2; ++bj) { float ss = dot4(acc[ai][bj][m][0] * rs8[ai][m]) + dot4(acc[ai][bj][m][1] * rs8[ai][m]); ss = fq_sum(ss);
                        if (fq == 0) xw[bj * 1024 + (ai * 128 + m * 16) * 4] = ss; EFENCE; }
            lds_barrier();
            const float* gg = pn < 4 ? gq : gk;
#pragma unroll
            for (int ai = 0; ai < 2; ++ai)
#pragma unroll
                for (int m = 0; m < 4; ++m) { const int r = EROW(u, ai, wr, m, fr);
#pragma unroll
                    for (int bj = 0; bj < 2; ++bj) { const f32x4 t = *(const LAS f32x4*)(xq + bj * 1024 + (ai * 128 + m * 16) * 4);
                        const float hs = wc < 2 ? t[0] + t[1] : t[2] + t[3]; const float rk = rsqrtf(hs * (1.f / 64.f) + EPS) * rs8[ai][m];
#pragma unroll
                        for (int n = 0; n < 2; ++n) { const f32x4 g = *(const f32x4*)(gg + (wc & 1) * 32 + n * 16 + fq * 4); const f32x4 v = acc[ai][bj][m][n] * rk * g;
                            const int ct = pn * 256 + ECOL(bj, wc, n, fq);
                            if (pn < 4) *(u32x2*)(proj + (size_t)r * 4096 + ct) = pk4(v);
                            else { const int ck = ct - 1024;
                                if (r < MP) { *(f32x4*)(out + O_FKP + (size_t)r * 1024 + ck) = v; *(u32x2*)(proj + (size_t)r * 4096 + ct) = pk4(v); }
                                else { const int rsm = r - MP; *(f32x4*)(out + O_FKS + (size_t)rsm * 1024 + ck) = v; *(u32x2*)(kall + ((size_t)(rsm >> 5) * TKS + SEQ + (rsm & 31)) * 1024 + ck) = pk4(v); } } } EFENCE; } }
        } else if (pn < 16) {
#pragma unroll
            for (int ai = 0; ai < 2; ++ai)
#pragma unroll
                for (int m = 0; m < 4; ++m) { const int r = EROW(u, ai, wr, m, fr);
#pragma unroll
                    for (int bj = 0; bj < 2; ++bj)
#pragma unroll
                        for (int n = 0; n < 2; ++n) { f32x4 v = acc[ai][bj][m][n] * rs8[ai][m]; const int ct = pn * 256 + ECOL(bj, wc, n, fq);
                            if (pn < 12) { const int cv = ct - 2048;
                                if (r < MP) { *(f32x4*)(out + O_FVP + (size_t)r * 1024 + cv) = v; *(u32x2*)(proj + (size_t)r * 4096 + ct) = pk4(v); }
                                else { const int rsm = r - MP; *(f32x4*)(out + O_FVS + (size_t)rsm * 1024 + cv) = v; *(u32x2*)(vall + ((size_t)(rsm >> 5) * TKS + SEQ + (rsm & 31)) * 1024 + cv) = pk4(v); } }
                            else { v[0] = sigmoidf_(v[0]); v[1] = sigmoidf_(v[1]); v[2] = sigmoidf_(v[2]); v[3] = sigmoidf_(v[3]); *(u32x2*)(proj + (size_t)r * 4096 + ct) = pk4(v); } } EFENCE; }
        } else if (wc == 0) {
            const f32x4 b = *(const f32x4*)(bf + fq * 4);
#pragma unroll
            for (int ai = 0; ai < 2; ++ai)
#pragma unroll
                for (int m = 0; m < 4; ++m) { const int r = EROW(u, ai, wr, m, fr); const f32x4 x = acc[ai][0][m][0] * rs8[ai][m] + b; f32x4 v;
#pragma unroll
                    for (int e = 0; e < 4; ++e) v[e] = fminf(x[e], 0.f) - log1pf(__expf(-fabsf(x[e])));
                    float* o = (r < MP ? out + O_FLP + (size_t)r * 16 : out + O_FLS + (size_t)(r - MP) * 16) + fq * 4; *(f32x4*)o = v; }
        }
    }
};

struct WJob { const float* src; const float* src2; const float* gain; bf16_t* dst; int K, Nsrc, Ndst, map; };
__device__ __forceinline__ WJob get_job(int j) {
    bf16_t* W = (bf16_t*)(PWS + WS_W); WJob J; J.src2 = nullptr; J.gain = nullptr; J.map = 0;
    if (j < 2)       { J.src = PIN(14) + (size_t)j * 1024 * 6144; J.gain = PIN(10) + (size_t)(3 * j) * 1024; J.K = 1024; J.Nsrc = 6144; J.Ndst = 6144; J.dst = W + W_RI + j * SZ_RI; }
    else if (j < 4)  { const int i = j - 2; J.src = PIN(16) + (size_t)i * 2048 * 1024; J.K = 2048; J.Nsrc = 1024; J.Ndst = 1024; J.dst = W + W_RO + i * SZ_RO; }
    else if (j == 4) { J.src = PIN(17); J.gain = PIN(10) + 1024; J.K = 1024; J.Nsrc = 832; J.Ndst = 1024; J.map = 1; J.dst = W + W_MI; }
    else if (j == 5) { J.src = PIN(20); J.gain = PIN(18); J.K = 512; J.Nsrc = 3072; J.Ndst = 3072; J.dst = W + W_QB; }
    else if (j == 6) { J.src = PIN(21); J.K = 256; J.Nsrc = 4096; J.Ndst = 4096; J.dst = W + W_KVB; }
    else if (j == 7) { J.src = PIN(26); J.K = 2048; J.Nsrc = 1024; J.Ndst = 1024; J.dst = W + W_MO; }
    else if (j == 8) { J.src = PIN(27); J.gain = PIN(10) + 2048; J.K = 1024; J.Nsrc = 4112; J.Ndst = 4352; J.dst = W + W_FI; }
    else if (j == 9) { J.src = PIN(31); J.K = 1024; J.Nsrc = 1024; J.Ndst = 1024; J.dst = W + W_FO; }
    else if (j < 14) { const int i = j - 10; J.src = PIN(32) + (size_t)i * 1024 * DFF; J.src2 = PIN(33) + (size_t)i * 1024 * DFF; J.gain = PIN(11) + (size_t)i * 1024; J.K = 1024; J.Nsrc = DFF; J.Ndst = 5632; J.map = 2; J.dst = W + W_GU + i * SZ_GU; }
    else if (j < 18) { const int i = j - 14; J.src = PIN(34) + (size_t)i * DFF * 1024; J.K = DFF; J.Nsrc = 1024; J.Ndst = 1024; J.dst = W + W_DN + i * SZ_DN; }
    else if (j < 22) { const int i = j - 18; J.src = PIN(36) + (size_t)i * 1024 * 1024; J.gain = PIN(12) + (size_t)i * 1024; J.K = 1024; J.Nsrc = 1024; J.Ndst = 1024; J.dst = W + W_PG + i * SZ_PG; }
    else             { const int i = j - 22; J.src = PIN(35) + (size_t)i * 256 * 1024; J.K = 256; J.Nsrc = 1024; J.Ndst = 1024; J.dst = W + W_PP + i * SZ_PP; }
    return J;
}
__device__ __forceinline__ void wt_item2(const WJob& J, LAS float* scr, int itemA, int itemB, bool hasB, int lane) {
    const int nblk = J.Ndst / 32; int k0[2], n0[2]; const float* sp[2]; int col[2];
#pragma unroll
    for (int q = 0; q < 2; ++q) { const int item = q ? (hasB ? itemB : itemA) : itemA; const int kb = item / nblk, nb = item % nblk; k0[q] = 64 * kb; n0[q] = 32 * nb;
        const int n = n0[q] + (lane & 31); sp[q] = nullptr; col[q] = 0;
        if (J.map == 0) { if (n < J.Nsrc) { sp[q] = J.src; col[q] = n; } }
        else if (J.map == 1) { if (n < 768) { sp[q] = J.src; col[q] = n; } else { const int c = n - 768; if (c < 32) { sp[q] = J.src; col[q] = 768 + c; } else if (c >= 128 && c < 160) { sp[q] = J.src; col[q] = 800 + (c - 128); } } }
        else { const int pn = n >> 8, c = n & 255; if (c < 128) { sp[q] = J.src; col[q] = pn * 128 + c; } else { sp[q] = J.src2; col[q] = pn * 128 + c - 128; } } }
    float v[2][32];
#pragma unroll
    for (int q = 0; q < 2; ++q)
#pragma unroll
        for (int i = 0; i < 32; ++i) { const int kk = 2 * i + (lane >> 5); float x = sp[q] ? sp[q][(size_t)(k0[q] + kk) * J.Nsrc + col[q]] : 0.f; if (J.gain) x *= J.gain[k0[q] + kk]; v[q][i] = x; }
#pragma unroll
    for (int q = 0; q < 2; ++q)
#pragma unroll
        for (int i = 0; i < 32; ++i) { const int kk = 2 * i + (lane >> 5); scr[q * 2112 + kk * 33 + (lane & 31)] = v[q][i]; }
    asm volatile("s_waitcnt lgkmcnt(0)" ::: "memory");
    const int c = lane & 7;
#pragma unroll
    for (int q = 0; q < 2; ++q) { if (q == 0 || hasB) {
#pragma unroll
        for (int j = 0; j < 4; ++j) { const int nn = (lane >> 3) + 8 * j; const LAS float* s = scr + q * 2112 + (8 * c) * 33 + nn;
            u32x4 o; o.x = pk2(s[0 * 33], s[1 * 33]); o.y = pk2(s[2 * 33], s[3 * 33]); o.z = pk2(s[4 * 33], s[5 * 33]); o.w = pk2(s[6 * 33], s[7 * 33]);
            *(u32x4*)(J.dst + (size_t)(n0[q] + nn) * J.K + k0[q] + 8 * c) = o; } } }
    asm volatile("s_waitcnt lgkmcnt(0)" ::: "memory");
}
__device__ __forceinline__ void phase_prologue(LAS unsigned char* lds) {
    int tid_o = threadIdx.x; asm volatile("" : "+v"(tid_o)); const int tid = tid_o, lane = tid & 63, wave = __builtin_amdgcn_readfirstlane(tid >> 6);
    const int gw = blockIdx.x * 8 + wave, NGW = gridDim.x * 8;
    LAS float* scr = (LAS float*)(lds + wave * 17408);
    int base = 0;
    for (int j = 0; j < 26; ++j) { const WJob J = get_job(j); const int cnt = (J.K / 64) * (J.Ndst / 32);
        int first = (gw - base) % NGW; if (first < 0) first += NGW;
        for (int it = first; it < cnt; it += 2 * NGW) wt_item2(J, scr, it, it + NGW, it + NGW < cnt, lane);
        base += cnt; }
    { float* tr = (float*)(PWS + WS_ROPE); float* tm = (float*)(PWS + WS_ROPEM); const int gt = blockIdx.x * 512 + tid, NT = gridDim.x * 512;
        for (int i = gt; i < TKS * 128 + TKS * 32; i += NT) {
            int pos, j, half; if (i < TKS * 128) { pos = i >> 7; j = i & 127; half = 128; } else { const int k = i - TKS * 128; pos = k >> 5; j = k & 31; half = 32; }
            const float inv = exp2f(-(float)j / (float)half * 13.287712379549449f);
            const float ang = (float)pos * inv; double rev = (double)ang * 0.15915494309189535; rev -= floor(rev); const float rf = (float)rev;
            const float c = __builtin_amdgcn_cosf(rf), s = __builtin_amdgcn_sinf(rf);
            if (half == 128) { tr[(size_t)pos * 256 + j] = c; tr[(size_t)pos * 256 + 128 + j] = s; } else { tm[(size_t)pos * 64 + j] = c; tm[(size_t)pos * 64 + 32 + j] = s; } } }
    { bf16_t* hb = (bf16_t*)(PWS + WS_HBB); float* ssq = (float*)(PWS + WS_SSQ);
        for (int r = gw; r < MT; r += NGW) { const float* x = r < MP ? PIN(0) + (size_t)r * D : PIN(1) + (size_t)(r - MP) * D; float s = 0.f;
#pragma unroll
            for (int j = 0; j < 4; ++j) { const f32x4 v = *(const f32x4*)(x + (lane + 64 * j) * 4); const u32x2 pw = pk4(v); *(u32x2*)(hb + (size_t)r * D + (lane + 64 * j) * 4) = pw; s += dot4(up4(pw)); }
            s = wave_sum(s); if (lane < 4) ssq[(size_t)r * 4 + lane] = lane == 0 ? s : 0.f; } }
}
__device__ __forceinline__ void cvt_chunks(const float* __restrict__ src, bf16_t* __restrict__ dst, size_t n8) {
    int tid_o = threadIdx.x; asm volatile("" : "+v"(tid_o)); const size_t gt = (size_t)blockIdx.x * 512 + tid_o, NT = (size_t)gridDim.x * 512;

    for (size_t i = gt; i < n8; i += NT) { const f32x4 a = *(const f32x4*)(src + i * 8), b = *(const f32x4*)(src + i * 8 + 4); u32x4 o; o.x = pk2(a[0], a[1]); o.y = pk2(a[2], a[3]); o.z = pk2(b[0], b[1]); o.w = pk2(b[2], b[3]); *(u32x4*)(dst + i * 8) = o; }
}
template <int width> __device__ __forceinline__ void cvt_cache(const float* __restrict__ src, bf16_t* __restrict__ dst) {
    constexpr int cpr = width / 8; const size_t n8 = (size_t)16 * 2048 * cpr;
    int tid_o = threadIdx.x; asm volatile("" : "+v"(tid_o)); const size_t gt = (size_t)blockIdx.x * 512 + tid_o, NT = (size_t)gridDim.x * 512;

    for (size_t i = gt; i < n8; i += NT) { const size_t row = i / cpr; const int ch = (int)(i % cpr); const size_t b = row >> 11, t = row & 2047;
        const float* s = src + row * width + ch * 8; const f32x4 a = *(const f32x4*)s, c = *(const f32x4*)(s + 4); u32x4 o; o.x = pk2(a[0], a[1]); o.y = pk2(a[2], a[3]); o.z = pk2(c[0], c[1]); o.w = pk2(c[2], c[3]);
        *(u32x4*)(dst + (b * TKS + t) * width + ch * 8) = o; }
}

struct AU { const bf16_t* Q; int qs; const bf16_t* K1; int k1s; const bf16_t* K2; int k2s; const bf16_t* V; int vs; bf16_t* O; int os; const bf16_t* G; int gs; const float* Fk;
            int q0, nq, off, Tk; };
struct MlaQ { const float* gqn; const float* gkn; const float* gqr; const float* ropem; };
template <int DK, int DV, int MODE>
__device__ __forceinline__ void attn_unit(LAS unsigned char* lds, const AU& a, const MlaQ& mq) {
    constexpr int KS = (DK + 8) * 2, VS = (DV + 16) * 2  , NS = DK / 32, NDB = DV / 16, KC = DK / 8, VC = DV / 8, KCH = 64 * KC / 512, VCH = 64 * VC / 512;
    constexpr int VOFF = 64 * KS, FOFF = VOFF + 64 * VS;
    int tid_o = threadIdx.x; asm volatile("" : "+v"(tid_o)); const int tid = tid_o, w = __builtin_amdgcn_readfirstlane(tid >> 6), lane = tid & 63, li = lane & 15, g = lane >> 4;
    const float cs = (MODE == 0 ? 0.07216878364870322f : 0.125f) * LOG2E;
    const bool active = 32 * w < a.nq;
    const int wq0 = a.q0 + 32 * w, rmax = a.q0 + a.nq - 1;
    bf16x8 qf[2][NS];
#pragma unroll
    for (int blk = 0; blk < 2; ++blk) { int row = wq0 + 16 * blk + li; row = row < rmax ? row : rmax; const bf16_t* qp = a.Q + (size_t)row * a.qs + 8 * g;
#pragma unroll
        for (int s = 0; s < NS; ++s) qf[blk][s] = *(const bf16x8*)(qp + 32 * s);
        if (MODE == 0) {
            float x[NS][8];
#pragma unroll
            for (int s = 0; s < NS; ++s)
#pragma unroll
                for (int j = 0; j < 8; ++j) x[s][j] = bf2f((unsigned short)qf[blk][s][j]);
            float ss = 0.f;
#pragma unroll
            for (int s = 0; s < 4; ++s)
#pragma unroll
                for (int j = 0; j < 8; ++j) ss += x[s][j] * x[s][j];
            ss = fq_sum(ss); const float rn = rsqrtf(ss * (1.f / 128.f) + EPS);
#pragma unroll
            for (int s = 0; s < 4; ++s)
{ const f32x4 ga = *(const f32x4*)(mq.gqn + 32 * s + 8 * g), gb = *(const f32x4*)(mq.gqn + 32 * s + 8 * g + 4), ha = *(const f32x4*)(mq.gkn + 32 * s + 8 * g), hb_ = *(const f32x4*)(mq.gkn + 32 * s + 8 * g + 4);
#pragma unroll
                  for (int j = 0; j < 4; ++j) { x[s][j] *= rn * ga[j] * ha[j]; x[s][4 + j] *= rn * gb[j] * hb_[j]; } }
            float sr = 0.f;
#pragma unroll
            for (int j = 0; j < 8; ++j) sr += x[4][j] * x[4][j] + x[5][j] * x[5][j];
            sr = fq_sum(sr); const float rr = rsqrtf(sr * (1.f / 64.f) + EPS);
            const float* tb = mq.ropem + (size_t)(a.off + row) * 64;
#pragma unroll
            for (int j = 0; j < 8; ++j) { const int dj = 8 * g + j; const float y1 = x[4][j] * rr * mq.gqr[dj], y2 = x[5][j] * rr * mq.gqr[32 + dj]; const float c = tb[dj], s = tb[32 + dj];
                x[4][j] = y1 * c - y2 * s; x[5][j] = y2 * c + y1 * s; }
#pragma unroll
            for (int s = 0; s < NS; ++s)
#pragma unroll
                for (int j = 0; j < 8; ++j) qf[blk][s][j] = (short)f2bf(x[s][j]);
        }
    }
    constexpr int QOFF = ((FOFF + 256 + 15) / 16) * 16;
    LAS unsigned char* qlds = lds + QOFF + w * (2 * NS * 1024) + lane * 16;
    if (MODE == 0) {
#pragma unroll
        for (int blk = 0; blk < 2; ++blk)
#pragma unroll
            for (int s = 0; s < NS; ++s) *(LAS bf16x8*)(qlds + (blk * NS + s) * 1024) = qf[blk][s];
    }
    const int last_pos = a.off + a.q0 + a.nq - 1;
    const int kend = MODE == 0 ? (((last_pos >> 6) + 1) * 64 < a.Tk ? ((last_pos >> 6) + 1) * 64 : a.Tk) : last_pos + 1;
    const int nt = (kend + 63) >> 6;
    f32x4 o[2][NDB]; float mrow[2], lrow[2];
#pragma unroll
    for (int blk = 0; blk < 2; ++blk) { mrow[blk] = -INFINITY; lrow[blk] = 0.f;
#pragma unroll
        for (int db = 0; db < NDB; ++db) o[blk][db] = (f32x4){0.f, 0.f, 0.f, 0.f}; }
    u32x4 kreg[2][KCH], vreg[2][VCH]; float freg[2] = {0.f, 0.f};
#define ATT_PREFETCH(t, P_) do { \
        _Pragma("unroll") for (int c_ = 0; c_ < KCH; ++c_) { const int id = tid + 512 * c_, key = id / KC, ch = id % KC; int kr_ = 64 * (t) + key; kr_ = kr_ < a.Tk ? kr_ : a.Tk - 1; \
            const bf16_t* p_ = (MODE == 0 && ch >= 16) ? a.K2 + (size_t)kr_ * a.k2s + (ch - 16) * 8 : a.K1 + (size_t)kr_ * a.k1s + ch * 8; kreg[P_][c_] = *(const u32x4*)p_; } \
        _Pragma("unroll") for (int c_ = 0; c_ < VCH; ++c_) { const int id = tid + 512 * c_, key = id / VC, ch = id % VC; int kr_ = 64 * (t) + key; kr_ = kr_ < a.Tk ? kr_ : a.Tk - 1; \
            vreg[P_][c_] = *(const u32x4*)(a.V + (size_t)kr_ * a.vs + ch * 8); } \
        if (MODE == 1) { int kr_ = 64 * (t) + (tid & 63); kr_ = kr_ < a.Tk ? kr_ : a.Tk - 1; freg[P_] = a.Fk[kr_]; } } while (0)
    ATT_PREFETCH(0, 0); if (nt > 1) ATT_PREFETCH(1, 1);
    const int wlo = a.off + wq0, whi = wlo + 31;
    for (int t0 = 0; t0 < nt; t0 += 2) {
#pragma unroll
      for (int P = 0; P < 2; ++P) { const int t = t0 + P; if (t < nt) {
        lds_barrier();
#pragma unroll
        for (int c_ = 0; c_ < KCH; ++c_) { const int id = tid + 512 * c_, key = id / KC, ch = id % KC; *(LAS u32x4*)(lds + key * KS + ch * 16) = kreg[P][c_]; }
#pragma unroll
        for (int c_ = 0; c_ < VCH; ++c_) { const int id = tid + 512 * c_, key = id / VC, ch = id % VC; *(LAS u32x4*)(lds + VOFF + key * VS + ch * 16) = vreg[P][c_]; }
        if (MODE == 1 && tid < 64) *(LAS float*)(lds + FOFF + tid * 4) = freg[P];
        lds_barrier();
        if (t + 2 < nt) ATT_PREFETCH(t + 2, P);
        const bool skip = !active || (MODE == 0 ? (t > (whi >> 6)) : (64 * t > whi));
        if (!skip) {
            const bool needmask = __builtin_amdgcn_readfirstlane((int)((MODE == 1 && 64 * t + 63 > wlo) || (64 * t + 63 >= a.Tk))) != 0;
            f32x4 sa[2][4];
#pragma unroll
            for (int blk = 0; blk < 2; ++blk)
#pragma unroll
                for (int kb = 0; kb < 4; ++kb) sa[blk][kb] = (f32x4){0.f, 0.f, 0.f, 0.f};
            if (MODE == 0) {
#pragma unroll
                for (int s = 0; s < NS; ++s) { const bf16x8 q0 = *(const LAS bf16x8*)(qlds + s * 1024), q1 = *(const LAS bf16x8*)(qlds + (NS + s) * 1024);
#pragma unroll
                    for (int kb = 0; kb < 4; ++kb) { const bf16x8 kf = *(const LAS bf16x8*)(lds + (16 * kb + li) * KS + (32 * s + 8 * g) * 2);
                        sa[0][kb] = __builtin_amdgcn_mfma_f32_16x16x32_bf16(kf, q0, sa[0][kb], 0, 0, 0);
                        sa[1][kb] = __builtin_amdgcn_mfma_f32_16x16x32_bf16(kf, q1, sa[1][kb], 0, 0, 0); }
                    }
            } else {
#pragma unroll
                for (int kb = 0; kb < 4; ++kb)
#pragma unroll
                    for (int s = 0; s < NS; ++s) { const bf16x8 kf = *(const LAS bf16x8*)(lds + (16 * kb + li) * KS + (32 * s + 8 * g) * 2);
                        sa[0][kb] = __builtin_amdgcn_mfma_f32_16x16x32_bf16(kf, qf[0][s], sa[0][kb], 0, 0, 0);
                        sa[1][kb] = __builtin_amdgcn_mfma_f32_16x16x32_bf16(kf, qf[1][s], sa[1][kb], 0, 0, 0); }
            }
            bf16x8 pf[2][2];
#pragma unroll
            for (int kb = 0; kb < 4; ++kb) { f32x4 fk = (f32x4){0.f, 0.f, 0.f, 0.f}; if (MODE == 1) fk = *(const LAS f32x4*)(lds + FOFF + (16 * kb + 4 * g) * 4);
                sa[0][kb] = sa[0][kb] * cs - fk; sa[1][kb] = sa[1][kb] * cs - fk; }
            if (needmask) {
#pragma unroll
                for (int blk = 0; blk < 2; ++blk) { const int pos = wlo + 16 * blk + li;
#pragma unroll
                    for (int kb = 0; kb < 4; ++kb)
#pragma unroll
                        for (int i = 0; i < 4; ++i) { const int key = 64 * t + 16 * kb + 4 * g + i; const bool ok = key < a.Tk && (MODE == 0 ? ((key >> 6) <= (pos >> 6)) : (key <= pos)); sa[blk][kb][i] = ok ? sa[blk][kb][i] : -INFINITY; } }
            }
#pragma unroll
            for (int blk = 0; blk < 2; ++blk) {
                float mx = -INFINITY;
#pragma unroll
                for (int kb = 0; kb < 4; ++kb)
#pragma unroll
                    for (int i = 0; i < 4; ++i) mx = fmaxf(mx, sa[blk][kb][i]);
                mx = fmaxf(mx, __shfl_xor(mx, 16)); mx = fmaxf(mx, __shfl_xor(mx, 32));
                const float mnew = fmaxf(mrow[blk], mx); float rsum = 0.f;
                if (__builtin_amdgcn_ballot_w64(mnew > mrow[blk]) != 0ull) {
                    const float alpha = __builtin_amdgcn_exp2f(mrow[blk] - mnew); mrow[blk] = mnew; lrow[blk] *= alpha;
#pragma unroll
                    for (int db = 0; db < NDB; ++db) o[blk][db] = o[blk][db] * alpha;
                }
#pragma unroll
                for (int kb = 0; kb < 4; ++kb)
#pragma unroll
                    for (int i = 0; i < 4; ++i) { const float p = __builtin_amdgcn_exp2f(sa[blk][kb][i] - mnew); sa[blk][kb][i] = p; rsum += p; }
                lrow[blk] += rsum;
#pragma unroll
                for (int kk = 0; kk < 2; ++kk) { const f32x4 p0 = sa[blk][2 * kk], p1 = sa[blk][2 * kk + 1]; u32x4 pw; pw.x = pk2(p0[0], p0[1]); pw.y = pk2(p0[2], p0[3]); pw.z = pk2(p1[0], p1[1]); pw.w = pk2(p1[2], p1[3]);
                    pf[blk][kk] = __builtin_bit_cast(bf16x8, pw); }
            }
#pragma unroll
            for (int kk = 0; kk < 2; ++kk)
#pragma unroll
                for (int db = 0; db < NDB; ++db) {
                    const unsigned ad = VOFF + (32 * kk + 4 * g + (li >> 2)) * VS + (16 * db + 4 * (li & 3)) * 2;
                    const s16x4 v0 = __builtin_amdgcn_ds_read_tr16_b64_v4i16((LAS s16x4*)(lds + ad)), v1 = __builtin_amdgcn_ds_read_tr16_b64_v4i16((LAS s16x4*)(lds + ad + 16 * VS));
                    bf16x8 vf; vf[0] = v0[0]; vf[1] = v0[1]; vf[2] = v0[2]; vf[3] = v0[3]; vf[4] = v1[0]; vf[5] = v1[1]; vf[6] = v1[2]; vf[7] = v1[3];
                    o[0][db] = __builtin_amdgcn_mfma_f32_16x16x32_bf16(vf, pf[0][kk], o[0][db], 0, 0, 0);
                    o[1][db] = __builtin_amdgcn_mfma_f32_16x16x32_bf16(vf, pf[1][kk], o[1][db], 0, 0, 0);  }
        }
      } }
    }
#undef ATT_PREFETCH
    if (active) {
#pragma unroll
        for (int blk = 0; blk < 2; ++blk) { const int rl = 32 * w + 16 * blk + li; const float inv = 1.f / fq_sum(lrow[blk]);
            if (rl < a.nq) { const size_t row = (size_t)(a.q0 + rl);
                u32x2 gw[NDB];
#pragma unroll
                for (int db = 0; db < NDB; ++db) { gw[db] = (u32x2){0u, 0u}; if (MODE == 1) gw[db] = *(const u32x2*)(a.G + row * a.gs + 16 * db + 4 * g); }
#pragma unroll
                for (int db = 0; db < NDB; ++db) { f32x4 v = o[blk][db] * inv;
                    if (MODE == 1) { v[0] *= bflo(gw[db].x); v[1] *= bfhi(gw[db].x); v[2] *= bflo(gw[db].y); v[3] *= bfhi(gw[db].y); }
                    *(u32x2*)(a.O + row * a.os + 16 * db + 4 * g) = pk4(v); } } }
    }
}

constexpr int R_QS = 528, R_VS = 272, R_AS = 144, R_SS = 528;
constexpr int R_QOFF = 0, R_KOFF = 64 * R_QS, R_VOFF = 2 * 64 * R_QS, R_AOFF = R_VOFF + 64 * R_VS, R_SOFF = R_AOFF + 64 * R_AS, R_END = R_SOFF + 8 * 16 * R_SS;
static_assert(R_END <= LDS_BYTES, "retention LDS");
__device__ __forceinline__ void ret_unit(LAS unsigned char* lds, const bf16_t* proj, bf16_t* obuf, int row0, int L, int nchunks, int h, int sl, const float* s0, float* sout) {
    int tid_o = threadIdx.x; asm volatile("" : "+v"(tid_o)); const int tid = tid_o, w = __builtin_amdgcn_readfirstlane(tid >> 6), lane = tid & 63, li = lane & 15, g = lane >> 4;
    const int NLB = L >> 4, KM = L >> 5;
    const float lg2 = log2f(1.f - exp2f(-5.f - (float)h));
    const float cdec = exp2f(lg2 * (float)L);
    LAS unsigned char* sst = lds + R_SOFF + w * (16 * R_SS);
    f32x4 S[16];
#pragma unroll
    for (int blk = 0; blk < 16; ++blk) {
        if (s0) {
#pragma unroll
            for (int i = 0; i < 4; ++i) S[blk][i] = s0[(size_t)(16 * blk + 4 * g + i) * 512 + sl * 128 + 16 * w + li];
        } else S[blk] = (f32x4){0.f, 0.f, 0.f, 0.f};
        *(LAS u32x2*)(sst + li * R_SS + (16 * blk + 4 * g) * 2) = pk4(S[blk]);
    }
    const bf16_t* qb = proj + (size_t)row0 * 6144 + h * 256, *kb = qb + 1024, *vb = proj + (size_t)row0 * 6144 + 2048 + h * 512 + sl * 128;
    u32x4 qr[4], kr[4], vr[2];
#define RET_PREFETCH(c) do { const size_t rb = (size_t)(c) * L; \
        _Pragma("unroll") for (int i_ = 0; i_ < 4; ++i_) { const int id = tid + 512 * i_, r_ = id >> 5, ch = id & 31; const int rr = r_ < L ? r_ : L - 1; \
            qr[i_] = *(const u32x4*)(qb + (rb + rr) * 6144 + ch * 8); kr[i_] = *(const u32x4*)(kb + (rb + rr) * 6144 + ch * 8); } \
        _Pragma("unroll") for (int i_ = 0; i_ < 2; ++i_) { const int id = tid + 512 * i_, r_ = id >> 4, ch = id & 15; const int rr = r_ < L ? r_ : L - 1; \
            vr[i_] = *(const u32x4*)(vb + (rb + rr) * 6144 + ch * 8); } } while (0)
    RET_PREFETCH(0);
    for (int c = 0; c < nchunks; ++c) {
        lds_barrier();
#pragma unroll
        for (int i_ = 0; i_ < 4; ++i_) { const int id = tid + 512 * i_, r_ = id >> 5, ch = id & 31; *(LAS u32x4*)(lds + R_QOFF + r_ * R_QS + ch * 16) = qr[i_]; *(LAS u32x4*)(lds + R_KOFF + r_ * R_QS + ch * 16) = kr[i_]; }
#pragma unroll
        for (int i_ = 0; i_ < 2; ++i_) { const int id = tid + 512 * i_, r_ = id >> 4, ch = id & 15; *(LAS u32x4*)(lds + R_VOFF + r_ * R_VS + ch * 16) = vr[i_]; }
        lds_barrier();
        if (c + 1 < nchunks) RET_PREFETCH(c + 1);
        { const int lb = w >> 1;
#pragma unroll
            for (int mbi = 0; mbi < 2; ++mbi) { const int mb = 2 * (w & 1) + mbi;
                if (lb < NLB && mb < NLB) { f32x4 av = (f32x4){0.f, 0.f, 0.f, 0.f};
                    if (mb <= lb) {
#pragma unroll
                        for (int s = 0; s < 8; ++s) { const bf16x8 af = *(const LAS bf16x8*)(lds + R_QOFF + (16 * lb + li) * R_QS + (32 * s + 8 * g) * 2), bf = *(const LAS bf16x8*)(lds + R_KOFF + (16 * mb + li) * R_QS + (32 * s + 8 * g) * 2);
                            av = __builtin_amdgcn_mfma_f32_16x16x32_bf16(af, bf, av, 0, 0, 0); }
                    }
#pragma unroll
                    for (int i = 0; i < 4; ++i) { const int l = 16 * lb + 4 * g + i, mm = 16 * mb + li; const float dm = l >= mm ? exp2f(lg2 * (float)(l - mm)) : 0.f;
                        *(LAS unsigned short*)(lds + R_AOFF + l * R_AS + mm * 2) = (unsigned short)f2bf(av[i] * dm); } } } }
        lds_barrier();
        __builtin_amdgcn_sched_barrier(0);
        bf16x8 vf[2];
#pragma unroll
        for (int kk = 0; kk < 2; ++kk) { if (kk < KM) { const unsigned ad = R_VOFF + (32 * kk + 4 * g + (li >> 2)) * R_VS + (16 * w + 4 * (li & 3)) * 2;
                const s16x4 v0 = __builtin_amdgcn_ds_read_tr16_b64_v4i16((LAS s16x4*)(lds + ad)), v1 = __builtin_amdgcn_ds_read_tr16_b64_v4i16((LAS s16x4*)(lds + ad + 16 * R_VS));
                vf[kk][0] = v0[0]; vf[kk][1] = v0[1]; vf[kk][2] = v0[2]; vf[kk][3] = v0[3]; vf[kk][4] = v1[0]; vf[kk][5] = v1[1]; vf[kk][6] = v1[2]; vf[kk][7] = v1[3]; }
            else vf[kk] = (bf16x8){0, 0, 0, 0, 0, 0, 0, 0}; }
        f32x4 a1[4], a2[4];
#pragma unroll
        for (int lb = 0; lb < 4; ++lb) { a1[lb] = (f32x4){0.f, 0.f, 0.f, 0.f}; a2[lb] = (f32x4){0.f, 0.f, 0.f, 0.f}; }
#pragma unroll
        for (int kk = 0; kk < 2; ++kk) if (kk < KM) {
#pragma unroll
            for (int lb = 0; lb < 4; ++lb) if (lb < NLB) { const LAS unsigned char* ap = lds + R_AOFF + (16 * lb + li) * R_AS + (32 * kk + 4 * g) * 2;
                const u32x2 t0 = *(const LAS u32x2*)ap, t1 = *(const LAS u32x2*)(ap + 32); u32x4 tw; tw.x = t0.x; tw.y = t0.y; tw.z = t1.x; tw.w = t1.y;
                a1[lb] = __builtin_amdgcn_mfma_f32_16x16x32_bf16(vf[kk], __builtin_bit_cast(bf16x8, tw), a1[lb], 0, 0, 0); } }
#pragma unroll
        for (int s = 0; s < 8; ++s) { const bf16x8 sfr = *(const LAS bf16x8*)(sst + li * R_SS + (32 * s + 8 * g) * 2);
#pragma unroll
            for (int lb = 0; lb < 4; ++lb) if (lb < NLB) { const bf16x8 qf = *(const LAS bf16x8*)(lds + R_QOFF + (16 * lb + li) * R_QS + (32 * s + 8 * g) * 2);
                a2[lb] = __builtin_amdgcn_mfma_f32_16x16x32_bf16(sfr, qf, a2[lb], 0, 0, 0); } }
#pragma unroll
        for (int lb = 0; lb < 4; ++lb) if (lb < NLB) { const int l = 16 * lb + li; const float qd = exp2f(lg2 * (float)(l + 1));
            *(u32x2*)(obuf + ((size_t)row0 + (size_t)c * L + l) * 2048 + h * 512 + sl * 128 + 16 * w + 4 * g) = pk4(a1[lb] + a2[lb] * qd); }
        __builtin_amdgcn_sched_barrier(0);
        bf16x8 vd[2];
#pragma unroll
        for (int kk = 0; kk < 2; ++kk) {
#pragma unroll
            for (int j = 0; j < 8; ++j) { const int mm = 32 * kk + (j < 4 ? 4 * g + j : 16 + 4 * g + (j - 4)); const float kd = exp2f(lg2 * (float)(L - 1 - mm));
                vd[kk][j] = (short)f2bf(bf2f((unsigned short)vf[kk][j]) * kd); } }
#pragma unroll
        for (int blk = 0; blk < 16; ++blk) { f32x4 sv = S[blk] * cdec;
#pragma unroll
            for (int kk = 0; kk < 2; ++kk) if (kk < KM) { const unsigned ad = R_KOFF + (32 * kk + 4 * g + (li >> 2)) * R_QS + (16 * blk + 4 * (li & 3)) * 2;
                const s16x4 k0 = __builtin_amdgcn_ds_read_tr16_b64_v4i16((LAS s16x4*)(lds + ad)), k1 = __builtin_amdgcn_ds_read_tr16_b64_v4i16((LAS s16x4*)(lds + ad + 16 * R_QS));
                bf16x8 kf; kf[0] = k0[0]; kf[1] = k0[1]; kf[2] = k0[2]; kf[3] = k0[3]; kf[4] = k1[0]; kf[5] = k1[1]; kf[6] = k1[2]; kf[7] = k1[3];
                sv = __builtin_amdgcn_mfma_f32_16x16x32_bf16(kf, vd[kk], sv, 0, 0, 0); }
            S[blk] = sv;
            *(LAS u32x2*)(sst + li * R_SS + (16 * blk + 4 * g) * 2) = pk4(sv);
            if ((blk & 3) == 3) __builtin_amdgcn_sched_barrier(0); }
    }
#undef RET_PREFETCH
#pragma unroll
    for (int blk = 0; blk < 16; ++blk)
#pragma unroll
        for (int i = 0; i < 4; ++i) sout[(size_t)(16 * blk + 4 * g + i) * 512 + sl * 128 + 16 * w + li] = S[blk][i];
}
__device__ __forceinline__ void phase_ret_ln(int j) {
    int tid_o = threadIdx.x; asm volatile("" : "+v"(tid_o)); const int tid = tid_o, lane = tid & 63, wave = tid >> 6, gw = blockIdx.x * 8 + wave, NGW = gridDim.x * 8;
    bf16_t* obuf = (bf16_t*)(PWS + PL_ROBUF); const bf16_t* proj = (const bf16_t*)(PWS + PL_RPROJ); const float* gn = PIN(15) + (size_t)j * 2048;
    for (int it0 = gw; it0 < MT * 4; it0 += 2 * NGW) {
        u32x4 ow[2], gwd[2]; f32x4 g0[2], g1[2]; bf16_t* op[2]; bool ok[2];
#pragma unroll
        for (int q = 0; q < 2; ++q) { int it = it0 + q * NGW; ok[q] = it < MT * 4; it = ok[q] ? it : it0; const int r = it >> 2, h = it & 3; op[q] = obuf + (size_t)r * 2048 + h * 512 + lane * 8;
            ow[q] = *(const u32x4*)op[q]; gwd[q] = *(const u32x4*)(proj + (size_t)r * 6144 + 4096 + h * 512 + lane * 8);
            g0[q] = *(const f32x4*)(gn + h * 512 + lane * 8); g1[q] = *(const f32x4*)(gn + h * 512 + lane * 8 + 4); }
#pragma unroll
        for (int q = 0; q < 2; ++q) {
            float x[8] = {bflo(ow[q].x), bfhi(ow[q].x), bflo(ow[q].y), bfhi(ow[q].y), bflo(ow[q].z), bfhi(ow[q].z), bflo(ow[q].w), bfhi(ow[q].w)};
            const float sg[8] = {bflo(gwd[q].x), bfhi(gwd[q].x), bflo(gwd[q].y), bfhi(gwd[q].y), bflo(gwd[q].z), bfhi(gwd[q].z), bflo(gwd[q].w), bfhi(gwd[q].w)};
            float sm = 0.f;
#pragma unroll
            for (int e = 0; e < 8; ++e) sm += x[e];
            const float mu = wave_sum(sm) * (1.f / 512.f); float qv = 0.f;
#pragma unroll
            for (int e = 0; e < 8; ++e) { x[e] -= mu; qv += x[e] * x[e]; }
            const float rstd = rsqrtf(wave_sum(qv) * (1.f / 512.f) + EPS);
            u32x4 o; o.x = pk2(x[0] * rstd * g0[q][0] * sg[0], x[1] * rstd * g0[q][1] * sg[1]); o.y = pk2(x[2] * rstd * g0[q][2] * sg[2], x[3] * rstd * g0[q][3] * sg[3]);
            o.z = pk2(x[4] * rstd * g1[q][0] * sg[4], x[5] * rstd * g1[q][1] * sg[5]); o.w = pk2(x[6] * rstd * g1[q][2] * sg[6], x[7] * rstd * g1[q][3] * sg[7]);
            if (ok[q]) *(u32x4*)op[q] = o; } }
}
__device__ __forceinline__ void phase_fox_scan() {
    int tid_o = threadIdx.x; asm volatile("" : "+v"(tid_o)); const int tid = tid_o, lane = tid & 63, wave = tid >> 6, gw = blockIdx.x * 8 + wave, NGW = gridDim.x * 8;
    for (int it = gw; it < 512; it += NGW) { const int grp = it >> 8, bh = it & 255, b = bh >> 4, h = bh & 15; const int T = grp ? TKS : SEQ, per = grp ? 33 : 32;
        float* F = grp ? (float*)(PWS + WS_FS) + (size_t)bh * TKS : (float*)(PWS + WS_FP) + (size_t)bh * SEQ;
        const float* srcA = grp ? PIN(7) + (size_t)b * SEQ * 16 + h : POUT + O_FLP + (size_t)b * SEQ * 16 + h;
        const float* srcB = POUT + O_FLS + (size_t)b * DEC * 16 + h;
        const int t0 = lane * per; float v[33]; float s = 0.f;
#pragma unroll
        for (int e = 0; e < 33; ++e) { const int t = t0 + e; v[e] = (e < per && t < T) ? (t < SEQ ? srcA[(size_t)t * 16] : srcB[(size_t)(t - SEQ) * 16]) : 0.f; }
#pragma unroll
        for (int e = 0; e < 33; ++e) s += v[e];
        float inc = s;
#pragma unroll
        for (int o = 1; o < 64; o <<= 1) { const float n = __shfl_up(inc, o); if (lane >= o) inc += n; }
        float run = inc - s;
#pragma unroll
        for (int e = 0; e < 33; ++e) { const int t = t0 + e; run += v[e]; if (e < per && t < T) F[t] = run * LOG2E; } }
}
__device__ __forceinline__ void phase_final() {
    int tid_o = threadIdx.x; asm volatile("" : "+v"(tid_o)); const int tid = tid_o, lane = tid & 63, wave = tid >> 6, gw = blockIdx.x * 8 + wave, NGW = gridDim.x * 8; const float* gf = PIN(13);
    const bf16_t* hb = (const bf16_t*)(PWS + WS_HBB);
    for (int r = gw; r < MT; r += NGW) { float* y = POUT + O_Y + (size_t)r * D; f32x4 v[4]; float s = 0.f;
#pragma unroll
        for (int j = 0; j < 4; ++j) { v[j] = up4(*(const u32x2*)(hb + (size_t)r * D + (lane + 64 * j) * 4)); s += dot4(v[j]); }
        const float rstd = rsqrtf(wave_sum(s) * (1.f / 1024.f) + EPS);
#pragma unroll
        for (int j = 0; j < 4; ++j) *(f32x4*)(y + (lane + 64 * j) * 4) = v[j] * rstd * *(const f32x4*)(gf + (lane + 64 * j) * 4); }
}

template <int EPI>
__device__ __forceinline__ void sample_gemm(LAS unsigned char* lds, const bf16_t* A, const bf16_t* Bt, int K, const bf16_t* hin, bf16_t* hout, float* ssqw, const float* ssqr, const bf16_t* pp, bf16_t* outp) {
    int tid_o = threadIdx.x; asm volatile("" : "+v"(tid_o)); const int tid = tid_o, w = __builtin_amdgcn_readfirstlane(tid >> 6), lane = tid & 63, li = lane & 15, g = lane >> 4;
    LAS float* xs = (LAS float*)(lds + XR_OFF);
    for (int mu = blockIdx.x; mu < 128; mu += gridDim.x) {
        const int rsb = mu >> 2, pn = mu & 3, row = MP + 16 * rsb + li, kw = K >> 3;
        f32x4 acc[16];
#pragma unroll
        for (int cb = 0; cb < 16; ++cb) acc[cb] = (f32x4){0.f, 0.f, 0.f, 0.f};
        const bf16_t* ap = A + (size_t)row * K + w * kw + 8 * g;
        const bf16_t* bp = Bt + (size_t)(pn * 256 + li) * K + w * kw + 8 * g;
        bf16x8 a0 = *(const bf16x8*)ap, b0[16], a1, b1[16];
#pragma unroll
        for (int cb = 0; cb < 16; ++cb) b0[cb] = *(const bf16x8*)(bp + (size_t)cb * 16 * K);
        for (int ks = 0; ks < kw; ks += 64) {
            const bool h1 = ks + 32 < kw, h2 = ks + 64 < kw;
            if (h1) { a1 = *(const bf16x8*)(ap + ks + 32);
#pragma unroll
                for (int cb = 0; cb < 16; ++cb) b1[cb] = *(const bf16x8*)(bp + (size_t)cb * 16 * K + ks + 32); }
#pragma unroll
            for (int cb = 0; cb < 16; ++cb) acc[cb] = __builtin_amdgcn_mfma_f32_16x16x32_bf16(b0[cb], a0, acc[cb], 0, 0, 0);
            if (h2) { a0 = *(const bf16x8*)(ap + ks + 64);
#pragma unroll
                for (int cb = 0; cb < 16; ++cb) b0[cb] = *(const bf16x8*)(bp + (size_t)cb * 16 * K + ks + 64); }
            if (h1) {
#pragma unroll
                for (int cb = 0; cb < 16; ++cb) acc[cb] = __builtin_amdgcn_mfma_f32_16x16x32_bf16(b1[cb], a1, acc[cb], 0, 0, 0); }
        }
        lds_barrier();
#pragma unroll
        for (int cb = 0; cb < 16; ++cb) *(LAS f32x4*)(lds + ((w * 16 + cb) * 64 + lane) * 16) = acc[cb];
        lds_barrier();
        f32x4 v[2];
#pragma unroll
        for (int e = 0; e < 2; ++e) { v[e] = (f32x4){0.f, 0.f, 0.f, 0.f};
#pragma unroll
            for (int ww = 0; ww < 8; ++ww) v[e] += *(const LAS f32x4*)(lds + ((ww * 16 + 2 * w + e) * 64 + lane) * 16); }
        const size_t off = (size_t)row * D + pn * 256 + 32 * w + 4 * g;
        if (EPI == 2) {
#pragma unroll
            for (int e = 0; e < 2; ++e) *(u32x2*)(outp + off + 16 * e) = pk4(v[e]);
        } else {
            float ss = 0.f; float rs = 1.f; if (EPI == 1) rs = row_rstd(ssqr, row, 1.f / 1024.f);
#pragma unroll
            for (int e = 0; e < 2; ++e) { f32x4 o = up4(*(const u32x2*)(hin + off + 16 * e));
                if (EPI == 0) o += v[e];
                else { const u32x2 pw = *(const u32x2*)(pp + off + 16 * e); const f32x4 a = v[e] * rs;
                    o[0] += sigmoidf_(a[0]) * bflo(pw.x); o[1] += sigmoidf_(a[1]) * bfhi(pw.x); o[2] += sigmoidf_(a[2]) * bflo(pw.y); o[3] += sigmoidf_(a[3]) * bfhi(pw.y); }
                const u32x2 ow = pk4(o); *(u32x2*)(hout + off + 16 * e) = ow; ss += dot4(up4(ow)); }
            ss = fq_sum(ss); if (g == 0) xs[li * 8 + w] = ss;
            lds_barrier();
            if (w == 0 && g == 0) { const f32x4 t0 = *(const LAS f32x4*)(xs + li * 8), t1 = *(const LAS f32x4*)(xs + li * 8 + 4); ssqw[(size_t)row * 4 + pn] = ((t0[0] + t0[1]) + (t0[2] + t0[3])) + ((t1[0] + t1[1]) + (t1[2] + t1[3])); }
        }
    }
    lds_barrier();
}

#define XB_TMO      128
#define XB_XCNT(j)  (256  + 64 * (j))
#define XB_XSUB(j)  (1280 + 64 * (j))
#define XB_XGEN(j)  (2304 + 64 * (j))
#define XB_TOP      3328
#define XB_TOPGEN   3392
#define XCD_BAR_WORDS 3456
#define XB_SPIN_CAP (1u << 18)

__device__ __forceinline__ unsigned xb_ld(unsigned* p)              { return __hip_atomic_load(p, __ATOMIC_RELAXED, __HIP_MEMORY_SCOPE_AGENT); }
__device__ __forceinline__ unsigned xb_add(unsigned* p, unsigned v) { return __hip_atomic_fetch_add(p, v, __ATOMIC_RELAXED, __HIP_MEMORY_SCOPE_AGENT); }
__device__ __forceinline__ unsigned xb_xcc_id() { return (unsigned)__builtin_amdgcn_s_getreg((3 << 11) | 20) & 0xFu; }
#define XB_SPIN(cond, bar) do { unsigned _sp = 0; while (cond) { __builtin_amdgcn_s_sleep(1); \
    if ((++_sp & 255u) == 0u) { if (xb_ld(&(bar)[XB_TMO])) break; if (_sp > XB_SPIN_CAP) { atomicAdd(&(bar)[XB_TMO], 1u); break; } } } } while (0)

struct XcdBarrier {
    unsigned* bar; unsigned x;
    volatile LAS unsigned* st;
};

__device__ __forceinline__ XcdBarrier xcd_barrier_post(unsigned* bar, volatile LAS unsigned* st) {
    XcdBarrier b; b.bar = bar; b.x = xb_xcc_id(); b.st = st;
    if (threadIdx.x == 0) (void)xb_add(&bar[XB_XCNT(b.x)], 1u);
    return b;
}
__device__ __forceinline__ void xcd_barrier_complete(unsigned* bar, unsigned x, unsigned& nloc, unsigned& nx) {
    const unsigned G = gridDim.x * gridDim.y * gridDim.z;
    unsigned sum, cnt, mine, sp = 0u;
    for (;;) {
        sum = 0u; cnt = 0u; mine = 0u;
#pragma unroll
        for (unsigned j = 0; j < 16; ++j) { const unsigned c = xb_ld(&bar[XB_XCNT(j)]); sum += c; cnt += (c > 0u) ? 1u : 0u; mine = (j == x) ? c : mine; }
        if (sum == G) break;
        __builtin_amdgcn_s_sleep(1);
        if ((++sp & 255u) == 0u) { if (xb_ld(&bar[XB_TMO])) break; if (sp > XB_SPIN_CAP) { atomicAdd(&bar[XB_TMO], 1u); break; } }
    }
    nloc = mine > 0u ? mine : 1u; nx = cnt > 0u ? cnt : 1u;
}

__device__ __forceinline__ void xcd_barrier(const XcdBarrier& b) {
    asm volatile("s_waitcnt vmcnt(0)" ::: "memory");
    __syncthreads();
    if (threadIdx.x == 0) {
        unsigned* bar = b.bar;
        __builtin_amdgcn_s_waitcnt(0);
        unsigned nloc = b.st[0], nx = b.st[1];
        if (nloc == 0u) { xcd_barrier_complete(bar, b.x, nloc, nx); b.st[0] = nloc; b.st[1] = nx; }
        const unsigned old = xb_add(&bar[XB_XSUB(b.x)], 1u);
        const unsigned gen = old / nloc;
        if (old + 1u == (gen + 1u) * nloc) {
            __builtin_amdgcn_fence(__ATOMIC_RELEASE, "agent");
            asm volatile("s_waitcnt vmcnt(0)" ::: "memory");
            const unsigned og = xb_add(&bar[XB_TOP], 1u);
            const unsigned tg = og / nx;
            if (og + 1u == (tg + 1u) * nx) xb_add(&bar[XB_TOPGEN], 1u);
            else XB_SPIN(xb_ld(&bar[XB_TOPGEN]) == tg, bar);
            __builtin_amdgcn_fence(__ATOMIC_ACQUIRE, "agent");
            xb_add(&bar[XB_XGEN(b.x)], 1u);
            asm volatile("s_waitcnt vmcnt(0)" ::: "memory");
        } else {
            XB_SPIN(xb_ld(&bar[XB_XGEN(b.x)]) == gen, bar);
            __builtin_amdgcn_fence(__ATOMIC_ACQUIRE, "agent");
            asm volatile("s_waitcnt vmcnt(0)" ::: "memory");
        }
    }
    __syncthreads();
}


typedef pg8::StaticOrder SO;
#define GEMM(EpiT, A_, Bt_, M_, N_, K_, E_) do { pg8::Gemm g_{(const bf16_t*)(A_), (const bf16_t*)(Bt_), (M_), (N_), (K_)}; SO S_; S_.init((M_), (N_), (int)gridDim.x, (int)blockIdx.x); \
        pg8::gemm_phase<EpiT, SO, true, true>(lds, g_, S_, (E_)); } while (0)

__global__ void __launch_bounds__(512, 2) trunk_fwd(Params P) {
    extern __shared__ __attribute__((aligned(16))) unsigned char lds_raw[];
    LAS unsigned char* lds = (LAS unsigned char*)lds_raw;
    cg::grid_group grid = cg::this_grid();
#define RUN true
#ifdef PROBE_SEL
    unsigned long long tacc = 0, tlast = __builtin_amdgcn_s_memrealtime(); int curcat = 0;
#define TSWITCH(c) do { const unsigned long long tn_ = __builtin_amdgcn_s_memrealtime(); if (curcat == PROBE_SEL) tacc += tn_ - tlast; tlast = tn_; curcat = (c); } while (0)
#define RUNT(c) ({ TSWITCH(c); RUN; })
#else
#define TSWITCH(c) do { } while (0)
#define RUNT(c) RUN
#endif
#ifndef ONLY
#define EN(k) true
#else
#define EN(k) ((k) == ONLY)
#endif
#define SEAM() do { TSWITCH(5); { XcdBarrier b_; b_.bar = (unsigned*)(PWS + WS_BAR); b_.x = xb_xcc_id(); b_.st = (volatile LAS unsigned*)(lds + LDS_BYTES - 64); xcd_barrier(b_); } TSWITCH(6); } while (0)
#define WB ((bf16_t*)(PWS + WS_W))
#define HBA ((bf16_t*)(PWS + WS_HBA))
#define HBB ((bf16_t*)(PWS + WS_HBB))
#define SSQ0 ((float*)(PWS + WS_SSQ))
#define SSQ1 ((float*)(PWS + WS_SSQ) + (size_t)MT * 4)
#define HRES (POUT + O_Y)
#define ROPE_ ((const float*)(PWS + WS_ROPE))
#define ROPEM_ ((const float*)(PWS + WS_ROPEM))
    LAS float* xr = (LAS float*)(lds + XR_OFF);
    volatile LAS unsigned* bst = (volatile LAS unsigned*)(lds + LDS_BYTES - 64);
    if (threadIdx.x < 2) bst[threadIdx.x] = 0u;
    __syncthreads();
#define SSQ_P(p) ((((layer) ^ (p)) & 1) ? SSQ1 : SSQ0)

    if (blockIdx.x == 0) { unsigned* bw = (unsigned*)(PWS + WS_BAR); for (int i = threadIdx.x; i < XCD_BAR_WORDS; i += 512) __hip_atomic_store(bw + i, 0u, __ATOMIC_RELAXED, __HIP_MEMORY_SCOPE_AGENT); }
    if (EN(1) && RUNT(4)) phase_prologue(lds);
    TSWITCH(5); grid.sync(); (void)xcd_barrier_post((unsigned*)(PWS + WS_BAR), bst); TSWITCH(6);

    for (int layer = 0; layer < 4; ++layer) {
        const int kind = layer % 3, j = layer / 3;
        if (kind == 0) {
            bf16_t* proj = (bf16_t*)(PWS + PL_RPROJ); bf16_t* obuf = (bf16_t*)(PWS + PL_ROBUF);
            if (EN(2) && RUNT(1)) { EpiRetIn E{SSQ_P(0), proj, ROPE_}; GEMM(EpiRetIn, HBB, WB + W_RI + j * SZ_RI, MT, 6144, 1024, E); }
            SEAM();
            if (EN(3) && RUNT(3)) {
                for (int u = blockIdx.x; u < 512; u += gridDim.x) { const int grp = u >> 8, c = u & 255, b = c >> 4, h = (c >> 2) & 3, sl = c & 3;
                    const size_t so = ((size_t)(j * 16 + b) * 4 + h) * 131072;
                    if (!grp) ret_unit(lds, proj, obuf, b * SEQ, 64, 32, h, sl, nullptr, POUT + O_RSP + so);
                    else ret_unit(lds, proj, obuf, MP + b * DEC, 32, 1, h, sl, PIN(2) + so, POUT + O_RSS + so);
                    lds_barrier(); }
            }
            SEAM();
            if (EN(4) && RUNT(3)) phase_ret_ln(j);
            SEAM();
            if (EN(5) && RUNT(1)) { sample_gemm<0>(lds, obuf, WB + W_RO + j * SZ_RO, 2048, HBB, HBA, SSQ_P(1), nullptr, nullptr, nullptr); EpiRes E{HBB, HBA, SSQ_P(1), xr}; GEMM(EpiRes, obuf, WB + W_RO + j * SZ_RO, MP, 1024, 2048, E); }
            SEAM();
        } else if (kind == 1) {
            bf16_t* cqb = (bf16_t*)(PWS + PL_CQB); float* cqss = (float*)(PWS + WS_CQSS); bf16_t* latb = (bf16_t*)(PWS + PL_LATB); bf16_t* krb = (bf16_t*)(PWS + PL_KRB);
            bf16_t* mq = (bf16_t*)(POUT + O_FKP); bf16_t* kvh = (bf16_t*)(PWS + PL_KVH); bf16_t* mo = (bf16_t*)(PWS + PL_MO);
            if (EN(6) && RUNT(1)) {
                cvt_cache<256>(PIN(3), latb + (size_t)MP * 256); cvt_cache<64>(PIN(4), krb + (size_t)MP * 64);
                EpiMlaIn E{SSQ_P(0), PWS, POUT, PIN(19), PIN(25), xr}; GEMM(EpiMlaIn, HBB, WB + W_MI, MT, 1024, 1024, E); }
            SEAM();
            for (int hh = 0; hh < 2; ++hh) {
                if (EN(7) && RUNT(1)) {
                    if (hh == 0) { EpiPlain E{mq, 3072, cqss, 1.f / 512.f}; GEMM(EpiPlain, cqb, WB + W_QB, MT, 3072, 512, E); }
                    EpiKV E2{kvh, xr}; GEMM(EpiKV, latb, WB + W_KVB + (size_t)hh * 2048 * 256, KVR, 2048, 256, E2); }
                SEAM();
                if (EN(8) && RUNT(2)) {
                    const MlaQ q4{PIN(22), PIN(24), PIN(23), ROPEM_};
                    for (int u = blockIdx.x; u < 6 * 256; u += gridDim.x) { const int i = u >> 8, c = u & 255;
                        const int qb = c < 128 ? (i == 0 ? -1 : (i == 1 ? 7 : (i == 2 ? 5 : -2))) : (i == 0 ? 6 : (i == 1 ? 4 : 5 - i));
                        if (qb > -2) { const int bh = c & 127, b = bh >> 3, hl = bh & 7, hd = hh * 8 + hl; const bool pr = qb >= 0;
                            const size_t rq = pr ? (size_t)b * SEQ : (size_t)MP + (size_t)b * DEC, rk = pr ? (size_t)b * SEQ : (size_t)MP + (size_t)b * TKS; AU a;
                            a.Q = mq + rq * 3072 + hd * 192; a.qs = 3072; a.K1 = kvh + rk * 2048 + hl * 256; a.k1s = 2048; a.K2 = krb + rk * 64; a.k2s = 64; a.V = kvh + rk * 2048 + hl * 256 + 128; a.vs = 2048;
                            a.O = mo + rq * 2048 + hd * 128; a.os = 2048; a.G = nullptr; a.gs = 0; a.Fk = nullptr; a.q0 = pr ? qb * 256 : 0; a.nq = pr ? 256 : DEC; a.off = pr ? 0 : SEQ; a.Tk = pr ? SEQ : TKS;
                            attn_unit<192, 128, 0>(lds, a, q4); } }

                    lds_barrier();
                }
                SEAM();
            }
            if (EN(9) && RUNT(1)) { sample_gemm<0>(lds, mo, WB + W_MO, 2048, HBB, HBA, SSQ_P(1), nullptr, nullptr, nullptr); EpiRes E{HBB, HBA, SSQ_P(1), xr}; GEMM(EpiRes, mo, WB + W_MO, MP, 1024, 2048, E); }
            SEAM();
        } else {
            bf16_t* proj = (bf16_t*)(PWS + PL_FPROJ); bf16_t* kall = (bf16_t*)(PWS + PL_FKALL); bf16_t* vall = (bf16_t*)(PWS + PL_FVALL); bf16_t* fo = (bf16_t*)(PWS + PL_FO);
            if (EN(10) && RUNT(1)) {
                cvt_cache<1024>(PIN(5), kall); cvt_cache<1024>(PIN(6), vall);
                EpiFoxIn E{SSQ_P(0), PWS, POUT, PIN(29), PIN(30), PIN(28), xr}; GEMM(EpiFoxIn, HBB, WB + W_FI, MT, 4352, 1024, E); }
            SEAM();
            if (EN(11) && RUNT(6)) phase_fox_scan();
            SEAM();
            if (EN(12) && RUNT(2)) {
                const MlaQ q4{nullptr, nullptr, nullptr, nullptr};
                for (int u = blockIdx.x; u < 2048 + 256; u += gridDim.x) { AU a; a.K2 = nullptr; a.k2s = 0;
                    if (u < 2048) { const int qb = u >> 8, bh = u & 255, b = bh >> 4, hd = bh & 15; const size_t r0 = (size_t)b * SEQ;
                        a.Q = proj + r0 * 4096 + hd * 64; a.qs = 4096; a.K1 = proj + r0 * 4096 + 1024 + hd * 64; a.k1s = 4096; a.V = proj + r0 * 4096 + 2048 + hd * 64; a.vs = 4096;
                        a.O = fo + r0 * 1024 + hd * 64; a.os = 1024; a.G = proj + r0 * 4096 + 3072 + hd * 64; a.gs = 4096; a.Fk = (const float*)(PWS + WS_FP) + (size_t)bh * SEQ; a.q0 = qb * 256; a.nq = 256; a.off = 0; a.Tk = SEQ; }
                    else { const int bh = u - 2048, b = bh >> 4, hd = bh & 15; const size_t rq = (size_t)MP + (size_t)b * DEC, rk = (size_t)b * TKS;
                        a.Q = proj + rq * 4096 + hd * 64; a.qs = 4096; a.K1 = kall + rk * 1024 + hd * 64; a.k1s = 1024; a.V = vall + rk * 1024 + hd * 64; a.vs = 1024;
                        a.O = fo + rq * 1024 + hd * 64; a.os = 1024; a.G = proj + rq * 4096 + 3072 + hd * 64; a.gs = 4096; a.Fk = (const float*)(PWS + WS_FS) + (size_t)bh * TKS; a.q0 = 0; a.nq = DEC; a.off = SEQ; a.Tk = TKS; }
                    attn_unit<64, 64, 1>(lds, a, q4); }
                lds_barrier();
            }
            SEAM();
            if (EN(13) && RUNT(1)) { sample_gemm<0>(lds, fo, WB + W_FO, 1024, HBB, HBA, SSQ_P(1), nullptr, nullptr, nullptr); EpiRes E{HBB, HBA, SSQ_P(1), xr}; GEMM(EpiRes, fo, WB + W_FO, MP, 1024, 1024, E); }
            SEAM();
        }
        bf16_t* act = (bf16_t*)(PWS + PL_ACT); bf16_t* pb = (bf16_t*)(PWS + PL_PB); bf16_t* pp = (bf16_t*)(PWS + PL_PP);
        if (EN(14) && RUNT(1)) {
            cvt_chunks(PIN(8) + (size_t)layer * MP * 256, pb, (size_t)MP * 32); cvt_chunks(PIN(9) + (size_t)layer * MS * 256, pb + (size_t)MP * 256, (size_t)MS * 32);
            EpiGU E{SSQ_P(1), act}; GEMM(EpiGU, HBA, WB + W_GU + layer * SZ_GU, MT, 5632, 1024, E); }
        SEAM();
        if (EN(15) && RUNT(1)) {
            sample_gemm<0>(lds, act, WB + W_DN + layer * SZ_DN, DFF, HBA, HBA, SSQ_P(0), nullptr, nullptr, nullptr);
            sample_gemm<2>(lds, pb, WB + W_PP + layer * SZ_PP, 256, nullptr, nullptr, nullptr, nullptr, nullptr, pp);
            { EpiRes E{HBA, HBA, SSQ_P(0), xr}; GEMM(EpiRes, act, WB + W_DN + layer * SZ_DN, MP, 1024, DFF, E); }
            { EpiPlain E{pp, 1024, nullptr, 0.f}; GEMM(EpiPlain, pb, WB + W_PP + layer * SZ_PP, MP, 1024, 256, E); } }
        SEAM();
        if (EN(16) && RUNT(1)) { sample_gemm<1>(lds, HBA, WB + W_PG + layer * SZ_PG, 1024, HBA, HBB, SSQ_P(1), SSQ_P(0), pp, nullptr); EpiPE E{HBA, pp, HBB, SSQ_P(0), SSQ_P(1), xr}; GEMM(EpiPE, HBA, WB + W_PG + layer * SZ_PG, MP, 1024, 1024, E); }
        SEAM();
    }
    if (EN(17) && RUNT(6)) phase_final();
#ifdef PROBE_SEL
    TSWITCH(0);
    if (blockIdx.x == 0 && threadIdx.x == 0) { asm volatile("s_waitcnt vmcnt(0)" ::: "memory"); POUT[0] += (float)tacc * 1e-5f; }
#endif
}

extern "C" void kernel_launch(void* const* d_in, const int* in_sizes, int n_in, void* d_out, int out_size, void* d_ws, size_t ws_size, hipStream_t stream) {
    static int grid = 0;
    if (grid == 0) {
        if (n_in != 37 || (size_t)out_size != O_END || ws_size < WS_NEED) { fprintf(stderr, "kernel_launch: unexpected sizes n_in %d out %d ws %zu (need %zu)\n", n_in, out_size, ws_size, (size_t)WS_NEED); grid = -1; return; }
        int dev = 0, cus = 0, per_cu = 0;
        if (hipGetDevice(&dev) != hipSuccess || hipDeviceGetAttribute(&cus, hipDeviceAttributeMultiprocessorCount, dev) != hipSuccess) { grid = -1; return; }
        if (hipFuncSetAttribute((const void*)trunk_fwd, hipFuncAttributeMaxDynamicSharedMemorySize, LDS_BYTES) != hipSuccess) { fprintf(stderr, "kernel_launch: hipFuncSetAttribute failed\n"); grid = -1; return; }
        if (hipOccupancyMaxActiveBlocksPerMultiprocessor(&per_cu, (const void*)trunk_fwd, 512, LDS_BYTES) != hipSuccess || per_cu < 1) { fprintf(stderr, "kernel_launch: occupancy query says %d\n", per_cu); per_cu = 1; }
        (void)hipGetLastError();
        grid = cus * per_cu;
    }
    if (grid < 0) return;
    Params p{};
    for (int i = 0; i < 37; ++i) p.in[i] = (const float*)d_in[i];
    p.out = (float*)d_out; p.ws = (unsigned char*)d_ws; p.ph_lo = 0; p.ph_hi = 1000;
    void* args[] = {&p};
    hipError_t e = hipLaunchCooperativeKernel((const void*)trunk_fwd, dim3(grid), dim3(512), args, LDS_BYTES, stream);
    if (e != hipSuccess) fprintf(stderr, "cooperative launch failed: %s (grid %d)\n", hipGetErrorString(e), grid);
}
```

```cpp
#include <hip/hip_runtime.h>
#include <hip/hip_cooperative_groups.h>
#include <cstdio>
#include <cstdint>
namespace cg = cooperative_groups;
namespace pg8 {
#define PG8_LAS __attribute__((address_space(3)))
typedef unsigned short bf16_t;
typedef short bf16x8 __attribute__((ext_vector_type(8)));
typedef float f32x4 __attribute__((ext_vector_type(4)));
typedef unsigned u32x4 __attribute__((ext_vector_type(4)));
constexpr int BM = 256, BK = 64, HALF = 128, HTB = HALF * BK * 2  , STAGE_BYTES = 8 * HTB, NXCD = 8, WGM = 8;

__host__ __device__ __forceinline__ int lds_byte(int r, int c) { const int st = (r >> 4) * 2 + (c >> 5), rr = r & 15, cc = c & 31, ob = rr * 64 + cc * 2; return st * 1024 + (ob ^ (((ob >> 9) & 1) << 5)); }
__host__ __device__ __forceinline__ void stage_rc(int b, int& R, int& C) { const int st = b / 1024, sb = b % 1024, swz = sb ^ (((sb >> 9) & 1) << 5); R = (st >> 1) * 16 + swz / 64; C = (st & 1) * 32 + (swz % 64) / 2; }
__host__ __device__ __forceinline__ int perm32(int rho) { const int n = rho >> 4, i = rho & 15; return 8 * (i >> 2) + 4 * n + (i & 3); }

struct Unit { int pm, pn; };
struct Gemm { const bf16_t* A; const bf16_t* Bt; int M, N, K; };

struct StaticOrder {
    int nM, nN, nwg, G, c;
    __host__ __device__ void init(int M, int N, int G_, int c_) { nM = M / BM; nN = N / BM; nwg = nM * nN; G = G_; c = c_; }
    __host__ __device__ bool next(int i, Unit& u) const {
        const long L = (long)i * G + c; if (L >= nwg) return false;
        int wgid = (int)L; { const int q = nwg / NXCD, r = nwg % NXCD, xcd = wgid % NXCD, off = wgid / NXCD; wgid = (xcd < r ? xcd * (q + 1) : r * (q + 1) + (xcd - r) * q) + off; }
        const int nig = WGM * nN, gid = wgid / nig, fm = gid * WGM, gsz = (nM - fm) < WGM ? (nM - fm) : WGM;
        u.pm = fm + ((wgid % nig) % gsz); u.pn = (wgid % nig) / gsz; return true;
    }
    __device__ __forceinline__ void a_ready(const Unit&) const {}
    __device__ __forceinline__ void done(const Unit&) const {}
};

typedef float f32x2 __attribute__((ext_vector_type(2)));
template <class Epi, class Sched, bool ALIGN_EPI = false, bool SP2 = false>
__device__ __forceinline__ void gemm_phase(PG8_LAS unsigned char* lds, const Gemm g, const Sched& S, const Epi& E) {
    int tid_o = threadIdx.x; asm volatile("" : "+v"(tid_o)); const int tid = tid_o, wid = __builtin_amdgcn_readfirstlane(tid >> 6), lane = tid & 63, wr = wid >> 2, wc = wid & 3, fr = lane & 15, fq = lane >> 4;
    const int K = g.K, nt = K / BK;
    unsigned voffA[2], voffB[2];
#pragma unroll
    for (int i = 0; i < 2; ++i) { int R, C; stage_rc(tid * 16 + i * 8192, R, C); const int Rb = Epi::PERM ? ((R & ~31) + perm32(R & 31)) : R;
        voffA[i] = (unsigned)(R * K + C) * 2u; voffB[i] = (unsigned)(Rb * K + C) * 2u; }
    const size_t kstep = (size_t)(BK * 2);
    const size_t hstep = (size_t)HALF * K * 2;
    const size_t tstep = 2 * hstep;
    const unsigned ldsw = (unsigned)wid * 1024u;
    const int aoff = lds_byte(wr * 64 + fr, fq * 8), boff = lds_byte(wc * 32 + fr, fq * 8);
#define PG8_SA(b, h) (((b) * 2 + (h)) * HTB)
#define PG8_SB(b, h) ((4 + (b) * 2 + (h)) * HTB)
#define PG8_STAGE(bufoff, gbase, voff) do { _Pragma("unroll") for (int _i = 0; _i < 2; ++_i) \
        __builtin_amdgcn_global_load_lds((const unsigned*)((const char*)(gbase) + (voff)[_i]), (PG8_LAS unsigned*)(lds + (bufoff) + ldsw + _i * 8192), 16, 0, 0); } while (0)
#define PG8_LDA(dst, b, h) do { _Pragma("unroll") for (int m = 0; m < 4; ++m) _Pragma("unroll") for (int k = 0; k < 2; ++k) dst[m][k] = *(const PG8_LAS bf16x8*)(lds + PG8_SA(b, h) + aoff + m * 2048 + k * 1024); } while (0)
#define PG8_LDB(dst, b, h) do { _Pragma("unroll") for (int n = 0; n < 2; ++n) _Pragma("unroll") for (int k = 0; k < 2; ++k) dst[n][k] = *(const PG8_LAS bf16x8*)(lds + PG8_SB(b, h) + boff + n * 2048 + k * 1024); } while (0)
#define PG8_MMA(ai, bj, At, Bt) do { __builtin_amdgcn_s_setprio(1); _Pragma("unroll") for (int m = 0; m < 4; ++m) _Pragma("unroll") for (int n = 0; n < 2; ++n) _Pragma("unroll") for (int k = 0; k < 2; ++k) \
        acc[ai][bj][m][n] = __builtin_amdgcn_mfma_f32_16x16x32_bf16(Bt[n][k], At[m][k], acc[ai][bj][m][n], 0, 0, 0); __builtin_amdgcn_s_setprio(0); } while (0)
#define PG8_WAIT_V(n) asm volatile("s_waitcnt vmcnt(" #n ")" ::: "memory")
#define PG8_WAIT_L(n) asm volatile("s_waitcnt lgkmcnt(" #n ")" ::: "memory")
#define PG8_BAR __builtin_amdgcn_s_barrier()
#define PG8_SCHED __builtin_amdgcn_sched_barrier(0)
    Unit cur, nxt; int ui = 0;
    if (!S.next(0, cur)) return;
    f32x4 acc[2][2][4][2];
#pragma unroll
    for (int a = 0; a < 2; ++a)
#pragma unroll
        for (int b = 0; b < 2; ++b)
#pragma unroll
            for (int m = 0; m < 4; ++m)
#pragma unroll
                for (int n = 0; n < 2; ++n) acc[a][b][m][n] = (f32x4){0.f, 0.f, 0.f, 0.f};
    bf16x8 At[4][2], B0[2][2], B1[2][2];
    const char* cA = (const char*)g.A + (size_t)cur.pm * tstep; const char* cB = (const char*)g.Bt + (size_t)cur.pn * tstep;
    S.a_ready(cur);
    if constexpr (SP2) {
        PG8_STAGE(PG8_SB(0, 0), cB, voffB); PG8_STAGE(PG8_SB(0, 1), cB + hstep, voffB); PG8_STAGE(PG8_SA(0, 0), cA, voffA); PG8_STAGE(PG8_SA(0, 1), cA + hstep, voffA);
        if (wr == 1) PG8_BAR;
        PG8_WAIT_V(2); PG8_BAR;
        PG8_STAGE(PG8_SB(1, 0), cB + kstep, voffB); PG8_STAGE(PG8_SA(1, 0), cA + kstep, voffA); PG8_STAGE(PG8_SB(1, 1), cB + hstep + kstep, voffB);
        PG8_WAIT_V(6); PG8_BAR;
    } else {
        PG8_STAGE(PG8_SB(0, 0), cB, voffB); PG8_STAGE(PG8_SA(0, 0), cA, voffA); PG8_STAGE(PG8_SB(0, 1), cB + hstep, voffB); PG8_STAGE(PG8_SA(0, 1), cA + hstep, voffA);
        if (wr == 1) PG8_BAR;
        PG8_WAIT_V(4); PG8_BAR;
        PG8_STAGE(PG8_SB(1, 0), cB + kstep, voffB); PG8_STAGE(PG8_SA(1, 0), cA + kstep, voffA); PG8_STAGE(PG8_SB(1, 1), cB + hstep + kstep, voffB);
        PG8_WAIT_V(6); PG8_BAR;
    }
    for (;;) {
        const bool has_next = S.next(ui + 1, nxt);
        const char* nA = has_next ? (const char*)g.A + (size_t)nxt.pm * tstep : cA; const char* nB = has_next ? (const char*)g.Bt + (size_t)nxt.pn * tstep : cB;
        for (int t = 0; t < nt; t += 2) {
            const bool last = (t == nt - 2);
            const char* a1 = cA + (size_t)(t + 1) * kstep;
            const char* a2 = last ? nA : cA + (size_t)(t + 2) * kstep; const char* b2 = last ? nB : cB + (size_t)(t + 2) * kstep;
            const char* a3 = a2 + kstep; const char* b3 = b2 + kstep;
            if (last && has_next) S.a_ready(nxt);
            if constexpr (SP2) {
            PG8_LDB(B0, 0, 0); PG8_LDB(B1, 0, 1); PG8_SCHED; PG8_LDA(At, 0, 0); PG8_STAGE(PG8_SA(1, 1), a1 + hstep, voffA);
            PG8_WAIT_V(8); PG8_WAIT_L(0); PG8_BAR; PG8_MMA(0, 0, At, B0); PG8_MMA(0, 1, At, B1); PG8_BAR; PG8_SCHED;
            PG8_LDA(At, 0, 1); PG8_STAGE(PG8_SB(0, 0), b2, voffB); PG8_STAGE(PG8_SB(0, 1), b2 + hstep, voffB); PG8_STAGE(PG8_SA(0, 0), a2, voffA);
            PG8_WAIT_V(8); PG8_WAIT_L(0); PG8_BAR; PG8_MMA(1, 0, At, B0); PG8_MMA(1, 1, At, B1); PG8_BAR; PG8_SCHED;
            PG8_LDB(B0, 1, 0); PG8_LDB(B1, 1, 1); PG8_SCHED; PG8_LDA(At, 1, 0); PG8_STAGE(PG8_SA(0, 1), a2 + hstep, voffA);
            PG8_WAIT_V(8); PG8_WAIT_L(0); PG8_BAR; PG8_MMA(0, 0, At, B0); PG8_MMA(0, 1, At, B1); PG8_BAR; PG8_SCHED;
            PG8_LDA(At, 1, 1); PG8_STAGE(PG8_SB(1, 0), b3, voffB); PG8_STAGE(PG8_SB(1, 1), b3 + hstep, voffB); PG8_STAGE(PG8_SA(1, 0), a3, voffA);
            PG8_WAIT_V(8); PG8_WAIT_L(0); PG8_BAR; PG8_MMA(1, 0, At, B0); PG8_MMA(1, 1, At, B1); PG8_BAR; PG8_SCHED;
            } else {
            PG8_LDB(B0, 0, 0); PG8_SCHED; PG8_LDA(At, 0, 0); PG8_STAGE(PG8_SA(1, 1), a1 + hstep, voffA);
            PG8_WAIT_L(8); PG8_BAR; PG8_WAIT_L(0); PG8_MMA(0, 0, At, B0); PG8_BAR; PG8_SCHED;
            PG8_LDB(B1, 0, 1); PG8_STAGE(PG8_SB(0, 0), b2, voffB);
            PG8_BAR; PG8_WAIT_L(0); PG8_MMA(0, 1, At, B1); PG8_BAR;
            PG8_LDA(At, 0, 1); PG8_STAGE(PG8_SA(0, 0), a2, voffA);
            PG8_BAR; PG8_WAIT_L(0); PG8_MMA(1, 0, At, B0); PG8_BAR; PG8_SCHED;
            PG8_STAGE(PG8_SB(0, 1), b2 + hstep, voffB);
            PG8_WAIT_V(6); PG8_BAR; PG8_MMA(1, 1, At, B1); PG8_BAR;
            PG8_LDB(B0, 1, 0); PG8_SCHED; PG8_LDA(At, 1, 0); PG8_STAGE(PG8_SA(0, 1), a2 + hstep, voffA);
            PG8_WAIT_L(8); PG8_BAR; PG8_WAIT_L(0); PG8_MMA(0, 0, At, B0); PG8_BAR; PG8_SCHED;
            PG8_LDB(B1, 1, 1); PG8_STAGE(PG8_SB(1, 0), b3, voffB);
            PG8_BAR; PG8_WAIT_L(0); PG8_MMA(0, 1, At, B1); PG8_BAR;
            PG8_LDA(At, 1, 1); PG8_STAGE(PG8_SA(1, 0), a3, voffA);
            PG8_BAR; PG8_WAIT_L(0); PG8_MMA(1, 0, At, B0); PG8_BAR; PG8_SCHED;
            PG8_STAGE(PG8_SB(1, 1), b3 + hstep, voffB);
            PG8_WAIT_V(6); PG8_BAR; PG8_MMA(1, 1, At, B1); PG8_BAR;
            }
        }
        if constexpr (ALIGN_EPI) { if (wr == 0) PG8_BAR; }
        if constexpr (!Epi::AFTER_DRAIN) { E(acc, cur, wr, wc, fr, fq); S.done(cur); }
        if (!has_next) break;
#pragma unroll
        for (int a = 0; a < 2; ++a)
#pragma unroll
            for (int b = 0; b < 2; ++b)
#pragma unroll
                for (int m = 0; m < 4; ++m)
#pragma unroll
                    for (int n = 0; n < 2; ++n) acc[a][b][m][n] = (f32x4){0.f, 0.f, 0.f, 0.f};
        cur = nxt; cA = nA; cB = nB; ++ui;
        if constexpr (ALIGN_EPI) { if (wr == 1) PG8_BAR; }
    }
    PG8_WAIT_V(0);
    if constexpr (!ALIGN_EPI) { if (wr == 0) PG8_BAR; }
    PG8_BAR;
    if constexpr (Epi::AFTER_DRAIN) { E.fused(acc, cur, wr, wc, fr, fq, lds, wid, lane); S.done(cur); }
#undef PG8_SA
#undef PG8_SB
#undef PG8_STAGE
#undef PG8_LDA
#undef PG8_LDB
#undef PG8_MMA
#undef PG8_WAIT_V
#undef PG8_WAIT_L
#undef PG8_BAR
#undef PG8_SCHED
}
}

using pg8::bf16_t; using pg8::bf16x8; using pg8::f32x4; using pg8::u32x4; using pg8::Unit;
#define LAS __attribute__((address_space(3)))
typedef unsigned u32x2 __attribute__((ext_vector_type(2)));
typedef short s16x4 __attribute__((ext_vector_type(4)));

constexpr float EPS = 1e-6f;
constexpr float LOG2E = 1.4426950408889634f;
constexpr int D = 1024, MP = 32768, MS = 512, MT = 33280, SEQ = 2048, DEC = 32, TKS = 2080, KVR = 66048, DFF = 2816;
constexpr size_t O_Y = 0;
constexpr size_t O_RSP = (size_t)MT * D;
constexpr size_t RS_ONE = (size_t)16 * 4 * 256 * 512;
constexpr size_t O_RSS = O_RSP + 2 * RS_ONE;
constexpr size_t O_LATP = O_RSS + 2 * RS_ONE;
constexpr size_t O_KRP = O_LATP + (size_t)MP * 256;
constexpr size_t O_LATS = O_KRP + (size_t)MP * 64;
constexpr size_t O_KRS = O_LATS + (size_t)MS * 256;
constexpr size_t O_FKP = O_KRS + (size_t)MS * 64;
constexpr size_t O_FVP = O_FKP + (size_t)MP * 1024;
constexpr size_t O_FLP = O_FVP + (size_t)MP * 1024;
constexpr size_t O_FKS = O_FLP + (size_t)MP * 16;
constexpr size_t O_FVS = O_FKS + (size_t)MS * 1024;
constexpr size_t O_FLS = O_FVS + (size_t)MS * 1024;
constexpr size_t O_END = O_FLS + (size_t)MS * 16;
constexpr size_t MiB = (size_t)1 << 20;
constexpr size_t WS_W = 0, WS_HBA = 140 * MiB, WS_SSQ = 206 * MiB, WS_CQSS = 211 * MiB, WS_ROPE = 213 * MiB, WS_ROPEM = 216 * MiB, WS_FP = 217 * MiB, WS_FS = 219 * MiB + 512 * 1024, WS_POOL = 222 * MiB;
constexpr size_t WS_HBB = WS_POOL + 400 * MiB;
constexpr size_t WS_BAR = 212 * MiB;
constexpr size_t WS_NEED = WS_POOL + 628 * MiB;
constexpr size_t PL_RPROJ = WS_POOL, PL_ROBUF = WS_POOL + 470 * MiB;
constexpr size_t PL_ACT = WS_POOL, PL_PB = WS_POOL + 180 * MiB, PL_PP = WS_POOL + 200 * MiB;
constexpr size_t PL_LATB = WS_POOL, PL_KRB = WS_POOL + 33 * MiB, PL_CQB = WS_POOL + 42 * MiB, PL_KVH = WS_POOL + 76 * MiB, PL_MO = WS_POOL + 470 * MiB;
constexpr size_t PL_FPROJ = WS_POOL, PL_FKALL = WS_POOL + 260 * MiB, PL_FVALL = WS_POOL + 325 * MiB, PL_FO = WS_POOL + 470 * MiB;
constexpr size_t W_RI = 0, SZ_RI = (size_t)6144 * 1024;
constexpr size_t W_RO = W_RI + 2 * SZ_RI, SZ_RO = (size_t)1024 * 2048;
constexpr size_t W_MI = W_RO + 2 * SZ_RO;
constexpr size_t W_QB = W_MI + (size_t)1024 * 1024;
constexpr size_t W_KVB = W_QB + (size_t)3072 * 512;
constexpr size_t W_MO = W_KVB + (size_t)4096 * 256;
constexpr size_t W_FI = W_MO + (size_t)1024 * 2048;
constexpr size_t W_FO = W_FI + (size_t)4352 * 1024;
constexpr size_t W_GU = W_FO + (size_t)1024 * 1024, SZ_GU = (size_t)5632 * 1024;
constexpr size_t W_DN = W_GU + 4 * SZ_GU, SZ_DN = (size_t)1024 * 2816;
constexpr size_t W_PG = W_DN + 4 * SZ_DN, SZ_PG = (size_t)1024 * 1024;
constexpr size_t W_PP = W_PG + 4 * SZ_PG, SZ_PP = (size_t)1024 * 256;
constexpr size_t W_END = W_PP + 4 * SZ_PP;
static_assert(W_END * 2 <= 140 * MiB, "weights region");
constexpr int LDS_BYTES = 163840;
constexpr int XR_OFF = 131072;

struct Params { const float* in[37]; float* out; unsigned char* ws; int ph_lo, ph_hi; };
typedef const __attribute__((address_space(4))) Params* KP;
__device__ __forceinline__ KP kp() { KP p = (KP)__builtin_amdgcn_kernarg_segment_ptr(); asm volatile("" : "+s"(p)); return p; }
#define PIN(k) (kp()->in[k])
#define POUT (kp()->out)
#define PWS (kp()->ws)

typedef float f32x2 __attribute__((ext_vector_type(2)));
typedef __bf16 bf16x2n __attribute__((ext_vector_type(2)));
__device__ __forceinline__ unsigned pk2(float lo, float hi) { const f32x2 v = {lo, hi}; return __builtin_bit_cast(unsigned, __builtin_convertvector(v, bf16x2n)); }
__device__ __forceinline__ unsigned f2bf(float f) { return pk2(f, 0.f) & 0xffffu; }
__device__ __forceinline__ float bf2f(unsigned short h) { return __builtin_bit_cast(float, (unsigned)h << 16); }
__device__ __forceinline__ float bflo(unsigned u) { return __builtin_bit_cast(float, u << 16); }
__device__ __forceinline__ float bfhi(unsigned u) { return __builtin_bit_cast(float, u & 0xffff0000u); }
__device__ __forceinline__ u32x2 pk4(f32x4 v) { u32x2 r; r.x = pk2(v[0], v[1]); r.y = pk2(v[2], v[3]); return r; }
__device__ __forceinline__ f32x4 up4(u32x2 w) { return (f32x4){bflo(w.x), bfhi(w.x), bflo(w.y), bfhi(w.y)}; }
__device__ __forceinline__ float wave_sum(float v) {
#pragma unroll
    for (int o = 1; o < 64; o <<= 1) v += __shfl_xor(v, o);
    return v;
}
__device__ __forceinline__ float fq_sum(float v) { v += __shfl_xor(v, 16); v += __shfl_xor(v, 32); return v; }
__device__ __forceinline__ float sigmoidf_(float x) { return __builtin_amdgcn_rcpf(1.f + __expf(-x)); }
__device__ __forceinline__ float dot4(f32x4 v) { return (v[0] * v[0] + v[1] * v[1]) + (v[2] * v[2] + v[3] * v[3]); }
__device__ __forceinline__ void lds_barrier() { asm volatile("s_waitcnt lgkmcnt(0)" ::: "memory"); __builtin_amdgcn_s_barrier(); asm volatile("" ::: "memory"); }
__device__ __forceinline__ int tok_pos(int r) { return r < MP ? (r & (SEQ - 1)) : SEQ + ((r - MP) & (DEC - 1)); }
__device__ __forceinline__ int kv_row(int r) { return r < MP ? r : MP + ((r - MP) >> 5) * TKS + SEQ + ((r - MP) & 31); }
__device__ __forceinline__ float row_rstd(const float* ssq, int row, float invdim) {
    const f32x4 v = *(const f32x4*)(ssq + (size_t)row * 4);
    return rsqrtf(((v[0] + v[1]) + (v[2] + v[3])) * invdim + EPS);
}
#define EROW(u, ai, wr, m, fr) ((u).pm * 256 + (ai) * 128 + (wr) * 64 + (m) * 16 + (fr))
#define LROW(ai, wr, m, fr) ((ai) * 128 + (wr) * 64 + (m) * 16 + (fr))
#define ECOL(bj, wc, n, fq) ((bj) * 128 + (wc) * 32 + (n) * 16 + (fq) * 4)
typedef const f32x4 (&AccRef)[2][2][4][2];
#define EFENCE asm volatile("" ::: "memory")
#define RSV(ai, m) row_rstd(ssq, EROW(u, ai, wr, m, fr), 1.f / 1024.f)

struct EpiRetIn {
    static constexpr bool PERM = false, AFTER_DRAIN = false;
    const float* ssq; bf16_t* proj; const float* rope;
    __device__ __forceinline__ void operator()(AccRef acc, const Unit& u, int wr, int wc, int fr, int fq) const {
        float rs8[2][4];
#pragma unroll
        for (int ai = 0; ai < 2; ++ai)
#pragma unroll
            for (int m = 0; m < 4; ++m) rs8[ai][m] = row_rstd(ssq, EROW(u, ai, wr, m, fr), 1.f / 1024.f);
        const int pn = u.pn;
#pragma unroll
        for (int ai = 0; ai < 2; ++ai)
#pragma unroll
            for (int m = 0; m < 4; ++m) {
                const int r = EROW(u, ai, wr, m, fr); const float rs = rs8[ai][m];
                bf16_t* orow = proj + (size_t)r * 6144 + pn * 256 + wc * 32 + fq * 4;
                if (pn < 8) {
                    const float* tb = rope + (size_t)tok_pos(r) * 256 + wc * 32 + fq * 4; const float sc = pn >= 4 ? 0.0625f : 1.f;
#pragma unroll
                    for (int n = 0; n < 2; ++n) { const f32x4 c = *(const f32x4*)(tb + n * 16), s = *(const f32x4*)(tb + 128 + n * 16);
                        const f32x4 x1 = acc[ai][0][m][n] * rs, x2 = acc[ai][1][m][n] * rs;
                        *(u32x2*)(orow + n * 16) = pk4((x1 * c - x2 * s) * sc); *(u32x2*)(orow + 128 + n * 16) = pk4((x2 * c + x1 * s) * sc); }
                } else {
#pragma unroll
                    for (int bj = 0; bj < 2; ++bj)
#pragma unroll
                        for (int n = 0; n < 2; ++n) { f32x4 v = acc[ai][bj][m][n] * rs;
                            if (pn >= 16) { v[0] *= sigmoidf_(v[0]); v[1] *= sigmoidf_(v[1]); v[2] *= sigmoidf_(v[2]); v[3] *= sigmoidf_(v[3]); }
                            *(u32x2*)(orow + bj * 128 + n * 16) = pk4(v); }
                }
            }
    }
};
struct EpiRes {
    static constexpr bool PERM = false, AFTER_DRAIN = false;
    const bf16_t* hin; bf16_t* hout; float* ssqw; LAS float* xr;
    __device__ __forceinline__ void operator()(AccRef acc, const Unit& u, int wr, int wc, int fr, int fq) const {
        LAS float* const xq = xr + (wr * 64 + fr) * 4; LAS float* const xw = xq + wc;
#pragma unroll
        for (int ai = 0; ai < 2; ++ai) {
            u32x2 hv[4][2][2];
#pragma unroll
            for (int m = 0; m < 4; ++m) { const size_t off = (size_t)EROW(u, ai, wr, m, fr) * D + u.pn * 256 + wc * 32 + fq * 4;
#pragma unroll
                for (int bj = 0; bj < 2; ++bj)
#pragma unroll
                    for (int n = 0; n < 2; ++n) hv[m][bj][n] = *(const u32x2*)(hin + off + bj * 128 + n * 16); }
#pragma unroll
            for (int m = 0; m < 4; ++m) {
                const int r = EROW(u, ai, wr, m, fr); const size_t off = (size_t)r * D + u.pn * 256 + wc * 32 + fq * 4; float ss = 0.f;
#pragma unroll
                for (int bj = 0; bj < 2; ++bj)
#pragma unroll
                    for (int n = 0; n < 2; ++n) { const size_t o = off + bj * 128 + n * 16; const f32x4 v = up4(hv[m][bj][n]) + acc[ai][bj][m][n];
                        const u32x2 pw = pk4(v); *(u32x2*)(hout + o) = pw; ss += dot4(up4(pw)); }
                ss = fq_sum(ss); if (fq == 0) xw[(ai * 128 + m * 16) * 4] = ss; EFENCE;
            }
        }
        lds_barrier();
        if (wc == 0 && fq == 0) {
#pragma unroll
            for (int ai = 0; ai < 2; ++ai)
#pragma unroll
                for (int m = 0; m < 4; ++m) { const f32x4 t = *(const LAS f32x4*)(xq + (ai * 128 + m * 16) * 4); ssqw[(size_t)EROW(u, ai, wr, m, fr) * 4 + u.pn] = (t[0] + t[1]) + (t[2] + t[3]); }
        }
    }
};
struct EpiGU {
    static constexpr bool PERM = false, AFTER_DRAIN = false;
    const float* ssq; bf16_t* act;
    __device__ __forceinline__ void operator()(AccRef acc, const Unit& u, int wr, int wc, int fr, int fq) const {
        float rs8[2][4];
#pragma unroll
        for (int ai = 0; ai < 2; ++ai)
#pragma unroll
            for (int m = 0; m < 4; ++m) rs8[ai][m] = row_rstd(ssq, EROW(u, ai, wr, m, fr), 1.f / 1024.f);
#pragma unroll
        for (int ai = 0; ai < 2; ++ai)
#pragma unroll
            for (int m = 0; m < 4; ++m) {
                const int r = EROW(u, ai, wr, m, fr); const float rs = rs8[ai][m];
                bf16_t* orow = act + (size_t)r * DFF + u.pn * 128 + wc * 32 + fq * 4;
#pragma unroll
                for (int n = 0; n < 2; ++n) { const f32x4 g = acc[ai][0][m][n] * rs, up = acc[ai][1][m][n] * rs; f32x4 v;
                    v[0] = g[0] * sigmoidf_(g[0]) * up[0]; v[1] = g[1] * sigmoidf_(g[1]) * up[1]; v[2] = g[2] * sigmoidf_(g[2]) * up[2]; v[3] = g[3] * sigmoidf_(g[3]) * up[3];
                    *(u32x2*)(orow + n * 16) = pk4(v); }
            }
    }
};
struct EpiPlain {
    static constexpr bool PERM = false, AFTER_DRAIN = false;
    bf16_t* out; int ldc; const float* ssq; float invdim;
    __device__ __forceinline__ void operator()(AccRef acc, const Unit& u, int wr, int wc, int fr, int fq) const {
#pragma unroll
        for (int ai = 0; ai < 2; ++ai)
#pragma unroll
            for (int m = 0; m < 4; ++m) {
                const int r = EROW(u, ai, wr, m, fr); const float rs = ssq ? row_rstd(ssq, r, invdim) : 1.f;
                bf16_t* orow = out + (size_t)r * ldc + u.pn * 256 + wc * 32 + fq * 4;
#pragma unroll
                for (int bj = 0; bj < 2; ++bj)
#pragma unroll
                    for (int n = 0; n < 2; ++n) *(u32x2*)(orow + bj * 128 + n * 16) = pk4(acc[ai][bj][m][n] * rs);
            }
    }
};
struct EpiPE {
    static constexpr bool PERM = false, AFTER_DRAIN = false;
    const bf16_t* hin; const bf16_t* pp; bf16_t* hout; const float* ssq; float* ssqw; LAS float* xr;
    __device__ __forceinline__ void operator()(AccRef acc, const Unit& u, int wr, int wc, int fr, int fq) const {
        float rs8[2][4];
#pragma unroll
        for (int ai = 0; ai < 2; ++ai)
#pragma unroll
            for (int m = 0; m < 4; ++m) rs8[ai][m] = row_rstd(ssq, EROW(u, ai, wr, m, fr), 1.f / 1024.f);
        LAS float* const xq = xr + (wr * 64 + fr) * 4; LAS float* const xw = xq + wc;
#pragma unroll
        for (int ai = 0; ai < 2; ++ai)
#pragma unroll
            for (int m = 0; m < 4; ++m) {
                const int r = EROW(u, ai, wr, m, fr); const float rs = rs8[ai][m];
                const size_t off = (size_t)r * D + u.pn * 256 + wc * 32 + fq * 4; float ss = 0.f;
#pragma unroll
                for (int bj = 0; bj < 2; ++bj)
#pragma unroll
                    for (int n = 0; n < 2; ++n) { const size_t o = off + bj * 128 + n * 16; const f32x4 a = acc[ai][bj][m][n] * rs; const u32x2 pw = *(const u32x2*)(pp + o);
                        f32x4 v = up4(*(const u32x2*)(hin + o));
                        v[0] += sigmoidf_(a[0]) * bflo(pw.x); v[1] += sigmoidf_(a[1]) * bfhi(pw.x); v[2] += sigmoidf_(a[2]) * bflo(pw.y); v[3] += sigmoidf_(a[3]) * bfhi(pw.y);
                        const u32x2 ow = pk4(v); *(u32x2*)(hout + o) = ow; ss += dot4(up4(ow)); }
                ss = fq_sum(ss); if (fq == 0) xw[(ai * 128 + m * 16) * 4] = ss;
            }
        lds_barrier();
        if (wc == 0 && fq == 0) {
#pragma unroll
            for (int ai = 0; ai < 2; ++ai)
#pragma unroll
                for (int m = 0; m < 4; ++m) { const f32x4 t = *(const LAS f32x4*)(xq + (ai * 128 + m * 16) * 4); ssqw[(size_t)EROW(u, ai, wr, m, fr) * 4 + u.pn] = (t[0] + t[1]) + (t[2] + t[3]); }
        }
    }
};
struct EpiMlaIn {
    static constexpr bool PERM = false, AFTER_DRAIN = false;
    const float* ssq; unsigned char* ws; float* out; const float* kvn; const float* gkr; LAS float* xr;
    __device__ __forceinline__ void operator()(AccRef acc, const Unit& u, int wr, int wc, int fr, int fq) const {
        LAS float* const xq = xr + (wr * 64 + fr) * 4; LAS float* const xw = xq + wc;
        const int pn = u.pn;
        bf16_t* const cqb = (bf16_t*)(ws + PL_CQB); float* const cqss = (float*)(ws + WS_CQSS); bf16_t* const latb = (bf16_t*)(ws + PL_LATB); bf16_t* const krb = (bf16_t*)(ws + PL_KRB); const float* const ropem = (const float*)(ws + WS_ROPEM);
        if (pn < 2) {
#pragma unroll
            for (int ai = 0; ai < 2; ++ai)
#pragma unroll
                for (int m = 0; m < 4; ++m) { const int r = EROW(u, ai, wr, m, fr); bf16_t* orow = cqb + (size_t)r * 512 + pn * 256 + wc * 32 + fq * 4; float ss = 0.f;
#pragma unroll
                    for (int bj = 0; bj < 2; ++bj)
#pragma unroll
                        for (int n = 0; n < 2; ++n) { const f32x4 v = acc[ai][bj][m][n] * RSV(ai, m); ss += dot4(v); *(u32x2*)(orow + bj * 128 + n * 16) = pk4(v); }
                    ss = fq_sum(ss); if (fq == 0) xw[(ai * 128 + m * 16) * 4] = ss; EFENCE; }
            lds_barrier();
            if (wc == 0 && fq == 0) {
#pragma unroll
                for (int ai = 0; ai < 2; ++ai)
#pragma unroll
                    for (int m = 0; m < 4; ++m) { const f32x4 t = *(const LAS f32x4*)(xq + (ai * 128 + m * 16) * 4); float* cp = cqss + (size_t)EROW(u, ai, wr, m, fr) * 4; cp[pn] = (t[0] + t[1]) + (t[2] + t[3]); cp[2 + pn] = 0.f; }
            }
        } else if (pn == 2) {
#pragma unroll
            for (int ai = 0; ai < 2; ++ai)
#pragma unroll
                for (int m = 0; m < 4; ++m) { float ss = 0.f;
#pragma unroll
                    for (int bj = 0; bj < 2; ++bj)
#pragma unroll
                        for (int n = 0; n < 2; ++n) ss += dot4(acc[ai][bj][m][n] * RSV(ai, m));
                    ss = fq_sum(ss); if (fq == 0) xw[(ai * 128 + m * 16) * 4] = ss; EFENCE; }
            lds_barrier();
#pragma unroll
            for (int ai = 0; ai < 2; ++ai)
#pragma unroll
                for (int m = 0; m < 4; ++m) { const int r = EROW(u, ai, wr, m, fr); const f32x4 t = *(const LAS f32x4*)(xq + (ai * 128 + m * 16) * 4);
                    const float rk = rsqrtf(((t[0] + t[1]) + (t[2] + t[3])) * (1.f / 256.f) + EPS) * RSV(ai, m);
                    float* o32 = (r < MP ? out + O_LATP + (size_t)r * 256 : out + O_LATS + (size_t)(r - MP) * 256) + wc * 32 + fq * 4;
                    bf16_t* o16 = latb + (size_t)kv_row(r) * 256 + wc * 32 + fq * 4;
#pragma unroll
                    for (int bj = 0; bj < 2; ++bj)
#pragma unroll
                        for (int n = 0; n < 2; ++n) { const f32x4 g = *(const f32x4*)(kvn + ECOL(bj, wc, n, fq)); const f32x4 v = acc[ai][bj][m][n] * rk * g;
                            *(f32x4*)(o32 + bj * 128 + n * 16) = v; *(u32x2*)(o16 + bj * 128 + n * 16) = pk4(v); } EFENCE; }
        } else if (wc == 0) {
#pragma unroll
            for (int ai = 0; ai < 2; ++ai)
#pragma unroll
                for (int m = 0; m < 4; ++m) { const int r = EROW(u, ai, wr, m, fr); float ss = 0.f;
#pragma unroll
                    for (int n = 0; n < 2; ++n) ss += dot4(acc[ai][0][m][n] * RSV(ai, m)) + dot4(acc[ai][1][m][n] * RSV(ai, m));
                    ss = fq_sum(ss); const float rk = rsqrtf(ss * (1.f / 64.f) + EPS) * RSV(ai, m);
                    const float* tb = ropem + (size_t)tok_pos(r) * 64 + fq * 4;
                    float* o32 = (r < MP ? out + O_KRP + (size_t)r * 64 : out + O_KRS + (size_t)(r - MP) * 64) + fq * 4;
                    bf16_t* o16 = krb + (size_t)kv_row(r) * 64 + fq * 4;
#pragma unroll
                    for (int n = 0; n < 2; ++n) { const f32x4 g1 = *(const f32x4*)(gkr + n * 16 + fq * 4), g2 = *(const f32x4*)(gkr + 32 + n * 16 + fq * 4);
                        const f32x4 c = *(const f32x4*)(tb + n * 16), s = *(const f32x4*)(tb + 32 + n * 16);
                        const f32x4 y1 = acc[ai][0][m][n] * rk * g1, y2 = acc[ai][1][m][n] * rk * g2; const f32x4 z1 = y1 * c - y2 * s, z2 = y2 * c + y1 * s;
                        *(f32x4*)(o32 + n * 16) = z1; *(f32x4*)(o32 + 32 + n * 16) = z2; *(u32x2*)(o16 + n * 16) = pk4(z1); *(u32x2*)(o16 + 32 + n * 16) = pk4(z2); } EFENCE; }
        }
    }
};
struct EpiKV {
    static constexpr bool PERM = false, AFTER_DRAIN = false;
    bf16_t* kvh; LAS float* xr;
    __device__ __forceinline__ void operator()(AccRef acc, const Unit& u, int wr, int wc, int fr, int fq) const {
        LAS float* const xq = xr + (wr * 64 + fr) * 4; LAS float* const xw = xq + wc;
#pragma unroll
        for (int ai = 0; ai < 2; ++ai)
#pragma unroll
            for (int m = 0; m < 4; ++m) { float ss = dot4(acc[ai][0][m][0]) + dot4(acc[ai][0][m][1]); ss = fq_sum(ss); if (fq == 0) xw[(ai * 128 + m * 16) * 4] = ss; EFENCE; }
        lds_barrier();
#pragma unroll
        for (int ai = 0; ai < 2; ++ai)
#pragma unroll
            for (int m = 0; m < 4; ++m) { const int r = EROW(u, ai, wr, m, fr); const f32x4 t = *(const LAS f32x4*)(xq + (ai * 128 + m * 16) * 4);
                const float rk = rsqrtf(((t[0] + t[1]) + (t[2] + t[3])) * (1.f / 128.f) + EPS);
                bf16_t* orow = kvh + (size_t)r * 2048 + u.pn * 256 + wc * 32 + fq * 4;
#pragma unroll
                for (int n = 0; n < 2; ++n) { *(u32x2*)(orow + n * 16) = pk4(acc[ai][0][m][n] * rk); *(u32x2*)(orow + 128 + n * 16) = pk4(acc[ai][1][m][n]); } }
    }
};
struct EpiFoxIn {
    static constexpr bool PERM = false, AFTER_DRAIN = false;
    const float* ssq; unsigned char* ws; float* out; const float* gq; const float* gk; const float* bf; LAS float* xr;
    __device__ __forceinline__ void operator()(AccRef acc, const Unit& u, int wr, int wc, int fr, int fq) const {
        LAS float* const xq = xr + (wr * 64 + fr) * 4; LAS float* const xw = xq + wc;
        const int pn = u.pn;
        bf16_t* const proj = (bf16_t*)(ws + PL_FPROJ); bf16_t* const kall = (bf16_t*)(ws + PL_FKALL); bf16_t* const vall = (bf16_t*)(ws + PL_FVALL);
        if (pn < 8) {
#pragma unroll
            for (int ai = 0; ai < 2; ++ai)
#pragma unroll
                for (int m = 0; m < 4; ++m)
#pragma unroll
                    for (int bj = 0; bj < 2; ++bj) { float ss = dot4(acc[ai][bj][m][0] * RSV(ai, m)) + dot4(acc[ai][bj][m][1] * RSV(ai, m)); ss = fq_sum(ss);
                        if (fq == 0) xw[bj * 1024 + (ai * 128 + m * 16) * 4] = ss; EFENCE; }
            lds_barrier();
            const float* gg = pn < 4 ? gq : gk;
#pragma unroll
            for (int ai = 0; ai < 2; ++ai)
#pragma unroll
                for (int m = 0; m < 4; ++m) { const int r = EROW(u, ai, wr, m, fr);
#pragma unroll
                    for (int bj = 0; bj < 2; ++bj) { const f32x4 t = *(const LAS f32x4*)(xq + bj * 1024 + (ai * 128 + m * 16) * 4);
                        const float hs = wc < 2 ? t[0] + t[1] : t[2] + t[3]; const float rk = rsqrtf(hs * (1.f / 64.f) + EPS) * RSV(ai, m);
#pragma unroll
                        for (int n = 0; n < 2; ++n) { const f32x4 g = *(const f32x4*)(gg + (wc & 1) * 32 + n * 16 + fq * 4); const f32x4 v = acc[ai][bj][m][n] * rk * g;
                            const int ct = pn * 256 + ECOL(bj, wc, n, fq);
                            if (pn < 4) *(u32x2*)(proj + (size_t)r * 4096 + ct) = pk4(v);
                            else { const int ck = ct - 1024;
                                if (r < MP) { *(f32x4*)(out + O_FKP + (size_t)r * 1024 + ck) = v; *(u32x2*)(proj + (size_t)r * 4096 + ct) = pk4(v); }
                                else { const int rsm = r - MP; *(f32x4*)(out + O_FKS + (size_t)rsm * 1024 + ck) = v; *(u32x2*)(kall + ((size_t)(rsm >> 5) * TKS + SEQ + (rsm & 31)) * 1024 + ck) = pk4(v); } } } EFENCE; } }
        } else if (pn < 16) {
#pragma unroll
            for (int ai = 0; ai < 2; ++ai)
#pragma unroll
                for (int m = 0; m < 4; ++m) { const int r = EROW(u, ai, wr, m, fr);
#pragma unroll
                    for (int bj = 0; bj < 2; ++bj)
#pragma unroll
                        for (int n = 0; n < 2; ++n) { f32x4 v = acc[ai][bj][m][n] * RSV(ai, m); const int ct = pn * 256 + ECOL(bj, wc, n, fq);
                            if (pn < 12) { const int cv = ct - 2048;
                                if (r < MP) { *(f32x4*)(out + O_FVP + (size_t)r * 1024 + cv) = v; *(u32x2*)(proj + (size_t)r * 4096 + ct) = pk4(v); }
                                else { const int rsm = r - MP; *(f32x4*)(out + O_FVS + (size_t)rsm * 1024 + cv) = v; *(u32x2*)(vall + ((size_t)(rsm >> 5) * TKS + SEQ + (rsm & 31)) * 1024 + cv) = pk4(v); } }
                            else { v[0] = sigmoidf_(v[0]); v[1] = sigmoidf_(v[1]); v[2] = sigmoidf_(v[2]); v[3] = sigmoidf_(v[3]); *(u32x2*)(proj + (size_t)r * 4096 + ct) = pk4(v); } } EFENCE; }
        } else if (wc == 0) {
            const f32x4 b = *(const f32x4*)(bf + fq * 4);
#pragma unroll
            for (int ai = 0; ai < 2; ++ai)
#pragma unroll
                for (int m = 0; m < 4; ++m) { const int r = EROW(u, ai, wr, m, fr); const f32x4 x = acc[ai][0][m][0] * RSV(ai, m) + b; f32x4 v;
#pragma unroll
                    for (int e = 0; e < 4; ++e) v[e] = fminf(x[e], 0.f) - log1pf(__expf(-fabsf(x[e])));
                    float* o = (r < MP ? out + O_FLP + (size_t)r * 16 : out + O_FLS + (size_t)(r - MP) * 16) + fq * 4; *(f32x4*)o = v; }
        }
    }
};

struct WJob { const float* src; const float* src2; const float* gain; bf16_t* dst; int K, Nsrc, Ndst, map; };
__device__ __forceinline__ WJob get_job(int j) {
    bf16_t* W = (bf16_t*)(PWS + WS_W); WJob J; J.src2 = nullptr; J.gain = nullptr; J.map = 0;
    if (j < 2)       { J.src = PIN(14) + (size_t)j * 1024 * 6144; J.gain = PIN(10) + (size_t)(3 * j) * 1024; J.K = 1024; J.Nsrc = 6144; J.Ndst = 6144; J.dst = W + W_RI + j * SZ_RI; }
    else if (j < 4)  { const int i = j - 2; J.src = PIN(16) + (size_t)i * 2048 * 1024; J.K = 2048; J.Nsrc = 1024; J.Ndst = 1024; J.dst = W + W_RO + i * SZ_RO; }
    else if (j == 4) { J.src = PIN(17); J.gain = PIN(10) + 1024; J.K = 1024; J.Nsrc = 832; J.Ndst = 1024; J.map = 1; J.dst = W + W_MI; }
    else if (j == 5) { J.src = PIN(20); J.gain = PIN(18); J.K = 512; J.Nsrc = 3072; J.Ndst = 3072; J.dst = W + W_QB; }
    else if (j == 6) { J.src = PIN(21); J.K = 256; J.Nsrc = 4096; J.Ndst = 4096; J.dst = W + W_KVB; }
    else if (j == 7) { J.src = PIN(26); J.K = 2048; J.Nsrc = 1024; J.Ndst = 1024; J.dst = W + W_MO; }
    else if (j == 8) { J.src = PIN(27); J.gain = PIN(10) + 2048; J.K = 1024; J.Nsrc = 4112; J.Ndst = 4352; J.dst = W + W_FI; }
    else if (j == 9) { J.src = PIN(31); J.K = 1024; J.Nsrc = 1024; J.Ndst = 1024; J.dst = W + W_FO; }
    else if (j < 14) { const int i = j - 10; J.src = PIN(32) + (size_t)i * 1024 * DFF; J.src2 = PIN(33) + (size_t)i * 1024 * DFF; J.gain = PIN(11) + (size_t)i * 1024; J.K = 1024; J.Nsrc = DFF; J.Ndst = 5632; J.map = 2; J.dst = W + W_GU + i * SZ_GU; }
    else if (j < 18) { const int i = j - 14; J.src = PIN(34) + (size_t)i * DFF * 1024; J.K = DFF; J.Nsrc = 1024; J.Ndst = 1024; J.dst = W + W_DN + i * SZ_DN; }
    else if (j < 22) { const int i = j - 18; J.src = PIN(36) + (size_t)i * 1024 * 1024; J.gain = PIN(12) + (size_t)i * 1024; J.K = 1024; J.Nsrc = 1024; J.Ndst = 1024; J.dst = W + W_PG + i * SZ_PG; }
    else             { const int i = j - 22; J.src = PIN(35) + (size_t)i * 256 * 1024; J.K = 256; J.Nsrc = 1024; J.Ndst = 1024; J.dst = W + W_PP + i * SZ_PP; }
    return J;
}
__device__ __forceinline__ void wt_item2(const WJob& J, LAS float* scr, int itemA, int itemB, bool hasB, int lane) {
    const int nblk = J.Ndst / 32; int k0[2], n0[2]; const float* sp[2]; int col[2];
#pragma unroll
    for (int q = 0; q < 2; ++q) { const int item = q ? (hasB ? itemB : itemA) : itemA; const int kb = item / nblk, nb = item % nblk; k0[q] = 64 * kb; n0[q] = 32 * nb;
        const int n = n0[q] + (lane & 31); sp[q] = nullptr; col[q] = 0;
        if (J.map == 0) { if (n < J.Nsrc) { sp[q] = J.src; col[q] = n; } }
        else if (J.map == 1) { if (n < 768) { sp[q] = J.src; col[q] = n; } else { const int c = n - 768; if (c < 32) { sp[q] = J.src; col[q] = 768 + c; } else if (c >= 128 && c < 160) { sp[q] = J.src; col[q] = 800 + (c - 128); } } }
        else { const int pn = n >> 8, c = n & 255; if (c < 128) { sp[q] = J.src; col[q] = pn * 128 + c; } else { sp[q] = J.src2; col[q] = pn * 128 + c - 128; } } }
    float v[2][32];
#pragma unroll
    for (int q = 0; q < 2; ++q)
#pragma unroll
        for (int i = 0; i < 32; ++i) { const int kk = 2 * i + (lane >> 5); float x = sp[q] ? sp[q][(size_t)(k0[q] + kk) * J.Nsrc + col[q]] : 0.f; if (J.gain) x *= J.gain[k0[q] + kk]; v[q][i] = x; }
#pragma unroll
    for (int q = 0; q < 2; ++q)
#pragma unroll
        for (int i = 0; i < 32; ++i) { const int kk = 2 * i + (lane >> 5); scr[q * 2112 + kk * 33 + (lane & 31)] = v[q][i]; }
    asm volatile("s_waitcnt lgkmcnt(0)" ::: "memory");
    const int c = lane & 7;
#pragma unroll
    for (int q = 0; q < 2; ++q) { if (q == 0 || hasB) {
#pragma unroll
        for (int j = 0; j < 4; ++j) { const int nn = (lane >> 3) + 8 * j; const LAS float* s = scr + q * 2112 + (8 * c) * 33 + nn;
            u32x4 o; o.x = pk2(s[0 * 33], s[1 * 33]); o.y = pk2(s[2 * 33], s[3 * 33]); o.z = pk2(s[4 * 33], s[5 * 33]); o.w = pk2(s[6 * 33], s[7 * 33]);
            *(u32x4*)(J.dst + (size_t)(n0[q] + nn) * J.K + k0[q] + 8 * c) = o; } } }
    asm volatile("s_waitcnt lgkmcnt(0)" ::: "memory");
}
__device__ __forceinline__ void phase_prologue(LAS unsigned char* lds) {
    int tid_o = threadIdx.x; asm volatile("" : "+v"(tid_o)); const int tid = tid_o, lane = tid & 63, wave = __builtin_amdgcn_readfirstlane(tid >> 6);
    const int gw = blockIdx.x * 8 + wave, NGW = gridDim.x * 8;
    LAS float* scr = (LAS float*)(lds + wave * 17408);
    int base = 0;
    for (int j = 0; j < 26; ++j) { const WJob J = get_job(j); const int cnt = (J.K / 64) * (J.Ndst / 32);
        int first = (gw - base) % NGW; if (first < 0) first += NGW;
        for (int it = first; it < cnt; it += 2 * NGW) wt_item2(J, scr, it, it + NGW, it + NGW < cnt, lane);
        base += cnt; }
    { float* tr = (float*)(PWS + WS_ROPE); float* tm = (float*)(PWS + WS_ROPEM); const int gt = blockIdx.x * 512 + tid, NT = gridDim.x * 512;
        for (int i = gt; i < TKS * 128 + TKS * 32; i += NT) {
            int pos, j, half; if (i < TKS * 128) { pos = i >> 7; j = i & 127; half = 128; } else { const int k = i - TKS * 128; pos = k >> 5; j = k & 31; half = 32; }
            const float inv = exp2f(-(float)j / (float)half * 13.287712379549449f);
            const float ang = (float)pos * inv; double rev = (double)ang * 0.15915494309189535; rev -= floor(rev); const float rf = (float)rev;
            const float c = __builtin_amdgcn_cosf(rf), s = __builtin_amdgcn_sinf(rf);
            if (half == 128) { tr[(size_t)pos * 256 + j] = c; tr[(size_t)pos * 256 + 128 + j] = s; } else { tm[(size_t)pos * 64 + j] = c; tm[(size_t)pos * 64 + 32 + j] = s; } } }
    { bf16_t* hb = (bf16_t*)(PWS + WS_HBB); float* ssq = (float*)(PWS + WS_SSQ);
        for (int r = gw; r < MT; r += NGW) { const float* x = r < MP ? PIN(0) + (size_t)r * D : PIN(1) + (size_t)(r - MP) * D; float s = 0.f;
#pragma unroll
            for (int j = 0; j < 4; ++j) { const f32x4 v = *(const f32x4*)(x + (lane + 64 * j) * 4); const u32x2 pw = pk4(v); *(u32x2*)(hb + (size_t)r * D + (lane + 64 * j) * 4) = pw; s += dot4(up4(pw)); }
            s = wave_sum(s); if (lane < 4) ssq[(size_t)r * 4 + lane] = lane == 0 ? s : 0.f; } }
}
__device__ __forceinline__ void cvt_chunks(const float* __restrict__ src, bf16_t* __restrict__ dst, size_t n8) {
    int tid_o = threadIdx.x; asm volatile("" : "+v"(tid_o)); const size_t gt = (size_t)blockIdx.x * 512 + tid_o, NT = (size_t)gridDim.x * 512;

    for (size_t i = gt; i < n8; i += NT) { const f32x4 a = *(const f32x4*)(src + i * 8), b = *(const f32x4*)(src + i * 8 + 4); u32x4 o; o.x = pk2(a[0], a[1]); o.y = pk2(a[2], a[3]); o.z = pk2(b[0], b[1]); o.w = pk2(b[2], b[3]); *(u32x4*)(dst + i * 8) = o; }
}
template <int width> __device__ __forceinline__ void cvt_cache(const float* __restrict__ src, bf16_t* __restrict__ dst) {
    constexpr int cpr = width / 8; const size_t n8 = (size_t)16 * 2048 * cpr;
    int tid_o = threadIdx.x; asm volatile("" : "+v"(tid_o)); const size_t gt = (size_t)blockIdx.x * 512 + tid_o, NT = (size_t)gridDim.x * 512;

    for (size_t i = gt; i < n8; i += NT) { const size_t row = i / cpr; const int ch = (int)(i % cpr); const size_t b = row >> 11, t = row & 2047;
        const float* s = src + row * width + ch * 8; const f32x4 a = *(const f32x4*)s, c = *(const f32x4*)(s + 4); u32x4 o; o.x = pk2(a[0], a[1]); o.y = pk2(a[2], a[3]); o.z = pk2(c[0], c[1]); o.w = pk2(c[2], c[3]);
        *(u32x4*)(dst + (b * TKS + t) * width + ch * 8) = o; }
}

struct AU { const bf16_t* Q; int qs; const bf16_t* K1; int k1s; const bf16_t* K2; int k2s; const bf16_t* V; int vs; bf16_t* O; int os; const bf16_t* G; int gs; const float* Fk;
            int q0, nq, off, Tk; };
struct MlaQ { const float* gqn; const float* gkn; const float* gqr; const float* ropem; };
template <int DK, int DV, int MODE>
__device__ __forceinline__ void attn_unit(LAS unsigned char* lds, const AU& a, const MlaQ& mq) {
    constexpr int KS = (DK + 8) * 2, VS = (DV + 16) * 2  , NS = DK / 32, NDB = DV / 16, KC = DK / 8, VC = DV / 8, KCH = 64 * KC / 512, VCH = 64 * VC / 512;
    constexpr int VOFF = 64 * KS, FOFF = VOFF + 64 * VS;
    int tid_o = threadIdx.x; asm volatile("" : "+v"(tid_o)); const int tid = tid_o, w = __builtin_amdgcn_readfirstlane(tid >> 6), lane = tid & 63, li = lane & 15, g = lane >> 4;
    const float cs = (MODE == 0 ? 0.07216878364870322f : 0.125f) * LOG2E;
    const bool active = 32 * w < a.nq;
    const int wq0 = a.q0 + 32 * w, rmax = a.q0 + a.nq - 1;
    bf16x8 qf[2][NS];
#pragma unroll
    for (int blk = 0; blk < 2; ++blk) { int row = wq0 + 16 * blk + li; row = row < rmax ? row : rmax; const bf16_t* qp = a.Q + (size_t)row * a.qs + 8 * g;
#pragma unroll
        for (int s = 0; s < NS; ++s) qf[blk][s] = *(const bf16x8*)(qp + 32 * s);
        if (MODE == 0) {
            float x[NS][8];
#pragma unroll
            for (int s = 0; s < NS; ++s)
#pragma unroll
                for (int j = 0; j < 8; ++j) x[s][j] = bf2f((unsigned short)qf[blk][s][j]);
            float ss = 0.f;
#pragma unroll
            for (int s = 0; s < 4; ++s)
#pragma unroll
                for (int j = 0; j < 8; ++j) ss += x[s][j] * x[s][j];
            ss = fq_sum(ss); const float rn = rsqrtf(ss * (1.f / 128.f) + EPS);
#pragma unroll
            for (int s = 0; s < 4; ++s)
{ const f32x4 ga = *(const f32x4*)(mq.gqn + 32 * s + 8 * g), gb = *(const f32x4*)(mq.gqn + 32 * s + 8 * g + 4), ha = *(const f32x4*)(mq.gkn + 32 * s + 8 * g), hb_ = *(const f32x4*)(mq.gkn + 32 * s + 8 * g + 4);
#pragma unroll
                  for (int j = 0; j < 4; ++j) { x[s][j] *= rn * ga[j] * ha[j]; x[s][4 + j] *= rn * gb[j] * hb_[j]; } }
            float sr = 0.f;
#pragma unroll
            for (int j = 0; j < 8; ++j) sr += x[4][j] * x[4][j] + x[5][j] * x[5][j];
            sr = fq_sum(sr); const float rr = rsqrtf(sr * (1.f / 64.f) + EPS);
            const float* tb = mq.ropem + (size_t)(a.off + row) * 64;
#pragma unroll
            for (int j = 0; j < 8; ++j) { const int dj = 8 * g + j; const float y1 = x[4][j] * rr * mq.gqr[dj], y2 = x[5][j] * rr * mq.gqr[32 + dj]; const float c = tb[dj], s = tb[32 + dj];
                x[4][j] = y1 * c - y2 * s; x[5][j] = y2 * c + y1 * s; }
#pragma unroll
            for (int s = 0; s < NS; ++s)
#pragma unroll
                for (int j = 0; j < 8; ++j) qf[blk][s][j] = (short)f2bf(x[s][j]);
        }
    }
    constexpr int QOFF = ((FOFF + 256 + 15) / 16) * 16;
    LAS unsigned char* qlds = lds + QOFF + w * (2 * NS * 1024) + lane * 16;
    if (MODE == 0) {
#pragma unroll
        for (int blk = 0; blk < 2; ++blk)
#pragma unroll
            for (int s = 0; s < NS; ++s) *(LAS bf16x8*)(qlds + (blk * NS + s) * 1024) = qf[blk][s];
    }
    const int last_pos = a.off + a.q0 + a.nq - 1;
    const int kend = MODE == 0 ? (((last_pos >> 6) + 1) * 64 < a.Tk ? ((last_pos >> 6) + 1) * 64 : a.Tk) : last_pos + 1;
    const int nt = (kend + 63) >> 6;
    f32x4 o[2][NDB]; float mrow[2], lrow[2];
#pragma unroll
    for (int blk = 0; blk < 2; ++blk) { mrow[blk] = -INFINITY; lrow[blk] = 0.f;
#pragma unroll
        for (int db = 0; db < NDB; ++db) o[blk][db] = (f32x4){0.f, 0.f, 0.f, 0.f}; }
    u32x4 kreg[2][KCH], vreg[2][VCH]; float freg[2] = {0.f, 0.f};
#define ATT_PREFETCH(t, P_) do { \
        _Pragma("unroll") for (int c_ = 0; c_ < KCH; ++c_) { const int id = tid + 512 * c_, key = id / KC, ch = id % KC; int kr_ = 64 * (t) + key; kr_ = kr_ < a.Tk ? kr_ : a.Tk - 1; \
            const bf16_t* p_ = (MODE == 0 && ch >= 16) ? a.K2 + (size_t)kr_ * a.k2s + (ch - 16) * 8 : a.K1 + (size_t)kr_ * a.k1s + ch * 8; kreg[P_][c_] = *(const u32x4*)p_; } \
        _Pragma("unroll") for (int c_ = 0; c_ < VCH; ++c_) { const int id = tid + 512 * c_, key = id / VC, ch = id % VC; int kr_ = 64 * (t) + key; kr_ = kr_ < a.Tk ? kr_ : a.Tk - 1; \
            vreg[P_][c_] = *(const u32x4*)(a.V + (size_t)kr_ * a.vs + ch * 8); } \
        if (MODE == 1) { int kr_ = 64 * (t) + (tid & 63); kr_ = kr_ < a.Tk ? kr_ : a.Tk - 1; freg[P_] = a.Fk[kr_]; } } while (0)
    ATT_PREFETCH(0, 0); if (nt > 1) ATT_PREFETCH(1, 1);
    const int wlo = a.off + wq0, whi = wlo + 31;
    for (int t0 = 0; t0 < nt; t0 += 2) {
#pragma unroll
      for (int P = 0; P < 2; ++P) { const int t = t0 + P; if (t < nt) {
        lds_barrier();
#pragma unroll
        for (int c_ = 0; c_ < KCH; ++c_) { const int id = tid + 512 * c_, key = id / KC, ch = id % KC; *(LAS u32x4*)(lds + key * KS + ch * 16) = kreg[P][c_]; }
#pragma unroll
        for (int c_ = 0; c_ < VCH; ++c_) { const int id = tid + 512 * c_, key = id / VC, ch = id % VC; *(LAS u32x4*)(lds + VOFF + key * VS + ch * 16) = vreg[P][c_]; }
        if (MODE == 1 && tid < 64) *(LAS float*)(lds + FOFF + tid * 4) = freg[P];
        lds_barrier();
        if (t + 2 < nt) ATT_PREFETCH(t + 2, P);
        const bool skip = !active || (MODE == 0 ? (t > (whi >> 6)) : (64 * t > whi));
        if (!skip) {
            const bool needmask = __builtin_amdgcn_readfirstlane((int)((MODE == 1 && 64 * t + 63 > wlo) || (64 * t + 63 >= a.Tk))) != 0;
            f32x4 sa[2][4];
#pragma unroll
            for (int blk = 0; blk < 2; ++blk)
#pragma unroll
                for (int kb = 0; kb < 4; ++kb) sa[blk][kb] = (f32x4){0.f, 0.f, 0.f, 0.f};
            __builtin_amdgcn_s_setprio(1);
            if (MODE == 0) {
#pragma unroll
                for (int s = 0; s < NS; ++s) { const bf16x8 q0 = *(const LAS bf16x8*)(qlds + s * 1024), q1 = *(const LAS bf16x8*)(qlds + (NS + s) * 1024);
#pragma unroll
                    for (int kb = 0; kb < 4; ++kb) { const bf16x8 kf = *(const LAS bf16x8*)(lds + (16 * kb + li) * KS + (32 * s + 8 * g) * 2);
                        sa[0][kb] = __builtin_amdgcn_mfma_f32_16x16x32_bf16(kf, q0, sa[0][kb], 0, 0, 0);
                        sa[1][kb] = __builtin_amdgcn_mfma_f32_16x16x32_bf16(kf, q1, sa[1][kb], 0, 0, 0); }
                    }
            } else {
#pragma unroll
                for (int kb = 0; kb < 4; ++kb)
#pragma unroll
                    for (int s = 0; s < NS; ++s) { const bf16x8 kf = *(const LAS bf16x8*)(lds + (16 * kb + li) * KS + (32 * s + 8 * g) * 2);
                        sa[0][kb] = __builtin_amdgcn_mfma_f32_16x16x32_bf16(kf, qf[0][s], sa[0][kb], 0, 0, 0);
                        sa[1][kb] = __builtin_amdgcn_mfma_f32_16x16x32_bf16(kf, qf[1][s], sa[1][kb], 0, 0, 0); }
            }
            bf16x8 pf[2][2];
            __builtin_amdgcn_s_setprio(0);
#pragma unroll
            for (int kb = 0; kb < 4; ++kb) { f32x4 fk = (f32x4){0.f, 0.f, 0.f, 0.f}; if (MODE == 1) fk = *(const LAS f32x4*)(lds + FOFF + (16 * kb + 4 * g) * 4);
                sa[0][kb] = sa[0][kb] * cs - fk; sa[1][kb] = sa[1][kb] * cs - fk; }
            if (needmask) {
#pragma unroll
                for (int blk = 0; blk < 2; ++blk) { const int pos = wlo + 16 * blk + li;
#pragma unroll
                    for (int kb = 0; kb < 4; ++kb)
#pragma unroll
                        for (int i = 0; i < 4; ++i) { const int key = 64 * t + 16 * kb + 4 * g + i; const bool ok = key < a.Tk && (MODE == 0 ? ((key >> 6) <= (pos >> 6)) : (key <= pos)); sa[blk][kb][i] = ok ? sa[blk][kb][i] : -INFINITY; } }
            }
#pragma unroll
            for (int blk = 0; blk < 2; ++blk) {
                float mx = -INFINITY;
#pragma unroll
                for (int kb = 0; kb < 4; ++kb)
#pragma unroll
                    for (int i = 0; i < 4; ++i) mx = fmaxf(mx, sa[blk][kb][i]);
                mx = fmaxf(mx, __shfl_xor(mx, 16)); mx = fmaxf(mx, __shfl_xor(mx, 32));
                const float mnew = fmaxf(mrow[blk], mx); float rsum = 0.f;
                if (__builtin_amdgcn_ballot_w64(mnew > mrow[blk]) != 0ull) {
                    const float alpha = __builtin_amdgcn_exp2f(mrow[blk] - mnew); mrow[blk] = mnew; lrow[blk] *= alpha;
#pragma unroll
                    for (int db = 0; db < NDB; ++db) o[blk][db] = o[blk][db] * alpha;
                }
#pragma unroll
                for (int kb = 0; kb < 4; ++kb)
#pragma unroll
                    for (int i = 0; i < 4; ++i) { const float p = __builtin_amdgcn_exp2f(sa[blk][kb][i] - mnew); sa[blk][kb][i] = p; rsum += p; }
                lrow[blk] += rsum;
#pragma unroll
                for (int kk = 0; kk < 2; ++kk) { const f32x4 p0 = sa[blk][2 * kk], p1 = sa[blk][2 * kk + 1]; u32x4 pw; pw.x = pk2(p0[0], p0[1]); pw.y = pk2(p0[2], p0[3]); pw.z = pk2(p1[0], p1[1]); pw.w = pk2(p1[2], p1[3]);
                    pf[blk][kk] = __builtin_bit_cast(bf16x8, pw); }
            }
            __builtin_amdgcn_s_setprio(1);
#pragma unroll
            for (int kk = 0; kk < 2; ++kk)
#pragma unroll
                for (int db = 0; db < NDB; ++db) {
                    const unsigned ad = VOFF + (32 * kk + 4 * g + (li >> 2)) * VS + (16 * db + 4 * (li & 3)) * 2;
                    const s16x4 v0 = __builtin_amdgcn_ds_read_tr16_b64_v4i16((LAS s16x4*)(lds + ad)), v1 = __builtin_amdgcn_ds_read_tr16_b64_v4i16((LAS s16x4*)(lds + ad + 16 * VS));
                    bf16x8 vf; vf[0] = v0[0]; vf[1] = v0[1]; vf[2] = v0[2]; vf[3] = v0[3]; vf[4] = v1[0]; vf[5] = v1[1]; vf[6] = v1[2]; vf[7] = v1[3];
                    o[0][db] = __builtin_amdgcn_mfma_f32_16x16x32_bf16(vf, pf[0][kk], o[0][db], 0, 0, 0);
                    o[1][db] = __builtin_amdgcn_mfma_f32_16x16x32_bf16(vf, pf[1][kk], o[1][db], 0, 0, 0);  }
            __builtin_amdgcn_s_setprio(0);
        }
      } }
    }
#undef ATT_PREFETCH
    if (active) {
#pragma unroll
        for (int blk = 0; blk < 2; ++blk) { const int rl = 32 * w + 16 * blk + li; const float inv = 1.f / fq_sum(lrow[blk]);
            if (rl < a.nq) { const size_t row = (size_t)(a.q0 + rl);
#pragma unroll
                for (int db = 0; db < NDB; ++db) { f32x4 v = o[blk][db] * inv;
                    if (MODE == 1) { const u32x2 gw = *(const u32x2*)(a.G + row * a.gs + 16 * db + 4 * g); v[0] *= bflo(gw.x); v[1] *= bfhi(gw.x); v[2] *= bflo(gw.y); v[3] *= bfhi(gw.y); }
                    *(u32x2*)(a.O + row * a.os + 16 * db + 4 * g) = pk4(v); } } }
    }
}

constexpr int R_QS = 528, R_VS = 272, R_AS = 144, R_SS = 528;
constexpr int R_QOFF = 0, R_KOFF = 64 * R_QS, R_VOFF = 2 * 64 * R_QS, R_AOFF = R_VOFF + 64 * R_VS, R_SOFF = R_AOFF + 64 * R_AS, R_END = R_SOFF + 8 * 16 * R_SS;
static_assert(R_END <= LDS_BYTES, "retention LDS");
__device__ __forceinline__ void ret_unit(LAS unsigned char* lds, const bf16_t* proj, bf16_t* obuf, int row0, int L, int nchunks, int h, int sl, const float* s0, float* sout) {
    int tid_o = threadIdx.x; asm volatile("" : "+v"(tid_o)); const int tid = tid_o, w = __builtin_amdgcn_readfirstlane(tid >> 6), lane = tid & 63, li = lane & 15, g = lane >> 4;
    const int NLB = L >> 4, KM = L >> 5;
    const float lg2 = log2f(1.f - exp2f(-5.f - (float)h));
    const float cdec = exp2f(lg2 * (float)L);
    LAS unsigned char* sst = lds + R_SOFF + w * (16 * R_SS);
    f32x4 S[16];
#pragma unroll
    for (int blk = 0; blk < 16; ++blk) {
        if (s0) {
#pragma unroll
            for (int i = 0; i < 4; ++i) S[blk][i] = s0[(size_t)(16 * blk + 4 * g + i) * 512 + sl * 128 + 16 * w + li];
        } else S[blk] = (f32x4){0.f, 0.f, 0.f, 0.f};
        *(LAS u32x2*)(sst + li * R_SS + (16 * blk + 4 * g) * 2) = pk4(S[blk]);
    }
    const bf16_t* qb = proj + (size_t)row0 * 6144 + h * 256, *kb = qb + 1024, *vb = proj + (size_t)row0 * 6144 + 2048 + h * 512 + sl * 128;
    u32x4 qr[4], kr[4], vr[2];
#define RET_PREFETCH(c) do { const size_t rb = (size_t)(c) * L; \
        _Pragma("unroll") for (int i_ = 0; i_ < 4; ++i_) { const int id = tid + 512 * i_, r_ = id >> 5, ch = id & 31; const int rr = r_ < L ? r_ : L - 1; \
            qr[i_] = *(const u32x4*)(qb + (rb + rr) * 6144 + ch * 8); kr[i_] = *(const u32x4*)(kb + (rb + rr) * 6144 + ch * 8); } \
        _Pragma("unroll") for (int i_ = 0; i_ < 2; ++i_) { const int id = tid + 512 * i_, r_ = id >> 4, ch = id & 15; const int rr = r_ < L ? r_ : L - 1; \
            vr[i_] = *(const u32x4*)(vb + (rb + rr) * 6144 + ch * 8); } } while (0)
    RET_PREFETCH(0);
    for (int c = 0; c < nchunks; ++c) {
        lds_barrier();
#pragma unroll
        for (int i_ = 0; i_ < 4; ++i_) { const int id = tid + 512 * i_, r_ = id >> 5, ch = id & 31; *(LAS u32x4*)(lds + R_QOFF + r_ * R_QS + ch * 16) = qr[i_]; *(LAS u32x4*)(lds + R_KOFF + r_ * R_QS + ch * 16) = kr[i_]; }
#pragma unroll
        for (int i_ = 0; i_ < 2; ++i_) { const int id = tid + 512 * i_, r_ = id >> 4, ch = id & 15; *(LAS u32x4*)(lds + R_VOFF + r_ * R_VS + ch * 16) = vr[i_]; }
        lds_barrier();
        if (c + 1 < nchunks) RET_PREFETCH(c + 1);
        { const int lb = w >> 1;
#pragma unroll
            for (int mbi = 0; mbi < 2; ++mbi) { const int mb = 2 * (w & 1) + mbi;
                if (lb < NLB && mb < NLB) { f32x4 av = (f32x4){0.f, 0.f, 0.f, 0.f};
                    if (mb <= lb) {
#pragma unroll
                        for (int s = 0; s < 8; ++s) { const bf16x8 af = *(const LAS bf16x8*)(lds + R_QOFF + (16 * lb + li) * R_QS + (32 * s + 8 * g) * 2), bf = *(const LAS bf16x8*)(lds + R_KOFF + (16 * mb + li) * R_QS + (32 * s + 8 * g) * 2);
                            av = __builtin_amdgcn_mfma_f32_16x16x32_bf16(af, bf, av, 0, 0, 0); }
                    }
#pragma unroll
                    for (int i = 0; i < 4; ++i) { const int l = 16 * lb + 4 * g + i, mm = 16 * mb + li; const float dm = l >= mm ? exp2f(lg2 * (float)(l - mm)) : 0.f;
                        *(LAS unsigned short*)(lds + R_AOFF + l * R_AS + mm * 2) = (unsigned short)f2bf(av[i] * dm); } } } }
        lds_barrier();
        __builtin_amdgcn_sched_barrier(0);
        bf16x8 vf[2];
#pragma unroll
        for (int kk = 0; kk < 2; ++kk) { if (kk < KM) { const unsigned ad = R_VOFF + (32 * kk + 4 * g + (li >> 2)) * R_VS + (16 * w + 4 * (li & 3)) * 2;
                const s16x4 v0 = __builtin_amdgcn_ds_read_tr16_b64_v4i16((LAS s16x4*)(lds + ad)), v1 = __builtin_amdgcn_ds_read_tr16_b64_v4i16((LAS s16x4*)(lds + ad + 16 * R_VS));
                vf[kk][0] = v0[0]; vf[kk][1] = v0[1]; vf[kk][2] = v0[2]; vf[kk][3] = v0[3]; vf[kk][4] = v1[0]; vf[kk][5] = v1[1]; vf[kk][6] = v1[2]; vf[kk][7] = v1[3]; }
            else vf[kk] = (bf16x8){0, 0, 0, 0, 0, 0, 0, 0}; }
        f32x4 a1[4], a2[4];
#pragma unroll
        for (int lb = 0; lb < 4; ++lb) { a1[lb] = (f32x4){0.f, 0.f, 0.f, 0.f}; a2[lb] = (f32x4){0.f, 0.f, 0.f, 0.f}; }
#pragma unroll
        for (int kk = 0; kk < 2; ++kk) if (kk < KM) {
#pragma unroll
            for (int lb = 0; lb < 4; ++lb) if (lb < NLB) { const LAS unsigned char* ap = lds + R_AOFF + (16 * lb + li) * R_AS + (32 * kk + 4 * g) * 2;
                const u32x2 t0 = *(const LAS u32x2*)ap, t1 = *(const LAS u32x2*)(ap + 32); u32x4 tw; tw.x = t0.x; tw.y = t0.y; tw.z = t1.x; tw.w = t1.y;
                a1[lb] = __builtin_amdgcn_mfma_f32_16x16x32_bf16(vf[kk], __builtin_bit_cast(bf16x8, tw), a1[lb], 0, 0, 0); } }
#pragma unroll
        for (int s = 0; s < 8; ++s) { const bf16x8 sfr = *(const LAS bf16x8*)(sst + li * R_SS + (32 * s + 8 * g) * 2);
#pragma unroll
            for (int lb = 0; lb < 4; ++lb) if (lb < NLB) { const bf16x8 qf = *(const LAS bf16x8*)(lds + R_QOFF + (16 * lb + li) * R_QS + (32 * s + 8 * g) * 2);
                a2[lb] = __builtin_amdgcn_mfma_f32_16x16x32_bf16(sfr, qf, a2[lb], 0, 0, 0); } }
#pragma unroll
        for (int lb = 0; lb < 4; ++lb) if (lb < NLB) { const int l = 16 * lb + li; const float qd = exp2f(lg2 * (float)(l + 1));
            *(u32x2*)(obuf + ((size_t)row0 + (size_t)c * L + l) * 2048 + h * 512 + sl * 128 + 16 * w + 4 * g) = pk4(a1[lb] + a2[lb] * qd); }
        __builtin_amdgcn_sched_barrier(0);
        bf16x8 vd[2];
#pragma unroll
        for (int kk = 0; kk < 2; ++kk) {
#pragma unroll
            for (int j = 0; j < 8; ++j) { const int mm = 32 * kk + (j < 4 ? 4 * g + j : 16 + 4 * g + (j - 4)); const float kd = exp2f(lg2 * (float)(L - 1 - mm));
                vd[kk][j] = (short)f2bf(bf2f((unsigned short)vf[kk][j]) * kd); } }
#pragma unroll
        for (int blk = 0; blk < 16; ++blk) { f32x4 sv = S[blk] * cdec;
#pragma unroll
            for (int kk = 0; kk < 2; ++kk) if (kk < KM) { const unsigned ad = R_KOFF + (32 * kk + 4 * g + (li >> 2)) * R_QS + (16 * blk + 4 * (li & 3)) * 2;
                const s16x4 k0 = __builtin_amdgcn_ds_read_tr16_b64_v4i16((LAS s16x4*)(lds + ad)), k1 = __builtin_amdgcn_ds_read_tr16_b64_v4i16((LAS s16x4*)(lds + ad + 16 * R_QS));
                bf16x8 kf; kf[0] = k0[0]; kf[1] = k0[1]; kf[2] = k0[2]; kf[3] = k0[3]; kf[4] = k1[0]; kf[5] = k1[1]; kf[6] = k1[2]; kf[7] = k1[3];
                sv = __builtin_amdgcn_mfma_f32_16x16x32_bf16(kf, vd[kk], sv, 0, 0, 0); }
            S[blk] = sv;
            *(LAS u32x2*)(sst + li * R_SS + (16 * blk + 4 * g) * 2) = pk4(sv);
            if ((blk & 3) == 3) __builtin_amdgcn_sched_barrier(0); }
    }
#undef RET_PREFETCH
#pragma unroll
    for (int blk = 0; blk < 16; ++blk)
#pragma unroll
        for (int i = 0; i < 4; ++i) sout[(size_t)(16 * blk + 4 * g + i) * 512 + sl * 128 + 16 * w + li] = S[blk][i];
}
__device__ __forceinline__ void phase_ret_ln(int j) {
    int tid_o = threadIdx.x; asm volatile("" : "+v"(tid_o)); const int tid = tid_o, lane = tid & 63, wave = tid >> 6, gw = blockIdx.x * 8 + wave, NGW = gridDim.x * 8;
    bf16_t* obuf = (bf16_t*)(PWS + PL_ROBUF); const bf16_t* proj = (const bf16_t*)(PWS + PL_RPROJ); const float* gn = PIN(15) + (size_t)j * 2048;
    for (int it0 = gw; it0 < MT * 4; it0 += 2 * NGW) {
        u32x4 ow[2], gwd[2]; f32x4 g0[2], g1[2]; bf16_t* op[2]; bool ok[2];
#pragma unroll
        for (int q = 0; q < 2; ++q) { int it = it0 + q * NGW; ok[q] = it < MT * 4; it = ok[q] ? it : it0; const int r = it >> 2, h = it & 3; op[q] = obuf + (size_t)r * 2048 + h * 512 + lane * 8;
            ow[q] = *(const u32x4*)op[q]; gwd[q] = *(const u32x4*)(proj + (size_t)r * 6144 + 4096 + h * 512 + lane * 8);
            g0[q] = *(const f32x4*)(gn + h * 512 + lane * 8); g1[q] = *(const f32x4*)(gn + h * 512 + lane * 8 + 4); }
#pragma unroll
        for (int q = 0; q < 2; ++q) {
            float x[8] = {bflo(ow[q].x), bfhi(ow[q].x), bflo(ow[q].y), bfhi(ow[q].y), bflo(ow[q].z), bfhi(ow[q].z), bflo(ow[q].w), bfhi(ow[q].w)};
            const float sg[8] = {bflo(gwd[q].x), bfhi(gwd[q].x), bflo(gwd[q].y), bfhi(gwd[q].y), bflo(gwd[q].z), bfhi(gwd[q].z), bflo(gwd[q].w), bfhi(gwd[q].w)};
            float sm = 0.f;
#pragma unroll
            for (int e = 0; e < 8; ++e) sm += x[e];
            const float mu = wave_sum(sm) * (1.f / 512.f); float qv = 0.f;
#pragma unroll
            for (int e = 0; e < 8; ++e) { x[e] -= mu; qv += x[e] * x[e]; }
            const float rstd = rsqrtf(wave_sum(qv) * (1.f / 512.f) + EPS);
            u32x4 o; o.x = pk2(x[0] * rstd * g0[q][0] * sg[0], x[1] * rstd * g0[q][1] * sg[1]); o.y = pk2(x[2] * rstd * g0[q][2] * sg[2], x[3] * rstd * g0[q][3] * sg[3]);
            o.z = pk2(x[4] * rstd * g1[q][0] * sg[4], x[5] * rstd * g1[q][1] * sg[5]); o.w = pk2(x[6] * rstd * g1[q][2] * sg[6], x[7] * rstd * g1[q][3] * sg[7]);
            if (ok[q]) *(u32x4*)op[q] = o; } }
}
__device__ __forceinline__ void phase_fox_scan() {
    int tid_o = threadIdx.x; asm volatile("" : "+v"(tid_o)); const int tid = tid_o, lane = tid & 63, wave = tid >> 6, gw = blockIdx.x * 8 + wave, NGW = gridDim.x * 8;
    for (int it = gw; it < 512; it += NGW) { const int grp = it >> 8, bh = it & 255, b = bh >> 4, h = bh & 15; const int T = grp ? TKS : SEQ, per = grp ? 33 : 32;
        float* F = grp ? (float*)(PWS + WS_FS) + (size_t)bh * TKS : (float*)(PWS + WS_FP) + (size_t)bh * SEQ;
        const float* srcA = grp ? PIN(7) + (size_t)b * SEQ * 16 + h : POUT + O_FLP + (size_t)b * SEQ * 16 + h;
        const float* srcB = POUT + O_FLS + (size_t)b * DEC * 16 + h;
        const int t0 = lane * per; float v[33]; float s = 0.f;
#pragma unroll
        for (int e = 0; e < 33; ++e) { const int t = t0 + e; v[e] = (e < per && t < T) ? (t < SEQ ? srcA[(size_t)t * 16] : srcB[(size_t)(t - SEQ) * 16]) : 0.f; }
#pragma unroll
        for (int e = 0; e < 33; ++e) s += v[e];
        float inc = s;
#pragma unroll
        for (int o = 1; o < 64; o <<= 1) { const float n = __shfl_up(inc, o); if (lane >= o) inc += n; }
        float run = inc - s;
#pragma unroll
        for (int e = 0; e < 33; ++e) { const int t = t0 + e; run += v[e]; if (e < per && t < T) F[t] = run * LOG2E; } }
}
__device__ __forceinline__ void phase_final() {
    int tid_o = threadIdx.x; asm volatile("" : "+v"(tid_o)); const int tid = tid_o, lane = tid & 63, wave = tid >> 6, gw = blockIdx.x * 8 + wave, NGW = gridDim.x * 8; const float* gf = PIN(13);
    const bf16_t* hb = (const bf16_t*)(PWS + WS_HBB);
    for (int r = gw; r < MT; r += NGW) { float* y = POUT + O_Y + (size_t)r * D; f32x4 v[4]; float s = 0.f;
#pragma unroll
        for (int j = 0; j < 4; ++j) { v[j] = up4(*(const u32x2*)(hb + (size_t)r * D + (lane + 64 * j) * 4)); s += dot4(v[j]); }
        const float rstd = rsqrtf(wave_sum(s) * (1.f / 1024.f) + EPS);
#pragma unroll
        for (int j = 0; j < 4; ++j) *(f32x4*)(y + (lane + 64 * j) * 4) = v[j] * rstd * *(const f32x4*)(gf + (lane + 64 * j) * 4); }
}

template <int EPI>
__device__ __forceinline__ void sample_gemm(LAS unsigned char* lds, const bf16_t* A, const bf16_t* Bt, int K, const bf16_t* hin, bf16_t* hout, float* ssqw, const float* ssqr, const bf16_t* pp, bf16_t* outp) {
    int tid_o = threadIdx.x; asm volatile("" : "+v"(tid_o)); const int tid = tid_o, w = __builtin_amdgcn_readfirstlane(tid >> 6), lane = tid & 63, li = lane & 15, g = lane >> 4;
    LAS float* xs = (LAS float*)(lds + XR_OFF);
    for (int mu = blockIdx.x; mu < 128; mu += gridDim.x) {
        const int rsb = mu >> 2, pn = mu & 3, row = MP + 16 * rsb + li, kw = K >> 3;
        f32x4 acc[16];
#pragma unroll
        for (int cb = 0; cb < 16; ++cb) acc[cb] = (f32x4){0.f, 0.f, 0.f, 0.f};
        const bf16_t* ap = A + (size_t)row * K + w * kw + 8 * g;
        const bf16_t* bp = Bt + (size_t)(pn * 256 + li) * K + w * kw + 8 * g;
        bf16x8 a0 = *(const bf16x8*)ap, b0[16], a1, b1[16];
#pragma unroll
        for (int cb = 0; cb < 16; ++cb) b0[cb] = *(const bf16x8*)(bp + (size_t)cb * 16 * K);
        for (int ks = 0; ks < kw; ks += 64) {
            const bool h1 = ks + 32 < kw, h2 = ks + 64 < kw;
            if (h1) { a1 = *(const bf16x8*)(ap + ks + 32);
#pragma unroll
                for (int cb = 0; cb < 16; ++cb) b1[cb] = *(const bf16x8*)(bp + (size_t)cb * 16 * K + ks + 32); }
#pragma unroll
            for (int cb = 0; cb < 16; ++cb) acc[cb] = __builtin_amdgcn_mfma_f32_16x16x32_bf16(b0[cb], a0, acc[cb], 0, 0, 0);
            if (h2) { a0 = *(const bf16x8*)(ap + ks + 64);
#pragma unroll
                for (int cb = 0; cb < 16; ++cb) b0[cb] = *(const bf16x8*)(bp + (size_t)cb * 16 * K + ks + 64); }
            if (h1) {
#pragma unroll
                for (int cb = 0; cb < 16; ++cb) acc[cb] = __builtin_amdgcn_mfma_f32_16x16x32_bf16(b1[cb], a1, acc[cb], 0, 0, 0); }
        }
        lds_barrier();
#pragma unroll
        for (int cb = 0; cb < 16; ++cb) *(LAS f32x4*)(lds + ((w * 16 + cb) * 64 + lane) * 16) = acc[cb];
        lds_barrier();
        f32x4 v[2];
#pragma unroll
        for (int e = 0; e < 2; ++e) { v[e] = (f32x4){0.f, 0.f, 0.f, 0.f};
#pragma unroll
            for (int ww = 0; ww < 8; ++ww) v[e] += *(const LAS f32x4*)(lds + ((ww * 16 + 2 * w + e) * 64 + lane) * 16); }
        const size_t off = (size_t)row * D + pn * 256 + 32 * w + 4 * g;
        if (EPI == 2) {
#pragma unroll
            for (int e = 0; e < 2; ++e) *(u32x2*)(outp + off + 16 * e) = pk4(v[e]);
        } else {
            float ss = 0.f; float rs = 1.f; if (EPI == 1) rs = row_rstd(ssqr, row, 1.f / 1024.f);
#pragma unroll
            for (int e = 0; e < 2; ++e) { f32x4 o = up4(*(const u32x2*)(hin + off + 16 * e));
                if (EPI == 0) o += v[e];
                else { const u32x2 pw = *(const u32x2*)(pp + off + 16 * e); const f32x4 a = v[e] * rs;
                    o[0] += sigmoidf_(a[0]) * bflo(pw.x); o[1] += sigmoidf_(a[1]) * bfhi(pw.x); o[2] += sigmoidf_(a[2]) * bflo(pw.y); o[3] += sigmoidf_(a[3]) * bfhi(pw.y); }
                const u32x2 ow = pk4(o); *(u32x2*)(hout + off + 16 * e) = ow; ss += dot4(up4(ow)); }
            ss = fq_sum(ss); if (g == 0) xs[li * 8 + w] = ss;
            lds_barrier();
            if (w == 0 && g == 0) { const f32x4 t0 = *(const LAS f32x4*)(xs + li * 8), t1 = *(const LAS f32x4*)(xs + li * 8 + 4); ssqw[(size_t)row * 4 + pn] = ((t0[0] + t0[1]) + (t0[2] + t0[3])) + ((t1[0] + t1[1]) + (t1[2] + t1[3])); }
        }
    }
    lds_barrier();
}

#define XB_TMO      128
#define XB_XCNT(j)  (256  + 64 * (j))
#define XB_XSUB(j)  (1280 + 64 * (j))
#define XB_XGEN(j)  (2304 + 64 * (j))
#define XB_TOP      3328
#define XB_TOPGEN   3392
#define XCD_BAR_WORDS 3456
#define XB_SPIN_CAP (1u << 18)

__device__ __forceinline__ unsigned xb_ld(unsigned* p)              { return __hip_atomic_load(p, __ATOMIC_RELAXED, __HIP_MEMORY_SCOPE_AGENT); }
__device__ __forceinline__ unsigned xb_add(unsigned* p, unsigned v) { return __hip_atomic_fetch_add(p, v, __ATOMIC_RELAXED, __HIP_MEMORY_SCOPE_AGENT); }
__device__ __forceinline__ unsigned xb_xcc_id() { return (unsigned)__builtin_amdgcn_s_getreg((3 << 11) | 20) & 0xFu; }
#define XB_SPIN(cond, bar) do { unsigned _sp = 0; while (cond) { __builtin_amdgcn_s_sleep(1); \
    if ((++_sp & 255u) == 0u) { if (xb_ld(&(bar)[XB_TMO])) break; if (_sp > XB_SPIN_CAP) { atomicAdd(&(bar)[XB_TMO], 1u); break; } } } } while (0)

struct XcdBarrier {
    unsigned* bar; unsigned x;
    volatile LAS unsigned* st;
};

__device__ __forceinline__ XcdBarrier xcd_barrier_post(unsigned* bar, volatile LAS unsigned* st) {
    XcdBarrier b; b.bar = bar; b.x = xb_xcc_id(); b.st = st;
    if (threadIdx.x == 0) (void)xb_add(&bar[XB_XCNT(b.x)], 1u);
    return b;
}
__device__ __forceinline__ void xcd_barrier_complete(unsigned* bar, unsigned x, unsigned& nloc, unsigned& nx) {
    const unsigned G = gridDim.x * gridDim.y * gridDim.z;
    unsigned sum, cnt, mine, sp = 0u;
    for (;;) {
        sum = 0u; cnt = 0u; mine = 0u;
#pragma unroll
        for (unsigned j = 0; j < 16; ++j) { const unsigned c = xb_ld(&bar[XB_XCNT(j)]); sum += c; cnt += (c > 0u) ? 1u : 0u; mine = (j == x) ? c : mine; }
        if (sum == G) break;
        __builtin_amdgcn_s_sleep(1);
        if ((++sp & 255u) == 0u) { if (xb_ld(&bar[XB_TMO])) break; if (sp > XB_SPIN_CAP) { atomicAdd(&bar[XB_TMO], 1u); break; } }
    }
    nloc = mine > 0u ? mine : 1u; nx = cnt > 0u ? cnt : 1u;
}

__device__ __forceinline__ void xcd_barrier(const XcdBarrier& b) {
    asm volatile("s_waitcnt vmcnt(0)" ::: "memory");
    __syncthreads();
    if (threadIdx.x == 0) {
        unsigned* bar = b.bar;
        __builtin_amdgcn_s_waitcnt(0);
        unsigned nloc = b.st[0], nx = b.st[1];
        if (nloc == 0u) { xcd_barrier_complete(bar, b.x, nloc, nx); b.st[0] = nloc; b.st[1] = nx; }
        const unsigned old = xb_add(&bar[XB_XSUB(b.x)], 1u);
        const unsigned gen = old / nloc;
        if (old + 1u == (gen + 1u) * nloc) {
            __builtin_amdgcn_fence(__ATOMIC_RELEASE, "agent");
            asm volatile("s_waitcnt vmcnt(0)" ::: "memory");
            const unsigned og = xb_add(&bar[XB_TOP], 1u);
            const unsigned tg = og / nx;
            if (og + 1u == (tg + 1u) * nx) xb_add(&bar[XB_TOPGEN], 1u);
            else XB_SPIN(xb_ld(&bar[XB_TOPGEN]) == tg, bar);
            __builtin_amdgcn_fence(__ATOMIC_ACQUIRE, "agent");
            xb_add(&bar[XB_XGEN(b.x)], 1u);
            asm volatile("s_waitcnt vmcnt(0)" ::: "memory");
        } else {
            XB_SPIN(xb_ld(&bar[XB_XGEN(b.x)]) == gen, bar);
            __builtin_amdgcn_fence(__ATOMIC_ACQUIRE, "agent");
            asm volatile("s_waitcnt vmcnt(0)" ::: "memory");
        }
    }
    __syncthreads();
}


typedef pg8::StaticOrder SO;
#define GEMM(EpiT, A_, Bt_, M_, N_, K_, E_) do { pg8::Gemm g_{(const bf16_t*)(A_), (const bf16_t*)(Bt_), (M_), (N_), (K_)}; SO S_; S_.init((M_), (N_), (int)gridDim.x, (int)blockIdx.x); \
        pg8::gemm_phase<EpiT, SO, true, true>(lds, g_, S_, (E_)); } while (0)

__global__ void __launch_bounds__(512, 2) trunk_fwd(Params P) {
    extern __shared__ __attribute__((aligned(16))) unsigned char lds_raw[];
    LAS unsigned char* lds = (LAS unsigned char*)lds_raw;
    cg::grid_group grid = cg::this_grid();
#define RUN true
#ifdef PROBE_SEL
    unsigned long long tacc = 0, tlast = __builtin_amdgcn_s_memrealtime(); int curcat = 0;
#define TSWITCH(c) do { const unsigned long long tn_ = __builtin_amdgcn_s_memrealtime(); if (curcat == PROBE_SEL) tacc += tn_ - tlast; tlast = tn_; curcat = (c); } while (0)
#define RUNT(c) ({ TSWITCH(c); RUN; })
#else
#define TSWITCH(c) do { } while (0)
#define RUNT(c) RUN
#endif
#ifndef ONLY
#define EN(k) true
#else
#define EN(k) ((k) == ONLY)
#endif
#define SEAM() do { TSWITCH(5); { XcdBarrier b_; b_.bar = (unsigned*)(PWS + WS_BAR); b_.x = xb_xcc_id(); b_.st = (volatile LAS unsigned*)(lds + LDS_BYTES - 64); xcd_barrier(b_); } TSWITCH(6); } while (0)
#define WB ((bf16_t*)(PWS + WS_W))
#define HBA ((bf16_t*)(PWS + WS_HBA))
#define HBB ((bf16_t*)(PWS + WS_HBB))
#define SSQ0 ((float*)(PWS + WS_SSQ))
#define SSQ1 ((float*)(PWS + WS_SSQ) + (size_t)MT * 4)
#define HRES (POUT + O_Y)
#define ROPE_ ((const float*)(PWS + WS_ROPE))
#define ROPEM_ ((const float*)(PWS + WS_ROPEM))
    LAS float* xr = (LAS float*)(lds + XR_OFF);
    volatile LAS unsigned* bst = (volatile LAS unsigned*)(lds + LDS_BYTES - 64);
    if (threadIdx.x < 2) bst[threadIdx.x] = 0u;
    __syncthreads();
#define SSQ_P(p) ((((layer) ^ (p)) & 1) ? SSQ1 : SSQ0)

    if (blockIdx.x == 0) { unsigned* bw = (unsigned*)(PWS + WS_BAR); for (int i = threadIdx.x; i < XCD_BAR_WORDS; i += 512) __hip_atomic_store(bw + i, 0u, __ATOMIC_RELAXED, __HIP_MEMORY_SCOPE_AGENT); }
    if (EN(1) && RUNT(4)) phase_prologue(lds);
    TSWITCH(5); grid.sync(); (void)xcd_barrier_post((unsigned*)(PWS + WS_BAR), bst); TSWITCH(6);

    for (int layer = 0; layer < 4; ++layer) {
        const int kind = layer % 3, j = layer / 3;
        if (kind == 0) {
            bf16_t* proj = (bf16_t*)(PWS + PL_RPROJ); bf16_t* obuf = (bf16_t*)(PWS + PL_ROBUF);
            if (EN(2) && RUNT(1)) { EpiRetIn E{SSQ_P(0), proj, ROPE_}; GEMM(EpiRetIn, HBB, WB + W_RI + j * SZ_RI, MT, 6144, 1024, E); }
            SEAM();
            if (EN(3) && RUNT(3)) {
                for (int u = blockIdx.x; u < 512; u += gridDim.x) { const int grp = u >> 8, c = u & 255, b = c >> 4, h = (c >> 2) & 3, sl = c & 3;
                    const size_t so = ((size_t)(j * 16 + b) * 4 + h) * 131072;
                    if (!grp) ret_unit(lds, proj, obuf, b * SEQ, 64, 32, h, sl, nullptr, POUT + O_RSP + so);
                    else ret_unit(lds, proj, obuf, MP + b * DEC, 32, 1, h, sl, PIN(2) + so, POUT + O_RSS + so);
                    lds_barrier(); }
            }
            SEAM();
            if (EN(4) && RUNT(3)) phase_ret_ln(j);
            SEAM();
            if (EN(5) && RUNT(1)) { sample_gemm<0>(lds, obuf, WB + W_RO + j * SZ_RO, 2048, HBB, HBA, SSQ_P(1), nullptr, nullptr, nullptr); EpiRes E{HBB, HBA, SSQ_P(1), xr}; GEMM(EpiRes, obuf, WB + W_RO + j * SZ_RO, MP, 1024, 2048, E); }
            SEAM();
        } else if (kind == 1) {
            bf16_t* cqb = (bf16_t*)(PWS + PL_CQB); float* cqss = (float*)(PWS + WS_CQSS); bf16_t* latb = (bf16_t*)(PWS + PL_LATB); bf16_t* krb = (bf16_t*)(PWS + PL_KRB);
            bf16_t* mq = (bf16_t*)(POUT + O_FKP); bf16_t* kvh = (bf16_t*)(PWS + PL_KVH); bf16_t* mo = (bf16_t*)(PWS + PL_MO);
            if (EN(6) && RUNT(1)) {
                cvt_cache<256>(PIN(3), latb + (size_t)MP * 256); cvt_cache<64>(PIN(4), krb + (size_t)MP * 64);
                EpiMlaIn E{SSQ_P(0), PWS, POUT, PIN(19), PIN(25), xr}; GEMM(EpiMlaIn, HBB, WB + W_MI, MT, 1024, 1024, E); }
            SEAM();
            for (int hh = 0; hh < 2; ++hh) {
                if (EN(7) && RUNT(1)) {
                    if (hh == 0) { EpiPlain E{mq, 3072, cqss, 1.f / 512.f}; GEMM(EpiPlain, cqb, WB + W_QB, MT, 3072, 512, E); }
                    EpiKV E2{kvh, xr}; GEMM(EpiKV, latb, WB + W_KVB + (size_t)hh * 2048 * 256, KVR, 2048, 256, E2); }
                SEAM();
                if (EN(8) && RUNT(2)) {
                    const MlaQ q4{PIN(22), PIN(24), PIN(23), ROPEM_};
                    for (int u = blockIdx.x; u < 6 * 256; u += gridDim.x) { const int i = u >> 8, c = u & 255;
                        const int qb = c < 128 ? (i == 0 ? -1 : (i == 1 ? 7 : (i == 2 ? 5 : -2))) : (i == 0 ? 6 : (i == 1 ? 4 : 5 - i));
                        if (qb > -2) { const int bh = c & 127, b = bh >> 3, hl = bh & 7, hd = hh * 8 + hl; const bool pr = qb >= 0;
                            const size_t rq = pr ? (size_t)b * SEQ : (size_t)MP + (size_t)b * DEC, rk = pr ? (size_t)b * SEQ : (size_t)MP + (size_t)b * TKS; AU a;
                            a.Q = mq + rq * 3072 + hd * 192; a.qs = 3072; a.K1 = kvh + rk * 2048 + hl * 256; a.k1s = 2048; a.K2 = krb + rk * 64; a.k2s = 64; a.V = kvh + rk * 2048 + hl * 256 + 128; a.vs = 2048;
                            a.O = mo + rq * 2048 + hd * 128; a.os = 2048; a.G = nullptr; a.gs = 0; a.Fk = nullptr; a.q0 = pr ? qb * 256 : 0; a.nq = pr ? 256 : DEC; a.off = pr ? 0 : SEQ; a.Tk = pr ? SEQ : TKS;
                            attn_unit<192, 128, 0>(lds, a, q4); } }

                    lds_barrier();
                }
                SEAM();
            }
            if (EN(9) && RUNT(1)) { sample_gemm<0>(lds, mo, WB + W_MO, 2048, HBB, HBA, SSQ_P(1), nullptr, nullptr, nullptr); EpiRes E{HBB, HBA, SSQ_P(1), xr}; GEMM(EpiRes, mo, WB + W_MO, MP, 1024, 2048, E); }
            SEAM();
        } else {
            bf16_t* proj = (bf16_t*)(PWS + PL_FPROJ); bf16_t* kall = (bf16_t*)(PWS + PL_FKALL); bf16_t* vall = (bf16_t*)(PWS + PL_FVALL); bf16_t* fo = (bf16_t*)(PWS + PL_FO);
            if (EN(10) && RUNT(1)) {
                cvt_cache<1024>(PIN(5), kall); cvt_cache<1024>(PIN(6), vall);
                EpiFoxIn E{SSQ_P(0), PWS, POUT, PIN(29), PIN(30), PIN(28), xr}; GEMM(EpiFoxIn, HBB, WB + W_FI, MT, 4352, 1024, E); }
            SEAM();
            if (EN(11) && RUNT(6)) phase_fox_scan();
            SEAM();
            if (EN(12) && RUNT(2)) {
                const MlaQ q4{nullptr, nullptr, nullptr, nullptr};
                for (int u = blockIdx.x; u < 2048 + 256; u += gridDim.x) { AU a; a.K2 = nullptr; a.k2s = 0;
                    if (u < 2048) { const int qb = u >> 8, bh = u & 255, b = bh >> 4, hd = bh & 15; const size_t r0 = (size_t)b * SEQ;
                        a.Q = proj + r0 * 4096 + hd * 64; a.qs = 4096; a.K1 = proj + r0 * 4096 + 1024 + hd * 64; a.k1s = 4096; a.V = proj + r0 * 4096 + 2048 + hd * 64; a.vs = 4096;
                        a.O = fo + r0 * 1024 + hd * 64; a.os = 1024; a.G = proj + r0 * 4096 + 3072 + hd * 64; a.gs = 4096; a.Fk = (const float*)(PWS + WS_FP) + (size_t)bh * SEQ; a.q0 = qb * 256; a.nq = 256; a.off = 0; a.Tk = SEQ; }
                    else { const int bh = u - 2048, b = bh >> 4, hd = bh & 15; const size_t rq = (size_t)MP + (size_t)b * DEC, rk = (size_t)b * TKS;
                        a.Q = proj + rq * 4096 + hd * 64; a.qs = 4096; a.K1 = kall + rk * 1024 + hd * 64; a.k1s = 1024; a.V = vall + rk * 1024 + hd * 64; a.vs = 1024;
                        a.O = fo + rq * 1024 + hd * 64; a.os = 1024; a.G = proj + rq * 4096 + 3072 + hd * 64; a.gs = 4096; a.Fk = (const float*)(PWS + WS_FS) + (size_t)bh * TKS; a.q0 = 0; a.nq = DEC; a.off = SEQ; a.Tk = TKS; }
                    attn_unit<64, 64, 1>(lds, a, q4); }
                lds_barrier();
            }
            SEAM();
            if (EN(13) && RUNT(1)) { sample_gemm<0>(lds, fo, WB + W_FO, 1024, HBB, HBA, SSQ_P(1), nullptr, nullptr, nullptr); EpiRes E{HBB, HBA, SSQ_P(1), xr}; GEMM(EpiRes, fo, WB + W_FO, MP, 1024, 1024, E); }
            SEAM();
        }
        bf16_t* act = (bf16_t*)(PWS + PL_ACT); bf16_t* pb = (bf16_t*)(PWS + PL_PB); bf16_t* pp = (bf16_t*)(PWS + PL_PP);
        if (EN(14) && RUNT(1)) {
            cvt_chunks(PIN(8) + (size_t)layer * MP * 256, pb, (size_t)MP * 32); cvt_chunks(PIN(9) + (size_t)layer * MS * 256, pb + (size_t)MP * 256, (size_t)MS * 32);
            EpiGU E{SSQ_P(1), act}; GEMM(EpiGU, HBA, WB + W_GU + layer * SZ_GU, MT, 5632, 1024, E); }
        SEAM();
        if (EN(15) && RUNT(1)) {
            sample_gemm<0>(lds, act, WB + W_DN + layer * SZ_DN, DFF, HBA, HBA, SSQ_P(0), nullptr, nullptr, nullptr);
            sample_gemm<2>(lds, pb, WB + W_PP + layer * SZ_PP, 256, nullptr, nullptr, nullptr, nullptr, nullptr, pp);
            { EpiRes E{HBA, HBA, SSQ_P(0), xr}; GEMM(EpiRes, act, WB + W_DN + layer * SZ_DN, MP, 1024, DFF, E); }
            { EpiPlain E{pp, 1024, nullptr, 0.f}; GEMM(EpiPlain, pb, WB + W_PP + layer * SZ_PP, MP, 1024, 256, E); } }
        SEAM();
        if (EN(16) && RUNT(1)) { sample_gemm<1>(lds, HBA, WB + W_PG + layer * SZ_PG, 1024, HBA, HBB, SSQ_P(1), SSQ_P(0), pp, nullptr); EpiPE E{HBA, pp, HBB, SSQ_P(0), SSQ_P(1), xr}; GEMM(EpiPE, HBA, WB + W_PG + layer * SZ_PG, MP, 1024, 1024, E); }
        SEAM();
    }
    if (EN(17) && RUNT(6)) phase_final();
#ifdef PROBE_SEL
    TSWITCH(0);
    if (blockIdx.x == 0 && threadIdx.x == 0) { asm volatile("s_waitcnt vmcnt(0)" ::: "memory"); POUT[0] += (float)tacc * 1e-5f; }
#endif
}

extern "C" void kernel_launch(void* const* d_in, const int* in_sizes, int n_in, void* d_out, int out_size, void* d_ws, size_t ws_size, hipStream_t stream) {
    static int grid = 0;
    if (grid == 0) {
        if (n_in != 37 || (size_t)out_size != O_END || ws_size < WS_NEED) { fprintf(stderr, "kernel_launch: unexpected sizes n_in %d out %d ws %zu (need %zu)\n", n_in, out_size, ws_size, (size_t)WS_NEED); grid = -1; return; }
        int dev = 0, cus = 0, per_cu = 0;
        if (hipGetDevice(&dev) != hipSuccess || hipDeviceGetAttribute(&cus, hipDeviceAttributeMultiprocessorCount, dev) != hipSuccess) { grid = -1; return; }
        if (hipFuncSetAttribute((const void*)trunk_fwd, hipFuncAttributeMaxDynamicSharedMemorySize, LDS_BYTES) != hipSuccess) { fprintf(stderr, "kernel_launch: hipFuncSetAttribute failed\n"); grid = -1; return; }
        if (hipOccupancyMaxActiveBlocksPerMultiprocessor(&per_cu, (const void*)trunk_fwd, 512, LDS_BYTES) != hipSuccess || per_cu < 1) { fprintf(stderr, "kernel_launch: occupancy query says %d\n", per_cu); per_cu = 1; }
        (void)hipGetLastError();
        grid = cus * per_cu;
    }
    if (grid < 0) return;
    Params p{};
    for (int i = 0; i < 37; ++i) p.in[i] = (const float*)d_in[i];
    p.out = (float*)d_out; p.ws = (unsigned char*)d_ws; p.ph_lo = 0; p.ph_hi = 1000;
    void* args[] = {&p};
    hipError_t e = hipLaunchCooperativeKernel((const void*)trunk_fwd, dim3(grid), dim3(512), args, LDS_BYTES, stream);
    if (e != hipSuccess) fprintf(stderr, "cooperative launch failed: %s (grid %d)\n", hipGetErrorString(e), grid);
}
```

```cpp
#include <hip/hip_runtime.h>
#include <hip/hip_cooperative_groups.h>
#include <cstdio>
#include <cstdint>
namespace cg = cooperative_groups;
namespace pg8 {
#define PG8_LAS __attribute__((address_space(3)))
typedef unsigned short bf16_t;
typedef short bf16x8 __attribute__((ext_vector_type(8)));
typedef float f32x4 __attribute__((ext_vector_type(4)));
typedef unsigned u32x4 __attribute__((ext_vector_type(4)));
constexpr int BM = 256, BK = 64, HALF = 128, HTB = HALF * BK * 2  , STAGE_BYTES = 8 * HTB, NXCD = 8, WGM = 8;

__host__ __device__ __forceinline__ int lds_byte(int r, int c) { const int st = (r >> 4) * 2 + (c >> 5), rr = r & 15, cc = c & 31, ob = rr * 64 + cc * 2; return st * 1024 + (ob ^ (((ob >> 9) & 1) << 5)); }
__host__ __device__ __forceinline__ void stage_rc(int b, int& R, int& C) { const int st = b / 1024, sb = b % 1024, swz = sb ^ (((sb >> 9) & 1) << 5); R = (st >> 1) * 16 + swz / 64; C = (st & 1) * 32 + (swz % 64) / 2; }
__host__ __device__ __forceinline__ int perm32(int rho) { const int n = rho >> 4, i = rho & 15; return 8 * (i >> 2) + 4 * n + (i & 3); }

struct Unit { int pm, pn; };
struct Gemm { const bf16_t* A; const bf16_t* Bt; int M, N, K; };

struct StaticOrder {
    int nM, nN, nwg, G, c;
    __host__ __device__ void init(int M, int N, int G_, int c_) { nM = M / BM; nN = N / BM; nwg = nM * nN; G = G_; c = c_; }
    __host__ __device__ bool next(int i, Unit& u) const {
        const long L = (long)i * G + c; if (L >= nwg) return false;
        int wgid = (int)L; { const int q = nwg / NXCD, r = nwg % NXCD, xcd = wgid % NXCD, off = wgid / NXCD; wgid = (xcd < r ? xcd * (q + 1) : r * (q + 1) + (xcd - r) * q) + off; }
        const int nig = WGM * nN, gid = wgid / nig, fm = gid * WGM, gsz = (nM - fm) < WGM ? (nM - fm) : WGM;
        u.pm = fm + ((wgid % nig) % gsz); u.pn = (wgid % nig) / gsz; return true;
    }
    __device__ __forceinline__ void a_ready(const Unit&) const {}
    __device__ __forceinline__ void done(const Unit&) const {}
};

typedef float f32x2 __attribute__((ext_vector_type(2)));
template <class Epi, class Sched, bool ALIGN_EPI = false, bool SP2 = false>
__device__ __forceinline__ void gemm_phase(PG8_LAS unsigned char* lds, const Gemm g, const Sched& S, const Epi& E) {
    int tid_o = threadIdx.x; asm volatile("" : "+v"(tid_o)); const int tid = tid_o, wid = __builtin_amdgcn_readfirstlane(tid >> 6), lane = tid & 63, wr = wid >> 2, wc = wid & 3, fr = lane & 15, fq = lane >> 4;
    const int K = g.K, nt = K / BK;
    unsigned voffA[2], voffB[2];
#pragma unroll
    for (int i = 0; i < 2; ++i) { int R, C; stage_rc(tid * 16 + i * 8192, R, C); const int Rb = Epi::PERM ? ((R & ~31) + perm32(R & 31)) : R;
        voffA[i] = (unsigned)(R * K + C) * 2u; voffB[i] = (unsigned)(Rb * K + C) * 2u; }
    const size_t kstep = (size_t)(BK * 2);
    const size_t hstep = (size_t)HALF * K * 2;
    const size_t tstep = 2 * hstep;
    const unsigned ldsw = (unsigned)wid * 1024u;
    const int aoff = lds_byte(wr * 64 + fr, fq * 8), boff = lds_byte(wc * 32 + fr, fq * 8);
#define PG8_SA(b, h) (((b) * 2 + (h)) * HTB)
#define PG8_SB(b, h) ((4 + (b) * 2 + (h)) * HTB)
#define PG8_STAGE(bufoff, gbase, voff) do { _Pragma("unroll") for (int _i = 0; _i < 2; ++_i) \
        __builtin_amdgcn_global_load_lds((const unsigned*)((const char*)(gbase) + (voff)[_i]), (PG8_LAS unsigned*)(lds + (bufoff) + ldsw + _i * 8192), 16, 0, 0); } while (0)
#define PG8_LDA(dst, b, h) do { _Pragma("unroll") for (int m = 0; m < 4; ++m) _Pragma("unroll") for (int k = 0; k < 2; ++k) dst[m][k] = *(const PG8_LAS bf16x8*)(lds + PG8_SA(b, h) + aoff + m * 2048 + k * 1024); } while (0)
#define PG8_LDB(dst, b, h) do { _Pragma("unroll") for (int n = 0; n < 2; ++n) _Pragma("unroll") for (int k = 0; k < 2; ++k) dst[n][k] = *(const PG8_LAS bf16x8*)(lds + PG8_SB(b, h) + boff + n * 2048 + k * 1024); } while (0)
#define PG8_MMA(ai, bj, At, Bt) do { __builtin_amdgcn_s_setprio(1); _Pragma("unroll") for (int m = 0; m < 4; ++m) _Pragma("unroll") for (int n = 0; n < 2; ++n) _Pragma("unroll") for (int k = 0; k < 2; ++k) \
        acc[ai][bj][m][n] = __builtin_amdgcn_mfma_f32_16x16x32_bf16(Bt[n][k], At[m][k], acc[ai][bj][m][n], 0, 0, 0); __builtin_amdgcn_s_setprio(0); } while (0)
#define PG8_WAIT_V(n) asm volatile("s_waitcnt vmcnt(" #n ")" ::: "memory")
#define PG8_WAIT_L(n) asm volatile("s_waitcnt lgkmcnt(" #n ")" ::: "memory")
#define PG8_BAR __builtin_amdgcn_s_barrier()
#define PG8_SCHED __builtin_amdgcn_sched_barrier(0)
    Unit cur, nxt; int ui = 0;
    if (!S.next(0, cur)) return;
    f32x4 acc[2][2][4][2];
#pragma unroll
    for (int a = 0; a < 2; ++a)
#pragma unroll
        for (int b = 0; b < 2; ++b)
#pragma unroll
            for (int m = 0; m < 4; ++m)
#pragma unroll
                for (int n = 0; n < 2; ++n) acc[a][b][m][n] = (f32x4){0.f, 0.f, 0.f, 0.f};
    bf16x8 At[4][2], B0[2][2], B1[2][2];
    const char* cA = (const char*)g.A + (size_t)cur.pm * tstep; const char* cB = (const char*)g.Bt + (size_t)cur.pn * tstep;
    S.a_ready(cur);
    if constexpr (SP2) {
        PG8_STAGE(PG8_SB(0, 0), cB, voffB); PG8_STAGE(PG8_SB(0, 1), cB + hstep, voffB); PG8_STAGE(PG8_SA(0, 0), cA, voffA); PG8_STAGE(PG8_SA(0, 1), cA + hstep, voffA);
        if (wr == 1) PG8_BAR;
        PG8_WAIT_V(2); PG8_BAR;
        PG8_STAGE(PG8_SB(1, 0), cB + kstep, voffB); PG8_STAGE(PG8_SA(1, 0), cA + kstep, voffA); PG8_STAGE(PG8_SB(1, 1), cB + hstep + kstep, voffB);
        PG8_WAIT_V(6); PG8_BAR;
    } else {
        PG8_STAGE(PG8_SB(0, 0), cB, voffB); PG8_STAGE(PG8_SA(0, 0), cA, voffA); PG8_STAGE(PG8_SB(0, 1), cB + hstep, voffB); PG8_STAGE(PG8_SA(0, 1), cA + hstep, voffA);
        if (wr == 1) PG8_BAR;
        PG8_WAIT_V(4); PG8_BAR;
        PG8_STAGE(PG8_SB(1, 0), cB + kstep, voffB); PG8_STAGE(PG8_SA(1, 0), cA + kstep, voffA); PG8_STAGE(PG8_SB(1, 1), cB + hstep + kstep, voffB);
        PG8_WAIT_V(6); PG8_BAR;
    }
    for (;;) {
        const bool has_next = S.next(ui + 1, nxt);
        const char* nA = has_next ? (const char*)g.A + (size_t)nxt.pm * tstep : cA; const char* nB = has_next ? (const char*)g.Bt + (size_t)nxt.pn * tstep : cB;
        for (int t = 0; t < nt; t += 2) {
            const bool last = (t == nt - 2);
            const char* a1 = cA + (size_t)(t + 1) * kstep;
            const char* a2 = last ? nA : cA + (size_t)(t + 2) * kstep; const char* b2 = last ? nB : cB + (size_t)(t + 2) * kstep;
            const char* a3 = a2 + kstep; const char* b3 = b2 + kstep;
            if (last && has_next) S.a_ready(nxt);
            if constexpr (SP2) {
            PG8_LDB(B0, 0, 0); PG8_LDB(B1, 0, 1); PG8_SCHED; PG8_LDA(At, 0, 0); PG8_STAGE(PG8_SA(1, 1), a1 + hstep, voffA);
            PG8_WAIT_V(8); PG8_WAIT_L(0); PG8_BAR; PG8_MMA(0, 0, At, B0); PG8_MMA(0, 1, At, B1); PG8_BAR; PG8_SCHED;
            PG8_LDA(At, 0, 1); PG8_STAGE(PG8_SB(0, 0), b2, voffB); PG8_STAGE(PG8_SB(0, 1), b2 + hstep, voffB); PG8_STAGE(PG8_SA(0, 0), a2, voffA);
            PG8_WAIT_V(8); PG8_WAIT_L(0); PG8_BAR; PG8_MMA(1, 0, At, B0); PG8_MMA(1, 1, At, B1); PG8_BAR; PG8_SCHED;
            PG8_LDB(B0, 1, 0); PG8_LDB(B1, 1, 1); PG8_SCHED; PG8_LDA(At, 1, 0); PG8_STAGE(PG8_SA(0, 1), a2 + hstep, voffA);
            PG8_WAIT_V(8); PG8_WAIT_L(0); PG8_BAR; PG8_MMA(0, 0, At, B0); PG8_MMA(0, 1, At, B1); PG8_BAR; PG8_SCHED;
            PG8_LDA(At, 1, 1); PG8_STAGE(PG8_SB(1, 0), b3, voffB); PG8_STAGE(PG8_SB(1, 1), b3 + hstep, voffB); PG8_STAGE(PG8_SA(1, 0), a3, voffA);
            PG8_WAIT_V(8); PG8_WAIT_L(0); PG8_BAR; PG8_MMA(1, 0, At, B0); PG8_MMA(1, 1, At, B1); PG8_BAR; PG8_SCHED;
            } else {
            PG8_LDB(B0, 0, 0); PG8_SCHED; PG8_LDA(At, 0, 0); PG8_STAGE(PG8_SA(1, 1), a1 + hstep, voffA);
            PG8_WAIT_L(8); PG8_BAR; PG8_WAIT_L(0); PG8_MMA(0, 0, At, B0); PG8_BAR; PG8_SCHED;
            PG8_LDB(B1, 0, 1); PG8_STAGE(PG8_SB(0, 0), b2, voffB);
            PG8_BAR; PG8_WAIT_L(0); PG8_MMA(0, 1, At, B1); PG8_BAR;
            PG8_LDA(At, 0, 1); PG8_STAGE(PG8_SA(0, 0), a2, voffA);
            PG8_BAR; PG8_WAIT_L(0); PG8_MMA(1, 0, At, B0); PG8_BAR; PG8_SCHED;
            PG8_STAGE(PG8_SB(0, 1), b2 + hstep, voffB);
            PG8_WAIT_V(6); PG8_BAR; PG8_MMA(1, 1, At, B1); PG8_BAR;
            PG8_LDB(B0, 1, 0); PG8_SCHED; PG8_LDA(At, 1, 0); PG8_STAGE(PG8_SA(0, 1), a2 + hstep, voffA);
            PG8_WAIT_L(8); PG8_BAR; PG8_WAIT_L(0); PG8_MMA(0, 0, At, B0); PG8_BAR; PG8_SCHED;
            PG8_LDB(B1, 1, 1); PG8_STAGE(PG8_SB(1, 0), b3, voffB);
            PG8_BAR; PG8_WAIT_L(0); PG8_MMA(0, 1, At, B1); PG8_BAR;
            PG8_LDA(At, 1, 1); PG8_STAGE(PG8_SA(1, 0), a3, voffA);
            PG8_BAR; PG8_WAIT_L(0); PG8_MMA(1, 0, At, B0); PG8_BAR; PG8_SCHED;
            PG8_STAGE(PG8_SB(1, 1), b3 + hstep, voffB);
            PG8_WAIT_V(6); PG8_BAR; PG8_MMA(1, 1, At, B1); PG8_BAR;
            }
        }
        if constexpr (ALIGN_EPI) { if (wr == 0) PG8_BAR; }
        if constexpr (!Epi::AFTER_DRAIN) { E(acc, cur, wr, wc, fr, fq); S.done(cur); }
        if (!has_next) break;
#pragma unroll
        for (int a = 0; a < 2; ++a)
#pragma unroll
            for (int b = 0; b < 2; ++b)
#pragma unroll
                for (int m = 0; m < 4; ++m)
#pragma unroll
                    for (int n = 0; n < 2; ++n) acc[a][b][m][n] = (f32x4){0.f, 0.f, 0.f, 0.f};
        cur = nxt; cA = nA; cB = nB; ++ui;
        if constexpr (ALIGN_EPI) { if (wr == 1) PG8_BAR; }
    }
    PG8_WAIT_V(0);
    if constexpr (!ALIGN_EPI) { if (wr == 0) PG8_BAR; }
    PG8_BAR;
    if constexpr (Epi::AFTER_DRAIN) { E.fused(acc, cur, wr, wc, fr, fq, lds, wid, lane); S.done(cur); }
#undef PG8_SA
#undef PG8_SB
#undef PG8_STAGE
#undef PG8_LDA
#undef PG8_LDB
#undef PG8_MMA
#undef PG8_WAIT_V
#undef PG8_WAIT_L
#undef PG8_BAR
#undef PG8_SCHED
}
}

using pg8::bf16_t; using pg8::bf16x8; using pg8::f32x4; using pg8::u32x4; using pg8::Unit;
#define LAS __attribute__((address_space(3)))
typedef unsigned u32x2 __attribute__((ext_vector_type(2)));
typedef short s16x4 __attribute__((ext_vector_type(4)));

constexpr float EPS = 1e-6f;
constexpr float LOG2E = 1.4426950408889634f;
constexpr int D = 1024, MP = 32768, MS = 512, MT = 33280, SEQ = 2048, DEC = 32, TKS = 2080, KVR = 66048, DFF = 2816;
constexpr size_t O_Y = 0;
constexpr size_t O_RSP = (size_t)MT * D;
constexpr size_t RS_ONE = (size_t)16 * 4 * 256 * 512;
constexpr size_t O_RSS = O_RSP + 2 * RS_ONE;
constexpr size_t O_LATP = O_RSS + 2 * RS_ONE;
constexpr size_t O_KRP = O_LATP + (size_t)MP * 256;
constexpr size_t O_LATS = O_KRP + (size_t)MP * 64;
constexpr size_t O_KRS = O_LATS + (size_t)MS * 256;
constexpr size_t O_FKP = O_KRS + (size_t)MS * 64;
constexpr size_t O_FVP = O_FKP + (size_t)MP * 1024;
constexpr size_t O_FLP = O_FVP + (size_t)MP * 1024;
constexpr size_t O_FKS = O_FLP + (size_t)MP * 16;
constexpr size_t O_FVS = O_FKS + (size_t)MS * 1024;
constexpr size_t O_FLS = O_FVS + (size_t)MS * 1024;
constexpr size_t O_END = O_FLS + (size_t)MS * 16;
constexpr size_t MiB = (size_t)1 << 20;
constexpr size_t WS_W = 0, WS_HBA = 140 * MiB, WS_SSQ = 206 * MiB, WS_CQSS = 211 * MiB, WS_ROPE = 213 * MiB, WS_ROPEM = 216 * MiB, WS_FP = 217 * MiB, WS_FS = 219 * MiB + 512 * 1024, WS_POOL = 222 * MiB;
constexpr size_t WS_HBB = WS_POOL + 400 * MiB;
constexpr size_t WS_BAR = 212 * MiB;
constexpr size_t WS_NEED = WS_POOL + 628 * MiB;
constexpr size_t PL_RPROJ = WS_POOL, PL_ROBUF = WS_POOL + 470 * MiB;
constexpr size_t PL_ACT = WS_POOL, PL_PB = WS_POOL + 180 * MiB, PL_PP = WS_POOL + 200 * MiB;
constexpr size_t PL_LATB = WS_POOL, PL_KRB = WS_POOL + 33 * MiB, PL_CQB = WS_POOL + 42 * MiB, PL_KVH = WS_POOL + 76 * MiB, PL_MO = WS_POOL + 470 * MiB;
constexpr size_t PL_FPROJ = WS_POOL, PL_FKALL = WS_POOL + 260 * MiB, PL_FVALL = WS_POOL + 325 * MiB, PL_FO = WS_POOL + 470 * MiB;
constexpr size_t W_RI = 0, SZ_RI = (size_t)6144 * 1024;
constexpr size_t W_RO = W_RI + 2 * SZ_RI, SZ_RO = (size_t)1024 * 2048;
constexpr size_t W_MI = W_RO + 2 * SZ_RO;
constexpr size_t W_QB = W_MI + (size_t)1024 * 1024;
constexpr size_t W_KVB = W_QB + (size_t)3072 * 512;
constexpr size_t W_MO = W_KVB + (size_t)4096 * 256;
constexpr size_t W_FI = W_MO + (size_t)1024 * 2048;
constexpr size_t W_FO = W_FI + (size_t)4352 * 1024;
constexpr size_t W_GU = W_FO + (size_t)1024 * 1024, SZ_GU = (size_t)5632 * 1024;
constexpr size_t W_DN = W_GU + 4 * SZ_GU, SZ_DN = (size_t)1024 * 2816;
constexpr size_t W_PG = W_DN + 4 * SZ_DN, SZ_PG = (size_t)1024 * 1024;
constexpr size_t W_PP = W_PG + 4 * SZ_PG, SZ_PP = (size_t)1024 * 256;
constexpr size_t W_END = W_PP + 4 * SZ_PP;
static_assert(W_END * 2 <= 140 * MiB, "weights region");
constexpr int LDS_BYTES = 163840;
constexpr int XR_OFF = 131072;

struct Params { const float* in[37]; float* out; unsigned char* ws; int ph_lo, ph_hi; };
typedef const __attribute__((address_space(4))) Params* KP;
__device__ __forceinline__ KP kp() { KP p = (KP)__builtin_amdgcn_kernarg_segment_ptr(); asm volatile("" : "+s"(p)); return p; }
#define PIN(k) (kp()->in[k])
#define POUT (kp()->out)
#define PWS (kp()->ws)

typedef float f32x2 __attribute__((ext_vector_type(2)));
typedef __bf16 bf16x2n __attribute__((ext_vector_type(2)));
__device__ __forceinline__ unsigned pk2(float lo, float hi) { const f32x2 v = {lo, hi}; return __builtin_bit_cast(unsigned, __builtin_convertvector(v, bf16x2n)); }
__device__ __forceinline__ unsigned f2bf(float f) { return pk2(f, 0.f) & 0xffffu; }
__device__ __forceinline__ float bf2f(unsigned short h) { return __builtin_bit_cast(float, (unsigned)h << 16); }
__device__ __forceinline__ float bflo(unsigned u) { return __builtin_bit_cast(float, u << 16); }
__device__ __forceinline__ float bfhi(unsigned u) { return __builtin_bit_cast(float, u & 0xffff0000u); }
__device__ __forceinline__ u32x2 pk4(f32x4 v) { u32x2 r; r.x = pk2(v[0], v[1]); r.y = pk2(v[2], v[3]); return r; }
__device__ __forceinline__ f32x4 up4(u32x2 w) { return (f32x4){bflo(w.x), bfhi(w.x), bflo(w.y), bfhi(w.y)}; }
__device__ __forceinline__ float wave_sum(float v) {
#pragma unroll
    for (int o = 1; o < 64; o <<= 1) v += __shfl_xor(v, o);
    return v;
}
__device__ __forceinline__ float fq_sum(float v) { v += __shfl_xor(v, 16); v += __shfl_xor(v, 32); return v; }
__device__ __forceinline__ float sigmoidf_(float x) { return __builtin_amdgcn_rcpf(1.f + __expf(-x)); }
__device__ __forceinline__ float dot4(f32x4 v) { return (v[0] * v[0] + v[1] * v[1]) + (v[2] * v[2] + v[3] * v[3]); }
__device__ __forceinline__ void lds_barrier() { asm volatile("s_waitcnt lgkmcnt(0)" ::: "memory"); __builtin_amdgcn_s_barrier(); asm volatile("" ::: "memory"); }
__device__ __forceinline__ int tok_pos(int r) { return r < MP ? (r & (SEQ - 1)) : SEQ + ((r - MP) & (DEC - 1)); }
__device__ __forceinline__ int kv_row(int r) { return r < MP ? r : MP + ((r - MP) >> 5) * TKS + SEQ + ((r - MP) & 31); }
__device__ __forceinline__ float row_rstd(const float* ssq, int row, float invdim) {
    const f32x4 v = *(const f32x4*)(ssq + (size_t)row * 4);
    return rsqrtf(((v[0] + v[1]) + (v[2] + v[3])) * invdim + EPS);
}
#define EROW(u, ai, wr, m, fr) ((u).pm * 256 + (ai) * 128 + (wr) * 64 + (m) * 16 + (fr))
#define LROW(ai, wr, m, fr) ((ai) * 128 + (wr) * 64 + (m) * 16 + (fr))
#define ECOL(bj, wc, n, fq) ((bj) * 128 + (wc) * 32 + (n) * 16 + (fq) * 4)
typedef const f32x4 (&AccRef)[2][2][4][2];
#define EFENCE asm volatile("" ::: "memory")
#define RSV(ai, m) row_rstd(ssq, EROW(u, ai, wr, m, fr), 1.f / 1024.f)

struct EpiRetIn {
    static constexpr bool PERM = false, AFTER_DRAIN = false;
    const float* ssq; bf16_t* proj; const float* rope;
    __device__ __forceinline__ void operator()(AccRef acc, const Unit& u, int wr, int wc, int fr, int fq) const {
        float rs8[2][4];
#pragma unroll
        for (int ai = 0; ai < 2; ++ai)
#pragma unroll
            for (int m = 0; m < 4; ++m) rs8[ai][m] = row_rstd(ssq, EROW(u, ai, wr, m, fr), 1.f / 1024.f);
        const int pn = u.pn;
#pragma unroll
        for (int ai = 0; ai < 2; ++ai)
#pragma unroll
            for (int m = 0; m < 4; ++m) {
                const int r = EROW(u, ai, wr, m, fr); const float rs = rs8[ai][m];
                bf16_t* orow = proj + (size_t)r * 6144 + pn * 256 + wc * 32 + fq * 4;
                if (pn < 8) {
                    const float* tb = rope + (size_t)tok_pos(r) * 256 + wc * 32 + fq * 4; const float sc = pn >= 4 ? 0.0625f : 1.f;
#pragma unroll
                    for (int n = 0; n < 2; ++n) { const f32x4 c = *(const f32x4*)(tb + n * 16), s = *(const f32x4*)(tb + 128 + n * 16);
                        const f32x4 x1 = acc[ai][0][m][n] * rs, x2 = acc[ai][1][m][n] * rs;
                        *(u32x2*)(orow + n * 16) = pk4((x1 * c - x2 * s) * sc); *(u32x2*)(orow + 128 + n * 16) = pk4((x2 * c + x1 * s) * sc); }
                } else {
#pragma unroll
                    for (int bj = 0; bj < 2; ++bj)
#pragma unroll
                        for (int n = 0; n < 2; ++n) { f32x4 v = acc[ai][bj][m][n] * rs;
                            if (pn >= 16) { v[0] *= sigmoidf_(v[0]); v[1] *= sigmoidf_(v[1]); v[2] *= sigmoidf_(v[2]); v[3] *= sigmoidf_(v[3]); }
                            *(u32x2*)(orow + bj * 128 + n * 16) = pk4(v); }
                }
            }
    }
};
struct EpiRes {
    static constexpr bool PERM = false, AFTER_DRAIN = false;
    const bf16_t* hin; bf16_t* hout; float* ssqw; LAS float* xr;
    __device__ __forceinline__ void operator()(AccRef acc, const Unit& u, int wr, int wc, int fr, int fq) const {
        LAS float* const xq = xr + (wr * 64 + fr) * 4; LAS float* const xw = xq + wc;
#pragma unroll
        for (int ai = 0; ai < 2; ++ai) {
            u32x2 hv[4][2][2];
#pragma unroll
            for (int m = 0; m < 4; ++m) { const size_t off = (size_t)EROW(u, ai, wr, m, fr) * D + u.pn * 256 + wc * 32 + fq * 4;
#pragma unroll
                for (int bj = 0; bj < 2; ++bj)
#pragma unroll
                    for (int n = 0; n < 2; ++n) hv[m][bj][n] = *(const u32x2*)(hin + off + bj * 128 + n * 16); }
#pragma unroll
            for (int m = 0; m < 4; ++m) {
                const int r = EROW(u, ai, wr, m, fr); const size_t off = (size_t)r * D + u.pn * 256 + wc * 32 + fq * 4; float ss = 0.f;
#pragma unroll
                for (int bj = 0; bj < 2; ++bj)
#pragma unroll
                    for (int n = 0; n < 2; ++n) { const size_t o = off + bj * 128 + n * 16; const f32x4 v = up4(hv[m][bj][n]) + acc[ai][bj][m][n];
                        const u32x2 pw = pk4(v); *(u32x2*)(hout + o) = pw; ss += dot4(up4(pw)); }
                ss = fq_sum(ss); if (fq == 0) xw[(ai * 128 + m * 16) * 4] = ss; EFENCE;
            }
        }
        lds_barrier();
        if (wc == 0 && fq == 0) {
#pragma unroll
            for (int ai = 0; ai < 2; ++ai)
#pragma unroll
                for (int m = 0; m < 4; ++m) { const f32x4 t = *(const LAS f32x4*)(xq + (ai * 128 + m * 16) * 4); ssqw[(size_t)EROW(u, ai, wr, m, fr) * 4 + u.pn] = (t[0] + t[1]) + (t[2] + t[3]); }
        }
    }
};
struct EpiGU {
    static constexpr bool PERM = false, AFTER_DRAIN = false;
    const float* ssq; bf16_t* act;
    __device__ __forceinline__ void operator()(AccRef acc, const Unit& u, int wr, int wc, int fr, int fq) const {
        float rs8[2][4];
#pragma unroll
        for (int ai = 0; ai < 2; ++ai)
#pragma unroll
            for (int m = 0; m < 4; ++m) rs8[ai][m] = row_rstd(ssq, EROW(u, ai, wr, m, fr), 1.f / 1024.f);
#pragma unroll
        for (int ai = 0; ai < 2; ++ai)
#pragma unroll
            for (int m = 0; m < 4; ++m) {
                const int r = EROW(u, ai, wr, m, fr); const float rs = rs8[ai][m];
                bf16_t* orow = act + (size_t)r * DFF + u.pn * 128 + wc * 32 + fq * 4;
#pragma unroll
                for (int n = 0; n < 2; ++n) { const f32x4 g = acc[ai][0][m][n] * rs, up = acc[ai][1][m][n] * rs; f32x4 v;
                    v[0] = g[0] * sigmoidf_(g[0]) * up[0]; v[1] = g[1] * sigmoidf_(g[1]) * up[1]; v[2] = g[2] * sigmoidf_(g[2]) * up[2]; v[3] = g[3] * sigmoidf_(g[3]) * up[3];
                    *(u32x2*)(orow + n * 16) = pk4(v); }
            }
    }
};
struct EpiPlain {
    static constexpr bool PERM = false, AFTER_DRAIN = false;
    bf16_t* out; int ldc; const float* ssq; float invdim;
    __device__ __forceinline__ void operator()(AccRef acc, const Unit& u, int wr, int wc, int fr, int fq) const {
#pragma unroll
        for (int ai = 0; ai < 2; ++ai)
#pragma unroll
            for (int m = 0; m < 4; ++m) {
                const int r = EROW(u, ai, wr, m, fr); const float rs = ssq ? row_rstd(ssq, r, invdim) : 1.f;
                bf16_t* orow = out + (size_t)r * ldc + u.pn * 256 + wc * 32 + fq * 4;
#pragma unroll
                for (int bj = 0; bj < 2; ++bj)
#pragma unroll
                    for (int n = 0; n < 2; ++n) *(u32x2*)(orow + bj * 128 + n * 16) = pk4(acc[ai][bj][m][n] * rs);
            }
    }
};
struct EpiPE {
    static constexpr bool PERM = false, AFTER_DRAIN = false;
    const bf16_t* hin; const bf16_t* pp; bf16_t* hout; const float* ssq; float* ssqw; LAS float* xr;
    __device__ __forceinline__ void operator()(AccRef acc, const Unit& u, int wr, int wc, int fr, int fq) const {
        float rs8[2][4];
#pragma unroll
        for (int ai = 0; ai < 2; ++ai)
#pragma unroll
            for (int m = 0; m < 4; ++m) rs8[ai][m] = row_rstd(ssq, EROW(u, ai, wr, m, fr), 1.f / 1024.f);
        LAS float* const xq = xr + (wr * 64 + fr) * 4; LAS float* const xw = xq + wc;
#pragma unroll
        for (int ai = 0; ai < 2; ++ai)
#pragma unroll
            for (int m = 0; m < 4; ++m) {
                const int r = EROW(u, ai, wr, m, fr); const float rs = rs8[ai][m];
                const size_t off = (size_t)r * D + u.pn * 256 + wc * 32 + fq * 4; float ss = 0.f;
#pragma unroll
                for (int bj = 0; bj < 2; ++bj)
#pragma unroll
                    for (int n = 0; n < 2; ++n) { const size_t o = off + bj * 128 + n * 16; const f32x4 a = acc[ai][bj][m][n] * rs; const u32x2 pw = *(const u32x2*)(pp + o);
                        f32x4 v = up4(*(const u32x2*)(hin + o));
                        v[0] += sigmoidf_(a[0]) * bflo(pw.x); v[1] += sigmoidf_(a[1]) * bfhi(pw.x); v[2] += sigmoidf_(a[2]) * bflo(pw.y); v[3] += sigmoidf_(a[3]) * bfhi(pw.y);
                        const u32x2 ow = pk4(v); *(u32x2*)(hout + o) = ow; ss += dot4(up4(ow)); }
                ss = fq_sum(ss); if (fq == 0) xw[(ai * 128 + m * 16) * 4] = ss;
            }
        lds_barrier();
        if (wc == 0 && fq == 0) {
#pragma unroll
            for (int ai = 0; ai < 2; ++ai)
#pragma unroll
                for (int m = 0; m < 4; ++m) { const f32x4 t = *(const LAS f32x4*)(xq + (ai * 128 + m * 16) * 4); ssqw[(size_t)EROW(u, ai, wr, m, fr) * 4 + u.pn] = (t[0] + t[1]) + (t[2] + t[3]); }
        }
    }
};
struct EpiMlaIn {
    static constexpr bool PERM = false, AFTER_DRAIN = false;
    const float* ssq; unsigned char* ws; float* out; const float* kvn; const float* gkr; LAS float* xr;
    __device__ __forceinline__ void operator()(AccRef acc, const Unit& u, int wr, int wc, int fr, int fq) const {
        LAS float* const xq = xr + (wr * 64 + fr) * 4; LAS float* const xw = xq + wc;
        const int pn = u.pn;
        bf16_t* const cqb = (bf16_t*)(ws + PL_CQB); float* const cqss = (float*)(ws + WS_CQSS); bf16_t* const latb = (bf16_t*)(ws + PL_LATB); bf16_t* const krb = (bf16_t*)(ws + PL_KRB); const float* const ropem = (const float*)(ws + WS_ROPEM);
        if (pn < 2) {
#pragma unroll
            for (int ai = 0; ai < 2; ++ai)
#pragma unroll
                for (int m = 0; m < 4; ++m) { const int r = EROW(u, ai, wr, m, fr); bf16_t* orow = cqb + (size_t)r * 512 + pn * 256 + wc * 32 + fq * 4; float ss = 0.f;
#pragma unroll
                    for (int bj = 0; bj < 2; ++bj)
#pragma unroll
                        for (int n = 0; n < 2; ++n) { const f32x4 v = acc[ai][bj][m][n] * RSV(ai, m); ss += dot4(v); *(u32x2*)(orow + bj * 128 + n * 16) = pk4(v); }
                    ss = fq_sum(ss); if (fq == 0) xw[(ai * 128 + m * 16) * 4] = ss; EFENCE; }
            lds_barrier();
            if (wc == 0 && fq == 0) {
#pragma unroll
                for (int ai = 0; ai < 2; ++ai)
#pragma unroll
                    for (int m = 0; m < 4; ++m) { const f32x4 t = *(const LAS f32x4*)(xq + (ai * 128 + m * 16) * 4); float* cp = cqss + (size_t)EROW(u, ai, wr, m, fr) * 4; cp[pn] = (t[0] + t[1]) + (t[2] + t[3]); cp[2 + pn] = 0.f; }
            }
        } else if (pn == 2) {
#pragma unroll
            for (int ai = 0; ai < 2; ++ai)
#pragma unroll
                for (int m = 0; m < 4; ++m) { float ss = 0.f;
#pragma unroll
                    for (int bj = 0; bj < 2; ++bj)
#pragma unroll
                        for (int n = 0; n < 2; ++n) ss += dot4(acc[ai][bj][m][n] * RSV(ai, m));
                    ss = fq_sum(ss); if (fq == 0) xw[(ai * 128 + m * 16) * 4] = ss; EFENCE; }
            lds_barrier();
#pragma unroll
            for (int ai = 0; ai < 2; ++ai)
#pragma unroll
                for (int m = 0; m < 4; ++m) { const int r = EROW(u, ai, wr, m, fr); const f32x4 t = *(const LAS f32x4*)(xq + (ai * 128 + m * 16) * 4);
                    const float rk = rsqrtf(((t[0] + t[1]) + (t[2] + t[3])) * (1.f / 256.f) + EPS) * RSV(ai, m);
                    float* o32 = (r < MP ? out + O_LATP + (size_t)r * 256 : out + O_LATS + (size_t)(r - MP) * 256) + wc * 32 + fq * 4;
                    bf16_t* o16 = latb + (size_t)kv_row(r) * 256 + wc * 32 + fq * 4;
#pragma unroll
                    for (int bj = 0; bj < 2; ++bj)
#pragma unroll
                        for (int n = 0; n < 2; ++n) { const f32x4 g = *(const f32x4*)(kvn + ECOL(bj, wc, n, fq)); const f32x4 v = acc[ai][bj][m][n] * rk * g;
                            *(f32x4*)(o32 + bj * 128 + n * 16) = v; *(u32x2*)(o16 + bj * 128 + n * 16) = pk4(v); } EFENCE; }
        } else if (wc == 0) {
#pragma unroll
            for (int ai = 0; ai < 2; ++ai)
#pragma unroll
                for (int m = 0; m < 4; ++m) { const int r = EROW(u, ai, wr, m, fr); float ss = 0.f;
#pragma unroll
                    for (int n = 0; n < 2; ++n) ss += dot4(acc[ai][0][m][n] * RSV(ai, m)) + dot4(acc[ai][1][m][n] * RSV(ai, m));
                    ss = fq_sum(ss); const float rk = rsqrtf(ss * (1.f / 64.f) + EPS) * RSV(ai, m);
                    const float* tb = ropem + (size_t)tok_pos(r) * 64 + fq * 4;
                    float* o32 = (r < MP ? out + O_KRP + (size_t)r * 64 : out + O_KRS + (size_t)(r - MP) * 64) + fq * 4;
                    bf16_t* o16 = krb + (size_t)kv_row(r) * 64 + fq * 4;
#pragma unroll
                    for (int n = 0; n < 2; ++n) { const f32x4 g1 = *(const f32x4*)(gkr + n * 16 + fq * 4), g2 = *(const f32x4*)(gkr + 32 + n * 16 + fq * 4);
                        const f32x4 c = *(const f32x4*)(tb + n * 16), s = *(const f32x4*)(tb + 32 + n * 16);
                        const f32x4 y1 = acc[ai][0][m][n] * rk * g1, y2 = acc[ai][1][m][n] * rk * g2; const f32x4 z1 = y1 * c - y2 * s, z2 = y2 * c + y1 * s;
                        *(f32x4*)(o32 + n * 16) = z1; *(f32x4*)(o32 + 32 + n * 16) = z2; *(u32x2*)(o16 + n * 16) = pk4(z1); *(u32x2*)(o16 + 32 + n * 16) = pk4(z2); } EFENCE; }
        }
    }
};
struct EpiKV {
    static constexpr bool PERM = false, AFTER_DRAIN = false;
    bf16_t* kvh; LAS float* xr;
    __device__ __forceinline__ void operator()(AccRef acc, const Unit& u, int wr, int wc, int fr, int fq) const {
        LAS float* const xq = xr + (wr * 64 + fr) * 4; LAS float* const xw = xq + wc;
#pragma unroll
        for (int ai = 0; ai < 2; ++ai)
#pragma unroll
            for (int m = 0; m < 4; ++m) { float ss = dot4(acc[ai][0][m][0]) + dot4(acc[ai][0][m][1]); ss = fq_sum(ss); if (fq == 0) xw[(ai * 128 + m * 16) * 4] = ss; EFENCE; }
        lds_barrier();
#pragma unroll
        for (int ai = 0; ai < 2; ++ai)
#pragma unroll
            for (int m = 0; m < 4; ++m) { const int r = EROW(u, ai, wr, m, fr); const f32x4 t = *(const LAS f32x4*)(xq + (ai * 128 + m * 16) * 4);
                const float rk = rsqrtf(((t[0] + t[1]) + (t[2] + t[3])) * (1.f / 128.f) + EPS);
                bf16_t* orow = kvh + (size_t)r * 2048 + u.pn * 256 + wc * 32 + fq * 4;
#pragma unroll
                for (int n = 0; n < 2; ++n) { *(u32x2*)(orow + n * 16) = pk4(acc[ai][0][m][n] * rk); *(u32x2*)(orow + 128 + n * 16) = pk4(acc[ai][1][m][n]); } }
    }
};
struct EpiFoxIn {
    static constexpr bool PERM = false, AFTER_DRAIN = false;
    const float* ssq; unsigned char* ws; float* out; const float* gq; const float* gk; const float* bf; LAS float* xr;
    __device__ __forceinline__ void operator()(AccRef acc, const Unit& u, int wr, int wc, int fr, int fq) const {
        LAS float* const xq = xr + (wr * 64 + fr) * 4; LAS float* const xw = xq + wc;
        const int pn = u.pn;
        bf16_t* const proj = (bf16_t*)(ws + PL_FPROJ); bf16_t* const kall = (bf16_t*)(ws + PL_FKALL); bf16_t* const vall = (bf16_t*)(ws + PL_FVALL);
        if (pn < 8) {
#pragma unroll
            for (int ai = 0; ai < 2; ++ai)
#pragma unroll
                for (int m = 0; m < 4; ++m)
#pragma unroll
                    for (int bj = 0; bj < 2; ++bj) { float ss = dot4(acc[ai][bj][m][0] * RSV(ai, m)) + dot4(acc[ai][bj][m][1] * RSV(ai, m)); ss = fq_sum(ss);
                        if (fq == 0) xw[bj * 1024 + (ai * 128 + m * 16) * 4] = ss; EFENCE; }
            lds_barrier();
            const float* gg = pn < 4 ? gq : gk;
#pragma unroll
            for (int ai = 0; ai < 2; ++ai)
#pragma unroll
                for (int m = 0; m < 4; ++m) { const int r = EROW(u, ai, wr, m, fr);
#pragma unroll
                    for (int bj = 0; bj < 2; ++bj) { const f32x4 t = *(const LAS f32x4*)(xq + bj * 1024 + (ai * 128 + m * 16) * 4);
                        const float hs = wc < 2 ? t[0] + t[1] : t[2] + t[3]; const float rk = rsqrtf(hs * (1.f / 64.f) + EPS) * RSV(ai, m);
#pragma unroll
                        for (int n = 0; n < 2; ++n) { const f32x4 g = *(const f32x4*)(gg + (wc & 1) * 32 + n * 16 + fq * 4); const f32x4 v = acc[ai][bj][m][n] * rk * g;
                            const int ct = pn * 256 + ECOL(bj, wc, n, fq);
                            if (pn < 4) *(u32x2*)(proj + (size_t)r * 4096 + ct) = pk4(v);
                            else { const int ck = ct - 1024;
                                if (r < MP) { *(f32x4*)(out + O_FKP + (size_t)r * 1024 + ck) = v; *(u32x2*)(proj + (size_t)r * 4096 + ct) = pk4(v); }
                                else { const int rsm = r - MP; *(f32x4*)(out + O_FKS + (size_t)rsm * 1024 + ck) = v; *(u32x2*)(kall + ((size_t)(rsm >> 5) * TKS + SEQ + (rsm & 31)) * 1024 + ck) = pk4(v); } } } EFENCE; } }
        } else if (pn < 16) {
#pragma unroll
            for (int ai = 0; ai < 2; ++ai)
#pragma unroll
                for (int m = 0; m < 4; ++m) { const int r = EROW(u, ai, wr, m, fr);
#pragma unroll
                    for (int bj = 0; bj < 2; ++bj)
#pragma unroll
                        for (int n = 0; n < 2; ++n) { f32x4 v = acc[ai][bj][m][n] * RSV(ai, m); const int ct = pn * 256 + ECOL(bj, wc, n, fq);
                            if (pn < 12) { const int cv = ct - 2048;
                                if (r < MP) { *(f32x4*)(out + O_FVP + (size_t)r * 1024 + cv) = v; *(u32x2*)(proj + (size_t)r * 4096 + ct) = pk4(v); }
                                else { const int rsm = r - MP; *(f32x4*)(out + O_FVS + (size_t)rsm * 1024 + cv) = v; *(u32x2*)(vall + ((size_t)(rsm >> 5) * TKS + SEQ + (rsm & 31)) * 1024 + cv) = pk4(v); } }
                            else { v[0] = sigmoidf_(v[0]); v[1] = sigmoidf_(v[1]); v[2] = sigmoidf_(v[2]); v[3] = sigmoidf_(v[3]); *(u32x2*)(proj + (size_t)r * 4096 + ct) = pk4(v); } } EFENCE; }
        } else if (wc == 0) {
            const f32x4 b = *(const f32x4*)(bf + fq * 4);
#pragma unroll
            for (int ai = 0; ai < 2; ++ai)
#pragma unroll
                for (int m = 0; m < 4; ++m) { const int r = EROW(u, ai, wr, m, fr); const f32x4 x = acc[ai][0][m][0] * RSV(ai, m) + b; f32x4 v;
#pragma unroll
                    for (int e = 0; e < 4; ++e) v[e] = fminf(x[e], 0.f) - log1pf(__expf(-fabsf(x[e])));
                    float* o = (r < MP ? out + O_FLP + (size_t)r * 16 : out + O_FLS + (size_t)(r - MP) * 16) + fq * 4; *(f32x4*)o = v; }
        }
    }
};

struct WJob { const float* src; const float* src2; const float* gain; bf16_t* dst; int K, Nsrc, Ndst, map; };
__device__ __forceinline__ WJob get_job(int j) {
    bf16_t* W = (bf16_t*)(PWS + WS_W); WJob J; J.src2 = nullptr; J.gain = nullptr; J.map = 0;
    if (j < 2)       { J.src = PIN(14) + (size_t)j * 1024 * 6144; J.gain = PIN(10) + (size_t)(3 * j) * 1024; J.K = 1024; J.Nsrc = 6144; J.Ndst = 6144; J.dst = W + W_RI + j * SZ_RI; }
    else if (j < 4)  { const int i = j - 2; J.src = PIN(16) + (size_t)i * 2048 * 1024; J.K = 2048; J.Nsrc = 1024; J.Ndst = 1024; J.dst = W + W_RO + i * SZ_RO; }
    else if (j == 4) { J.src = PIN(17); J.gain = PIN(10) + 1024; J.K = 1024; J.Nsrc = 832; J.Ndst = 1024; J.map = 1; J.dst = W + W_MI; }
    else if (j == 5) { J.src = PIN(20); J.gain = PIN(18); J.K = 512; J.Nsrc = 3072; J.Ndst = 3072; J.dst = W + W_QB; }
    else if (j == 6) { J.src = PIN(21); J.K = 256; J.Nsrc = 4096; J.Ndst = 4096; J.dst = W + W_KVB; }
    else if (j == 7) { J.src = PIN(26); J.K = 2048; J.Nsrc = 1024; J.Ndst = 1024; J.dst = W + W_MO; }
    else if (j == 8) { J.src = PIN(27); J.gain = PIN(10) + 2048; J.K = 1024; J.Nsrc = 4112; J.Ndst = 4352; J.dst = W + W_FI; }
    else if (j == 9) { J.src = PIN(31); J.K = 1024; J.Nsrc = 1024; J.Ndst = 1024; J.dst = W + W_FO; }
    else if (j < 14) { const int i = j - 10; J.src = PIN(32) + (size_t)i * 1024 * DFF; J.src2 = PIN(33) + (size_t)i * 1024 * DFF; J.gain = PIN(11) + (size_t)i * 1024; J.K = 1024; J.Nsrc = DFF; J.Ndst = 5632; J.map = 2; J.dst = W + W_GU + i * SZ_GU; }
    else if (j < 18) { const int i = j - 14; J.src = PIN(34) + (size_t)i * DFF * 1024; J.K = DFF; J.Nsrc = 1024; J.Ndst = 1024; J.dst = W + W_DN + i * SZ_DN; }
    else if (j < 22) { const int i = j - 18; J.src = PIN(36) + (size_t)i * 1024 * 1024; J.gain = PIN(12) + (size_t)i * 1024; J.K = 1024; J.Nsrc = 1024; J.Ndst = 1024; J.dst = W + W_PG + i * SZ_PG; }
    else             { const int i = j - 22; J.src = PIN(35) + (size_t)i * 256 * 1024; J.K = 256; J.Nsrc = 1024; J.Ndst = 1024; J.dst = W + W_PP + i * SZ_PP; }
    return J;
}
__device__ __forceinline__ void wt_item2(const WJob& J, LAS float* scr, int itemA, int itemB, bool hasB, int lane) {
    const int nblk = J.Ndst / 32; int k0[2], n0[2]; const float* sp[2]; int col[2];
#pragma unroll
    for (int q = 0; q < 2; ++q) { const int item = q ? (hasB ? itemB : itemA) : itemA; const int kb = item / nblk, nb = item % nblk; k0[q] = 64 * kb; n0[q] = 32 * nb;
        const int n = n0[q] + (lane & 31); sp[q] = nullptr; col[q] = 0;
        if (J.map == 0) { if (n < J.Nsrc) { sp[q] = J.src; col[q] = n; } }
        else if (J.map == 1) { if (n < 768) { sp[q] = J.src; col[q] = n; } else { const int c = n - 768; if (c < 32) { sp[q] = J.src; col[q] = 768 + c; } else if (c >= 128 && c < 160) { sp[q] = J.src; col[q] = 800 + (c - 128); } } }
        else { const int pn = n >> 8, c = n & 255; if (c < 128) { sp[q] = J.src; col[q] = pn * 128 + c; } else { sp[q] = J.src2; col[q] = pn * 128 + c - 128; } } }
    float v[2][32];
#pragma unroll
    for (int q = 0; q < 2; ++q)
#pragma unroll
        for (int i = 0; i < 32; ++i) { const int kk = 2 * i + (lane >> 5); float x = sp[q] ? sp[q][(size_t)(k0[q] + kk) * J.Nsrc + col[q]] : 0.f; if (J.gain) x *= J.gain[k0[q] + kk]; v[q][i] = x; }
#pragma unroll
    for (int q = 0; q < 2; ++q)
#pragma unroll
        for (int i = 0; i < 32; ++i) { const int kk = 2 * i + (lane >> 5); scr[q * 2112 + kk * 33 + (lane & 31)] = v[q][i]; }
    asm volatile("s_waitcnt lgkmcnt(0)" ::: "memory");
    const int c = lane & 7;
#pragma unroll
    for (int q = 0; q < 2; ++q) { if (q == 0 || hasB) {
#pragma unroll
        for (int j = 0; j < 4; ++j) { const int nn = (lane >> 3) + 8 * j; const LAS float* s = scr + q * 2112 + (8 * c) * 33 + nn;
            u32x4 o; o.x = pk2(s[0 * 33], s[1 * 33]); o.y = pk2(s[2 * 33], s[3 * 33]); o.z = pk2(s[4 * 33], s[5 * 33]); o.w = pk2(s[6 * 33], s[7 * 33]);
            *(u32x4*)(J.dst + (size_t)(n0[q] + nn) * J.K + k0[q] + 8 * c) = o; } } }
    asm volatile("s_waitcnt lgkmcnt(0)" ::: "memory");
}
__device__ __forceinline__ void phase_prologue(LAS unsigned char* lds) {
    int tid_o = threadIdx.x; asm volatile("" : "+v"(tid_o)); const int tid = tid_o, lane = tid & 63, wave = __builtin_amdgcn_readfirstlane(tid >> 6);
    const int gw = blockIdx.x * 8 + wave, NGW = gridDim.x * 8;
    LAS float* scr = (LAS float*)(lds + wave * 17408);
    int base = 0;
    for (int j = 0; j < 26; ++j) { const WJob J = get_job(j); const int cnt = (J.K / 64) * (J.Ndst / 32);
        int first = (gw - base) % NGW; if (first < 0) first += NGW;
        for (int it = first; it < cnt; it += 2 * NGW) wt_item2(J, scr, it, it + NGW, it + NGW < cnt, lane);
        base += cnt; }
    { float* tr = (float*)(PWS + WS_ROPE); float* tm = (float*)(PWS + WS_ROPEM); const int gt = blockIdx.x * 512 + tid, NT = gridDim.x * 512;
        for (int i = gt; i < TKS * 128 + TKS * 32; i += NT) {
            int pos, j, half; if (i < TKS * 128) { pos = i >> 7; j = i & 127; half = 128; } else { const int k = i - TKS * 128; pos = k >> 5; j = k & 31; half = 32; }
            const float inv = exp2f(-(float)j / (float)half * 13.287712379549449f);
            const float ang = (float)pos * inv; double rev = (double)ang * 0.15915494309189535; rev -= floor(rev); const float rf = (float)rev;
            const float c = __builtin_amdgcn_cosf(rf), s = __builtin_amdgcn_sinf(rf);
            if (half == 128) { tr[(size_t)pos * 256 + j] = c; tr[(size_t)pos * 256 + 128 + j] = s; } else { tm[(size_t)pos * 64 + j] = c; tm[(size_t)pos * 64 + 32 + j] = s; } } }
    { bf16_t* hb = (bf16_t*)(PWS + WS_HBB); float* ssq = (float*)(PWS + WS_SSQ);
        for (int r = gw; r < MT; r += NGW) { const float* x = r < MP ? PIN(0) + (size_t)r * D : PIN(1) + (size_t)(r - MP) * D; float s = 0.f;
#pragma unroll
            for (int j = 0; j < 4; ++j) { const f32x4 v = *(const f32x4*)(x + (lane + 64 * j) * 4); const u32x2 pw = pk4(v); *(u32x2*)(hb + (size_t)r * D + (lane + 64 * j) * 4) = pw; s += dot4(up4(pw)); }
            s = wave_sum(s); if (lane < 4) ssq[(size_t)r * 4 + lane] = lane == 0 ? s : 0.f; } }
}
__device__ __forceinline__ void cvt_chunks(const float* __restrict__ src, bf16_t* __restrict__ dst, size_t n8) {
    int tid_o = threadIdx.x; asm volatile("" : "+v"(tid_o)); const size_t gt = (size_t)blockIdx.x * 512 + tid_o, NT = (size_t)gridDim.x * 512;

    for (size_t i = gt; i < n8; i += NT) { const f32x4 a = *(const f32x4*)(src + i * 8), b = *(const f32x4*)(src + i * 8 + 4); u32x4 o; o.x = pk2(a[0], a[1]); o.y = pk2(a[2], a[3]); o.z = pk2(b[0], b[1]); o.w = pk2(b[2], b[3]); *(u32x4*)(dst + i * 8) = o; }
}
template <int width> __device__ __forceinline__ void cvt_cache(const float* __restrict__ src, bf16_t* __restrict__ dst) {
    constexpr int cpr = width / 8; const size_t n8 = (size_t)16 * 2048 * cpr;
    int tid_o = threadIdx.x; asm volatile("" : "+v"(tid_o)); const size_t gt = (size_t)blockIdx.x * 512 + tid_o, NT = (size_t)gridDim.x * 512;

    for (size_t i = gt; i < n8; i += NT) { const size_t row = i / cpr; const int ch = (int)(i % cpr); const size_t b = row >> 11, t = row & 2047;
        const float* s = src + row * width + ch * 8; const f32x4 a = *(const f32x4*)s, c = *(const f32x4*)(s + 4); u32x4 o; o.x = pk2(a[0], a[1]); o.y = pk2(a[2], a[3]); o.z = pk2(c[0], c[1]); o.w = pk2(c[2], c[3]);
        *(u32x4*)(dst + (b * TKS + t) * width + ch * 8) = o; }
}

struct AU { const bf16_t* Q; int qs; const bf16_t* K1; int k1s; const bf16_t* K2; int k2s; const bf16_t* V; int vs; bf16_t* O; int os; const bf16_t* G; int gs; const float* Fk;
            int q0, nq, off, Tk; };
struct MlaQ { const float* gqn; const float* gkn; const float* gqr; const float* ropem; };
template <int DK, int DV, int MODE>
__device__ __forceinline__ void attn_unit(LAS unsigned char* lds, const AU& a, const MlaQ& mq) {
    constexpr int KS = (DK + 8) * 2, VS = (DV + 16) * 2  , NS = DK / 32, NDB = DV / 16, KC = DK / 8, VC = DV / 8, KCH = 64 * KC / 512, VCH = 64 * VC / 512;
    constexpr int VOFF = 64 * KS, FOFF = VOFF + 64 * VS;
    int tid_o = threadIdx.x; asm volatile("" : "+v"(tid_o)); const int tid = tid_o, w = __builtin_amdgcn_readfirstlane(tid >> 6), lane = tid & 63, li = lane & 15, g = lane >> 4;
    const float cs = (MODE == 0 ? 0.07216878364870322f : 0.125f) * LOG2E;
    const bool active = 32 * w < a.nq;
    const int wq0 = a.q0 + 32 * w, rmax = a.q0 + a.nq - 1;
    bf16x8 qf[2][NS];
#pragma unroll
    for (int blk = 0; blk < 2; ++blk) { int row = wq0 + 16 * blk + li; row = row < rmax ? row : rmax; const bf16_t* qp = a.Q + (size_t)row * a.qs + 8 * g;
#pragma unroll
        for (int s = 0; s < NS; ++s) qf[blk][s] = *(const bf16x8*)(qp + 32 * s);
        if (MODE == 0) {
            float x[NS][8];
#pragma unroll
            for (int s = 0; s < NS; ++s)
#pragma unroll
                for (int j = 0; j < 8; ++j) x[s][j] = bf2f((unsigned short)qf[blk][s][j]);
            float ss = 0.f;
#pragma unroll
            for (int s = 0; s < 4; ++s)
#pragma unroll
                for (int j = 0; j < 8; ++j) ss += x[s][j] * x[s][j];
            ss = fq_sum(ss); const float rn = rsqrtf(ss * (1.f / 128.f) + EPS);
#pragma unroll
            for (int s = 0; s < 4; ++s)
{ const f32x4 ga = *(const f32x4*)(mq.gqn + 32 * s + 8 * g), gb = *(const f32x4*)(mq.gqn + 32 * s + 8 * g + 4), ha = *(const f32x4*)(mq.gkn + 32 * s + 8 * g), hb_ = *(const f32x4*)(mq.gkn + 32 * s + 8 * g + 4);
#pragma unroll
                  for (int j = 0; j < 4; ++j) { x[s][j] *= rn * ga[j] * ha[j]; x[s][4 + j] *= rn * gb[j] * hb_[j]; } }
            float sr = 0.f;
#pragma unroll
            for (int j = 0; j < 8; ++j) sr += x[4][j] * x[4][j] + x[5][j] * x[5][j];
            sr = fq_sum(sr); const float rr = rsqrtf(sr * (1.f / 64.f) + EPS);
            const float* tb = mq.ropem + (size_t)(a.off + row) * 64;
#pragma unroll
            for (int j = 0; j < 8; ++j) { const int dj = 8 * g + j; const float y1 = x[4][j] * rr * mq.gqr[dj], y2 = x[5][j] * rr * mq.gqr[32 + dj]; const float c = tb[dj], s = tb[32 + dj];
                x[4][j] = y1 * c - y2 * s; x[5][j] = y2 * c + y1 * s; }
#pragma unroll
            for (int s = 0; s < NS; ++s)
#pragma unroll
                for (int j = 0; j < 8; ++j) qf[blk][s][j] = (short)f2bf(x[s][j]);
        }
    }
    constexpr int QOFF = ((FOFF + 256 + 15) / 16) * 16;
    LAS unsigned char* qlds = lds + QOFF + w * (2 * NS * 1024) + lane * 16;
    if (MODE == 0) {
#pragma unroll
        for (int blk = 0; blk < 2; ++blk)
#pragma unroll
            for (int s = 0; s < NS; ++s) *(LAS bf16x8*)(qlds + (blk * NS + s) * 1024) = qf[blk][s];
    }
    const int last_pos = a.off + a.q0 + a.nq - 1;
    const int kend = MODE == 0 ? (((last_pos >> 6) + 1) * 64 < a.Tk ? ((last_pos >> 6) + 1) * 64 : a.Tk) : last_pos + 1;
    const int nt = (kend + 63) >> 6;
    f32x4 o[2][NDB]; float mrow[2], lrow[2];
#pragma unroll
    for (int blk = 0; blk < 2; ++blk) { mrow[blk] = -INFINITY; lrow[blk] = 0.f;
#pragma unroll
        for (int db = 0; db < NDB; ++db) o[blk][db] = (f32x4){0.f, 0.f, 0.f, 0.f}; }
    u32x4 kreg[2][KCH], vreg[2][VCH]; float freg[2] = {0.f, 0.f};
#define ATT_PREFETCH(t, P_) do { \
        _Pragma("unroll") for (int c_ = 0; c_ < KCH; ++c_) { const int id = tid + 512 * c_, key = id / KC, ch = id % KC; int kr_ = 64 * (t) + key; kr_ = kr_ < a.Tk ? kr_ : a.Tk - 1; \
            const bf16_t* p_ = (MODE == 0 && ch >= 16) ? a.K2 + (size_t)kr_ * a.k2s + (ch - 16) * 8 : a.K1 + (size_t)kr_ * a.k1s + ch * 8; kreg[P_][c_] = *(const u32x4*)p_; } \
        _Pragma("unroll") for (int c_ = 0; c_ < VCH; ++c_) { const int id = tid + 512 * c_, key = id / VC, ch = id % VC; int kr_ = 64 * (t) + key; kr_ = kr_ < a.Tk ? kr_ : a.Tk - 1; \
            vreg[P_][c_] = *(const u32x4*)(a.V + (size_t)kr_ * a.vs + ch * 8); } \
        if (MODE == 1) { int kr_ = 64 * (t) + (tid & 63); kr_ = kr_ < a.Tk ? kr_ : a.Tk - 1; freg[P_] = a.Fk[kr_]; } } while (0)
    ATT_PREFETCH(0, 0); if (nt > 1) ATT_PREFETCH(1, 1);
    const int wlo = a.off + wq0, whi = wlo + 31;
    for (int t0 = 0; t0 < nt; t0 += 2) {
#pragma unroll
      for (int P = 0; P < 2; ++P) { const int t = t0 + P; if (t < nt) {
        lds_barrier();
#pragma unroll
        for (int c_ = 0; c_ < KCH; ++c_) { const int id = tid + 512 * c_, key = id / KC, ch = id % KC; *(LAS u32x4*)(lds + key * KS + ch * 16) = kreg[P][c_]; }
#pragma unroll
        for (int c_ = 0; c_ < VCH; ++c_) { const int id = tid + 512 * c_, key = id / VC, ch = id % VC; *(LAS u32x4*)(lds + VOFF + key * VS + ch * 16) = vreg[P][c_]; }
        if (MODE == 1 && tid < 64) *(LAS float*)(lds + FOFF + tid * 4) = freg[P];
        lds_barrier();
        if (t + 2 < nt) ATT_PREFETCH(t + 2, P);
        const bool skip = !active || (MODE == 0 ? (t > (whi >> 6)) : (64 * t > whi));
        if (!skip) {
            const bool needmask = __builtin_amdgcn_readfirstlane((int)((MODE == 1 && 64 * t + 63 > wlo) || (64 * t + 63 >= a.Tk))) != 0;
            f32x4 sa[2][4];
#pragma unroll
            for (int blk = 0; blk < 2; ++blk)
#pragma unroll
                for (int kb = 0; kb < 4; ++kb) sa[blk][kb] = (f32x4){0.f, 0.f, 0.f, 0.f};
            if (MODE == 0) {
#pragma unroll
                for (int s = 0; s < NS; ++s) { const bf16x8 q0 = *(const LAS bf16x8*)(qlds + s * 1024), q1 = *(const LAS bf16x8*)(qlds + (NS + s) * 1024);
#pragma unroll
                    for (int kb = 0; kb < 4; ++kb) { const bf16x8 kf = *(const LAS bf16x8*)(lds + (16 * kb + li) * KS + (32 * s + 8 * g) * 2);
                        sa[0][kb] = __builtin_amdgcn_mfma_f32_16x16x32_bf16(kf, q0, sa[0][kb], 0, 0, 0);
                        sa[1][kb] = __builtin_amdgcn_mfma_f32_16x16x32_bf16(kf, q1, sa[1][kb], 0, 0, 0); }
                    }
            } else {
#pragma unroll
                for (int kb = 0; kb < 4; ++kb)
#pragma unroll
                    for (int s = 0; s < NS; ++s) { const bf16x8 kf = *(const LAS bf16x8*)(lds + (16 * kb + li) * KS + (32 * s + 8 * g) * 2);
                        sa[0][kb] = __builtin_amdgcn_mfma_f32_16x16x32_bf16(kf, qf[0][s], sa[0][kb], 0, 0, 0);
                        sa[1][kb] = __builtin_amdgcn_mfma_f32_16x16x32_bf16(kf, qf[1][s], sa[1][kb], 0, 0, 0); }
            }
            bf16x8 pf[2][2];
#pragma unroll
            for (int kb = 0; kb < 4; ++kb) { f32x4 fk = (f32x4){0.f, 0.f, 0.f, 0.f}; if (MODE == 1) fk = *(const LAS f32x4*)(lds + FOFF + (16 * kb + 4 * g) * 4);
                sa[0][kb] = sa[0][kb] * cs - fk; sa[1][kb] = sa[1][kb] * cs - fk; }
            if (needmask) {
#pragma unroll
                for (int blk = 0; blk < 2; ++blk) { const int pos = wlo + 16 * blk + li;
#pragma unroll
                    for (int kb = 0; kb < 4; ++kb)
#pragma unroll
                        for (int i = 0; i < 4; ++i) { const int key = 64 * t + 16 * kb + 4 * g + i; const bool ok = key < a.Tk && (MODE == 0 ? ((key >> 6) <= (pos >> 6)) : (key <= pos)); sa[blk][kb][i] = ok ? sa[blk][kb][i] : -INFINITY; } }
            }
#pragma unroll
            for (int blk = 0; blk < 2; ++blk) {
                float mx = -INFINITY;
#pragma unroll
                for (int kb = 0; kb < 4; ++kb)
#pragma unroll
                    for (int i = 0; i < 4; ++i) mx = fmaxf(mx, sa[blk][kb][i]);
                mx = fmaxf(mx, __shfl_xor(mx, 16)); mx = fmaxf(mx, __shfl_xor(mx, 32));
                const float mnew = fmaxf(mrow[blk], mx); float rsum = 0.f;
                if (__builtin_amdgcn_ballot_w64(mnew > mrow[blk]) != 0ull) {
                    const float alpha = __builtin_amdgcn_exp2f(mrow[blk] - mnew); mrow[blk] = mnew; lrow[blk] *= alpha;
#pragma unroll
                    for (int db = 0; db < NDB; ++db) o[blk][db] = o[blk][db] * alpha;
                }
#pragma unroll
                for (int kb = 0; kb < 4; ++kb)
#pragma unroll
                    for (int i = 0; i < 4; ++i) { const float p = __builtin_amdgcn_exp2f(sa[blk][kb][i] - mnew); sa[blk][kb][i] = p; rsum += p; }
                lrow[blk] += rsum;
#pragma unroll
                for (int kk = 0; kk < 2; ++kk) { const f32x4 p0 = sa[blk][2 * kk], p1 = sa[blk][2 * kk + 1]; u32x4 pw; pw.x = pk2(p0[0], p0[1]); pw.y = pk2(p0[2], p0[3]); pw.z = pk2(p1[0], p1[1]); pw.w = pk2(p1[2], p1[3]);
                    pf[blk][kk] = __builtin_bit_cast(bf16x8, pw); }
            }
#pragma unroll
            for (int kk = 0; kk < 2; ++kk)
#pragma unroll
                for (int db = 0; db < NDB; ++db) {
                    const unsigned ad = VOFF + (32 * kk + 4 * g + (li >> 2)) * VS + (16 * db + 4 * (li & 3)) * 2;
                    const s16x4 v0 = __builtin_amdgcn_ds_read_tr16_b64_v4i16((LAS s16x4*)(lds + ad)), v1 = __builtin_amdgcn_ds_read_tr16_b64_v4i16((LAS s16x4*)(lds + ad + 16 * VS));
                    bf16x8 vf; vf[0] = v0[0]; vf[1] = v0[1]; vf[2] = v0[2]; vf[3] = v0[3]; vf[4] = v1[0]; vf[5] = v1[1]; vf[6] = v1[2]; vf[7] = v1[3];
                    o[0][db] = __builtin_amdgcn_mfma_f32_16x16x32_bf16(vf, pf[0][kk], o[0][db], 0, 0, 0);
                    o[1][db] = __builtin_amdgcn_mfma_f32_16x16x32_bf16(vf, pf[1][kk], o[1][db], 0, 0, 0);  }
        }
      } }
    }
#undef ATT_PREFETCH
    if (active) {
#pragma unroll
        for (int blk = 0; blk < 2; ++blk) { const int rl = 32 * w + 16 * blk + li; const float inv = 1.f / fq_sum(lrow[blk]);
            if (rl < a.nq) { const size_t row = (size_t)(a.q0 + rl);
#pragma unroll
                for (int db = 0; db < NDB; ++db) { f32x4 v = o[blk][db] * inv;
                    if (MODE == 1) { const u32x2 gw = *(const u32x2*)(a.G + row * a.gs + 16 * db + 4 * g); v[0] *= bflo(gw.x); v[1] *= bfhi(gw.x); v[2] *= bflo(gw.y); v[3] *= bfhi(gw.y); }
                    *(u32x2*)(a.O + row * a.os + 16 * db + 4 * g) = pk4(v); } } }
    }
}

constexpr int R_QS = 528, R_VS = 272, R_AS = 144, R_SS = 528;
constexpr int R_QOFF = 0, R_KOFF = 64 * R_QS, R_VOFF = 2 * 64 * R_QS, R_AOFF = R_VOFF + 64 * R_VS, R_SOFF = R_AOFF + 64 * R_AS, R_END = R_SOFF + 8 * 16 * R_SS;
static_assert(R_END <= LDS_BYTES, "retention LDS");
__device__ __forceinline__ void ret_unit(LAS unsigned char* lds, const bf16_t* proj, bf16_t* obuf, int row0, int L, int nchunks, int h, int sl, const float* s0, float* sout) {
    int tid_o = threadIdx.x; asm volatile("" : "+v"(tid_o)); const int tid = tid_o, w = __builtin_amdgcn_readfirstlane(tid >> 6), lane = tid & 63, li = lane & 15, g = lane >> 4;
    const int NLB = L >> 4, KM = L >> 5;
    const float lg2 = log2f(1.f - exp2f(-5.f - (float)h));
    const float cdec = exp2f(lg2 * (float)L);
    LAS unsigned char* sst = lds + R_SOFF + w * (16 * R_SS);
    f32x4 S[16];
#pragma unroll
    for (int blk = 0; blk < 16; ++blk) {
        if (s0) {
#pragma unroll
            for (int i = 0; i < 4; ++i) S[blk][i] = s0[(size_t)(16 * blk + 4 * g + i) * 512 + sl * 128 + 16 * w + li];
        } else S[blk] = (f32x4){0.f, 0.f, 0.f, 0.f};
        *(LAS u32x2*)(sst + li * R_SS + (16 * blk + 4 * g) * 2) = pk4(S[blk]);
    }
    const bf16_t* qb = proj + (size_t)row0 * 6144 + h * 256, *kb = qb + 1024, *vb = proj + (size_t)row0 * 6144 + 2048 + h * 512 + sl * 128;
    u32x4 qr[4], kr[4], vr[2];
#define RET_PREFETCH(c) do { const size_t rb = (size_t)(c) * L; \
        _Pragma("unroll") for (int i_ = 0; i_ < 4; ++i_) { const int id = tid + 512 * i_, r_ = id >> 5, ch = id & 31; const int rr = r_ < L ? r_ : L - 1; \
            qr[i_] = *(const u32x4*)(qb + (rb + rr) * 6144 + ch * 8); kr[i_] = *(const u32x4*)(kb + (rb + rr) * 6144 + ch * 8); } \
        _Pragma("unroll") for (int i_ = 0; i_ < 2; ++i_) { const int id = tid + 512 * i_, r_ = id >> 4, ch = id & 15; const int rr = r_ < L ? r_ : L - 1; \
            vr[i_] = *(const u32x4*)(vb + (rb + rr) * 6144 + ch * 8); } } while (0)
    RET_PREFETCH(0);
    for (int c = 0; c < nchunks; ++c) {
        lds_barrier();
#pragma unroll
        for (int i_ = 0; i_ < 4; ++i_) { const int id = tid + 512 * i_, r_ = id >> 5, ch = id & 31; *(LAS u32x4*)(lds + R_QOFF + r_ * R_QS + ch * 16) = qr[i_]; *(LAS u32x4*)(lds + R_KOFF + r_ * R_QS + ch * 16) = kr[i_]; }
#pragma unroll
        for (int i_ = 0; i_ < 2; ++i_) { const int id = tid + 512 * i_, r_ = id >> 4, ch = id & 15; *(LAS u32x4*)(lds + R_VOFF + r_ * R_VS + ch * 16) = vr[i_]; }
        lds_barrier();
        if (c + 1 < nchunks) RET_PREFETCH(c + 1);
        { const int lb = w >> 1;
#pragma unroll
            for (int mbi = 0; mbi < 2; ++mbi) { const int mb = 2 * (w & 1) + mbi;
                if (lb < NLB && mb < NLB) { f32x4 av = (f32x4){0.f, 0.f, 0.f, 0.f};
                    if (mb <= lb) {
#pragma unroll
                        for (int s = 0; s < 8; ++s) { const bf16x8 af = *(const LAS bf16x8*)(lds + R_QOFF + (16 * lb + li) * R_QS + (32 * s + 8 * g) * 2), bf = *(const LAS bf16x8*)(lds + R_KOFF + (16 * mb + li) * R_QS + (32 * s + 8 * g) * 2);
                            av = __builtin_amdgcn_mfma_f32_16x16x32_bf16(af, bf, av, 0, 0, 0); }
                    }
#pragma unroll
                    for (int i = 0; i < 4; ++i) { const int l = 16 * lb + 4 * g + i, mm = 16 * mb + li; const float dm = l >= mm ? __builtin_amdgcn_exp2f(lg2 * (float)(l - mm)) : 0.f;
                        *(LAS unsigned short*)(lds + R_AOFF + l * R_AS + mm * 2) = (unsigned short)f2bf(av[i] * dm); } } } }
        lds_barrier();
        __builtin_amdgcn_sched_barrier(0);
        bf16x8 vf[2];
#pragma unroll
        for (int kk = 0; kk < 2; ++kk) { if (kk < KM) { const unsigned ad = R_VOFF + (32 * kk + 4 * g + (li >> 2)) * R_VS + (16 * w + 4 * (li & 3)) * 2;
                const s16x4 v0 = __builtin_amdgcn_ds_read_tr16_b64_v4i16((LAS s16x4*)(lds + ad)), v1 = __builtin_amdgcn_ds_read_tr16_b64_v4i16((LAS s16x4*)(lds + ad + 16 * R_VS));
                vf[kk][0] = v0[0]; vf[kk][1] = v0[1]; vf[kk][2] = v0[2]; vf[kk][3] = v0[3]; vf[kk][4] = v1[0]; vf[kk][5] = v1[1]; vf[kk][6] = v1[2]; vf[kk][7] = v1[3]; }
            else vf[kk] = (bf16x8){0, 0, 0, 0, 0, 0, 0, 0}; }
        f32x4 a1[4], a2[4];
#pragma unroll
        for (int lb = 0; lb < 4; ++lb) { a1[lb] = (f32x4){0.f, 0.f, 0.f, 0.f}; a2[lb] = (f32x4){0.f, 0.f, 0.f, 0.f}; }
#pragma unroll
        for (int kk = 0; kk < 2; ++kk) if (kk < KM) {
#pragma unroll
            for (int lb = 0; lb < 4; ++lb) if (lb < NLB) { const LAS unsigned char* ap = lds + R_AOFF + (16 * lb + li) * R_AS + (32 * kk + 4 * g) * 2;
                const u32x2 t0 = *(const LAS u32x2*)ap, t1 = *(const LAS u32x2*)(ap + 32); u32x4 tw; tw.x = t0.x; tw.y = t0.y; tw.z = t1.x; tw.w = t1.y;
                a1[lb] = __builtin_amdgcn_mfma_f32_16x16x32_bf16(vf[kk], __builtin_bit_cast(bf16x8, tw), a1[lb], 0, 0, 0); } }
#pragma unroll
        for (int s = 0; s < 8; ++s) { const bf16x8 sfr = *(const LAS bf16x8*)(sst + li * R_SS + (32 * s + 8 * g) * 2);
#pragma unroll
            for (int lb = 0; lb < 4; ++lb) if (lb < NLB) { const bf16x8 qf = *(const LAS bf16x8*)(lds + R_QOFF + (16 * lb + li) * R_QS + (32 * s + 8 * g) * 2);
                a2[lb] = __builtin_amdgcn_mfma_f32_16x16x32_bf16(sfr, qf, a2[lb], 0, 0, 0); } }
#pragma unroll
        for (int lb = 0; lb < 4; ++lb) if (lb < NLB) { const int l = 16 * lb + li; const float qd = __builtin_amdgcn_exp2f(lg2 * (float)(l + 1));
            *(u32x2*)(obuf + ((size_t)row0 + (size_t)c * L + l) * 2048 + h * 512 + sl * 128 + 16 * w + 4 * g) = pk4(a1[lb] + a2[lb] * qd); }
        __builtin_amdgcn_sched_barrier(0);
        bf16x8 vd[2];
#pragma unroll
        for (int kk = 0; kk < 2; ++kk) {
#pragma unroll
            for (int j = 0; j < 8; ++j) { const int mm = 32 * kk + (j < 4 ? 4 * g + j : 16 + 4 * g + (j - 4)); const float kd = __builtin_amdgcn_exp2f(lg2 * (float)(L - 1 - mm));
                vd[kk][j] = (short)f2bf(bf2f((unsigned short)vf[kk][j]) * kd); } }
#pragma unroll
        for (int blk = 0; blk < 16; ++blk) { f32x4 sv = S[blk] * cdec;
#pragma unroll
            for (int kk = 0; kk < 2; ++kk) if (kk < KM) { const unsigned ad = R_KOFF + (32 * kk + 4 * g + (li >> 2)) * R_QS + (16 * blk + 4 * (li & 3)) * 2;
                const s16x4 k0 = __builtin_amdgcn_ds_read_tr16_b64_v4i16((LAS s16x4*)(lds + ad)), k1 = __builtin_amdgcn_ds_read_tr16_b64_v4i16((LAS s16x4*)(lds + ad + 16 * R_QS));
                bf16x8 kf; kf[0] = k0[0]; kf[1] = k0[1]; kf[2] = k0[2]; kf[3] = k0[3]; kf[4] = k1[0]; kf[5] = k1[1]; kf[6] = k1[2]; kf[7] = k1[3];
                sv = __builtin_amdgcn_mfma_f32_16x16x32_bf16(kf, vd[kk], sv, 0, 0, 0); }
            S[blk] = sv;
            *(LAS u32x2*)(sst + li * R_SS + (16 * blk + 4 * g) * 2) = pk4(sv);
            if ((blk & 3) == 3) __builtin_amdgcn_sched_barrier(0); }
    }
#undef RET_PREFETCH
#pragma unroll
    for (int blk = 0; blk < 16; ++blk)
#pragma unroll
        for (int i = 0; i < 4; ++i) sout[(size_t)(16 * blk + 4 * g + i) * 512 + sl * 128 + 16 * w + li] = S[blk][i];
}
__device__ __forceinline__ void phase_ret_ln(int j) {
    int tid_o = threadIdx.x; asm volatile("" : "+v"(tid_o)); const int tid = tid_o, lane = tid & 63, wave = tid >> 6, gw = blockIdx.x * 8 + wave, NGW = gridDim.x * 8;
    bf16_t* obuf = (bf16_t*)(PWS + PL_ROBUF); const bf16_t* proj = (const bf16_t*)(PWS + PL_RPROJ); const float* gn = PIN(15) + (size_t)j * 2048;
    for (int it0 = gw; it0 < MT * 4; it0 += 2 * NGW) {
        u32x4 ow[2], gwd[2]; f32x4 g0[2], g1[2]; bf16_t* op[2]; bool ok[2];
#pragma unroll
        for (int q = 0; q < 2; ++q) { int it = it0 + q * NGW; ok[q] = it < MT * 4; it = ok[q] ? it : it0; const int r = it >> 2, h = it & 3; op[q] = obuf + (size_t)r * 2048 + h * 512 + lane * 8;
            ow[q] = *(const u32x4*)op[q]; gwd[q] = *(const u32x4*)(proj + (size_t)r * 6144 + 4096 + h * 512 + lane * 8);
            g0[q] = *(const f32x4*)(gn + h * 512 + lane * 8); g1[q] = *(const f32x4*)(gn + h * 512 + lane * 8 + 4); }
#pragma unroll
        for (int q = 0; q < 2; ++q) {
            float x[8] = {bflo(ow[q].x), bfhi(ow[q].x), bflo(ow[q].y), bfhi(ow[q].y), bflo(ow[q].z), bfhi(ow[q].z), bflo(ow[q].w), bfhi(ow[q].w)};
            const float sg[8] = {bflo(gwd[q].x), bfhi(gwd[q].x), bflo(gwd[q].y), bfhi(gwd[q].y), bflo(gwd[q].z), bfhi(gwd[q].z), bflo(gwd[q].w), bfhi(gwd[q].w)};
            float sm = 0.f;
#pragma unroll
            for (int e = 0; e < 8; ++e) sm += x[e];
            const float mu = wave_sum(sm) * (1.f / 512.f); float qv = 0.f;
#pragma unroll
            for (int e = 0; e < 8; ++e) { x[e] -= mu; qv += x[e] * x[e]; }
            const float rstd = rsqrtf(wave_sum(qv) * (1.f / 512.f) + EPS);
            u32x4 o; o.x = pk2(x[0] * rstd * g0[q][0] * sg[0], x[1] * rstd * g0[q][1] * sg[1]); o.y = pk2(x[2] * rstd * g0[q][2] * sg[2], x[3] * rstd * g0[q][3] * sg[3]);
            o.z = pk2(x[4] * rstd * g1[q][0] * sg[4], x[5] * rstd * g1[q][1] * sg[5]); o.w = pk2(x[6] * rstd * g1[q][2] * sg[6], x[7] * rstd * g1[q][3] * sg[7]);
            if (ok[q]) *(u32x4*)op[q] = o; } }
}
__device__ __forceinline__ void phase_fox_scan() {
    int tid_o = threadIdx.x; asm volatile("" : "+v"(tid_o)); const int tid = tid_o, lane = tid & 63, wave = tid >> 6, gw = blockIdx.x * 8 + wave, NGW = gridDim.x * 8;
    for (int it = gw; it < 512; it += NGW) { const int grp = it >> 8, bh = it & 255, b = bh >> 4, h = bh & 15; const int T = grp ? TKS : SEQ, per = grp ? 33 : 32;
        float* F = grp ? (float*)(PWS + WS_FS) + (size_t)bh * TKS : (float*)(PWS + WS_FP) + (size_t)bh * SEQ;
        const float* srcA = grp ? PIN(7) + (size_t)b * SEQ * 16 + h : POUT + O_FLP + (size_t)b * SEQ * 16 + h;
        const float* srcB = POUT + O_FLS + (size_t)b * DEC * 16 + h;
        const int t0 = lane * per; float v[33]; float s = 0.f;
#pragma unroll
        for (int e = 0; e < 33; ++e) { const int t = t0 + e; v[e] = (e < per && t < T) ? (t < SEQ ? srcA[(size_t)t * 16] : srcB[(size_t)(t - SEQ) * 16]) : 0.f; }
#pragma unroll
        for (int e = 0; e < 33; ++e) s += v[e];
        float inc = s;
#pragma unroll
        for (int o = 1; o < 64; o <<= 1) { const float n = __shfl_up(inc, o); if (lane >= o) inc += n; }
        float run = inc - s;
#pragma unroll
        for (int e = 0; e < 33; ++e) { const int t = t0 + e; run += v[e]; if (e < per && t < T) F[t] = run * LOG2E; } }
}
__device__ __forceinline__ void phase_final() {
    int tid_o = threadIdx.x; asm volatile("" : "+v"(tid_o)); const int tid = tid_o, lane = tid & 63, wave = tid >> 6, gw = blockIdx.x * 8 + wave, NGW = gridDim.x * 8; const float* gf = PIN(13);
    const bf16_t* hb = (const bf16_t*)(PWS + WS_HBB);
    for (int r = gw; r < MT; r += NGW) { float* y = POUT + O_Y + (size_t)r * D; f32x4 v[4]; float s = 0.f;
#pragma unroll
        for (int j = 0; j < 4; ++j) { v[j] = up4(*(const u32x2*)(hb + (size_t)r * D + (lane + 64 * j) * 4)); s += dot4(v[j]); }
        const float rstd = rsqrtf(wave_sum(s) * (1.f / 1024.f) + EPS);
#pragma unroll
        for (int j = 0; j < 4; ++j) *(f32x4*)(y + (lane + 64 * j) * 4) = v[j] * rstd * *(const f32x4*)(gf + (lane + 64 * j) * 4); }
}

template <int EPI>
__device__ __forceinline__ void sample_gemm(LAS unsigned char* lds, const bf16_t* A, const bf16_t* Bt, int K, const bf16_t* hin, bf16_t* hout, float* ssqw, const float* ssqr, const bf16_t* pp, bf16_t* outp) {
    int tid_o = threadIdx.x; asm volatile("" : "+v"(tid_o)); const int tid = tid_o, w = __builtin_amdgcn_readfirstlane(tid >> 6), lane = tid & 63, li = lane & 15, g = lane >> 4;
    LAS float* xs = (LAS float*)(lds + XR_OFF);
    for (int mu = blockIdx.x; mu < 128; mu += gridDim.x) {
        const int rsb = mu >> 2, pn = mu & 3, row = MP + 16 * rsb + li, kw = K >> 3;
        f32x4 acc[16];
#pragma unroll
        for (int cb = 0; cb < 16; ++cb) acc[cb] = (f32x4){0.f, 0.f, 0.f, 0.f};
        const bf16_t* ap = A + (size_t)row * K + w * kw + 8 * g;
        const bf16_t* bp = Bt + (size_t)(pn * 256 + li) * K + w * kw + 8 * g;
        bf16x8 a0 = *(const bf16x8*)ap, b0[16], a1, b1[16];
#pragma unroll
        for (int cb = 0; cb < 16; ++cb) b0[cb] = *(const bf16x8*)(bp + (size_t)cb * 16 * K);
        for (int ks = 0; ks < kw; ks += 64) {
            const bool h1 = ks + 32 < kw, h2 = ks + 64 < kw;
            if (h1) { a1 = *(const bf16x8*)(ap + ks + 32);
#pragma unroll
                for (int cb = 0; cb < 16; ++cb) b1[cb] = *(const bf16x8*)(bp + (size_t)cb * 16 * K + ks + 32); }
#pragma unroll
            for (int cb = 0; cb < 16; ++cb) acc[cb] = __builtin_amdgcn_mfma_f32_16x16x32_bf16(b0[cb], a0, acc[cb], 0, 0, 0);
            if (h2) { a0 = *(const bf16x8*)(ap + ks + 64);
#pragma unroll
                for (int cb = 0; cb < 16; ++cb) b0[cb] = *(const bf16x8*)(bp + (size_t)cb * 16 * K + ks + 64); }
            if (h1) {
#pragma unroll
                for (int cb = 0; cb < 16; ++cb) acc[cb] = __builtin_amdgcn_mfma_f32_16x16x32_bf16(b1[cb], a1, acc[cb], 0, 0, 0); }
        }
        lds_barrier();
#pragma unroll
        for (int cb = 0; cb < 16; ++cb) *(LAS f32x4*)(lds + ((w * 16 + cb) * 64 + lane) * 16) = acc[cb];
        lds_barrier();
        f32x4 v[2];
#pragma unroll
        for (int e = 0; e < 2; ++e) { v[e] = (f32x4){0.f, 0.f, 0.f, 0.f};
#pragma unroll
            for (int ww = 0; ww < 8; ++ww) v[e] += *(const LAS f32x4*)(lds + ((ww * 16 + 2 * w + e) * 64 + lane) * 16); }
        const size_t off = (size_t)row * D + pn * 256 + 32 * w + 4 * g;
        if (EPI == 2) {
#pragma unroll
            for (int e = 0; e < 2; ++e) *(u32x2*)(outp + off + 16 * e) = pk4(v[e]);
        } else {
            float ss = 0.f; float rs = 1.f; if (EPI == 1) rs = row_rstd(ssqr, row, 1.f / 1024.f);
#pragma unroll
            for (int e = 0; e < 2; ++e) { f32x4 o = up4(*(const u32x2*)(hin + off + 16 * e));
                if (EPI == 0) o += v[e];
                else { const u32x2 pw = *(const u32x2*)(pp + off + 16 * e); const f32x4 a = v[e] * rs;
                    o[0] += sigmoidf_(a[0]) * bflo(pw.x); o[1] += sigmoidf_(a[1]) * bfhi(pw.x); o[2] += sigmoidf_(a[2]) * bflo(pw.y); o[3] += sigmoidf_(a[3]) * bfhi(pw.y); }
                const u32x2 ow = pk4(o); *(u32x2*)(hout + off + 16 * e) = ow; ss += dot4(up4(ow)); }
            ss = fq_sum(ss); if (g == 0) xs[li * 8 + w] = ss;
            lds_barrier();
            if (w == 0 && g == 0) { const f32x4 t0 = *(const LAS f32x4*)(xs + li * 8), t1 = *(const LAS f32x4*)(xs + li * 8 + 4); ssqw[(size_t)row * 4 + pn] = ((t0[0] + t0[1]) + (t0[2] + t0[3])) + ((t1[0] + t1[1]) + (t1[2] + t1[3])); }
        }
    }
    lds_barrier();
}

#define XB_TMO      128
#define XB_XCNT(j)  (256  + 64 * (j))
#define XB_XSUB(j)  (1280 + 64 * (j))
#define XB_XGEN(j)  (2304 + 64 * (j))
#define XB_TOP      3328
#define XB_TOPGEN   3392
#define XCD_BAR_WORDS 3456
#define XB_SPIN_CAP (1u << 18)

__device__ __forceinline__ unsigned xb_ld(unsigned* p)              { return __hip_atomic_load(p, __ATOMIC_RELAXED, __HIP_MEMORY_SCOPE_AGENT); }
__device__ __forceinline__ unsigned xb_add(unsigned* p, unsigned v) { return __hip_atomic_fetch_add(p, v, __ATOMIC_RELAXED, __HIP_MEMORY_SCOPE_AGENT); }
__device__ __forceinline__ unsigned xb_xcc_id() { return (unsigned)__builtin_amdgcn_s_getreg((3 << 11) | 20) & 0xFu; }
#define XB_SPIN(cond, bar) do { unsigned _sp = 0; while (cond) { __builtin_amdgcn_s_sleep(1); \
    if ((++_sp & 255u) == 0u) { if (xb_ld(&(bar)[XB_TMO])) break; if (_sp > XB_SPIN_CAP) { atomicAdd(&(bar)[XB_TMO], 1u); break; } } } } while (0)

struct XcdBarrier {
    unsigned* bar; unsigned x;
    volatile LAS unsigned* st;
};

__device__ __forceinline__ XcdBarrier xcd_barrier_post(unsigned* bar, volatile LAS unsigned* st) {
    XcdBarrier b; b.bar = bar; b.x = xb_xcc_id(); b.st = st;
    if (threadIdx.x == 0) (void)xb_add(&bar[XB_XCNT(b.x)], 1u);
    return b;
}
__device__ __forceinline__ void xcd_barrier_complete(unsigned* bar, unsigned x, unsigned& nloc, unsigned& nx) {
    const unsigned G = gridDim.x * gridDim.y * gridDim.z;
    unsigned sum, cnt, mine, sp = 0u;
    for (;;) {
        sum = 0u; cnt = 0u; mine = 0u;
#pragma unroll
        for (unsigned j = 0; j < 16; ++j) { const unsigned c = xb_ld(&bar[XB_XCNT(j)]); sum += c; cnt += (c > 0u) ? 1u : 0u; mine = (j == x) ? c : mine; }
        if (sum == G) break;
        __builtin_amdgcn_s_sleep(1);
        if ((++sp & 255u) == 0u) { if (xb_ld(&bar[XB_TMO])) break; if (sp > XB_SPIN_CAP) { atomicAdd(&bar[XB_TMO], 1u); break; } }
    }
    nloc = mine > 0u ? mine : 1u; nx = cnt > 0u ? cnt : 1u;
}

__device__ __forceinline__ void xcd_barrier(const XcdBarrier& b) {
    asm volatile("s_waitcnt vmcnt(0)" ::: "memory");
    __syncthreads();
    if (threadIdx.x == 0) {
        unsigned* bar = b.bar;
        __builtin_amdgcn_s_waitcnt(0);
        unsigned nloc = b.st[0], nx = b.st[1];
        if (nloc == 0u) { xcd_barrier_complete(bar, b.x, nloc, nx); b.st[0] = nloc; b.st[1] = nx; }
        const unsigned old = xb_add(&bar[XB_XSUB(b.x)], 1u);
        const unsigned gen = old / nloc;
        if (old + 1u == (gen + 1u) * nloc) {
            __builtin_amdgcn_fence(__ATOMIC_RELEASE, "agent");
            asm volatile("s_waitcnt vmcnt(0)" ::: "memory");
            const unsigned og = xb_add(&bar[XB_TOP], 1u);
            const unsigned tg = og / nx;
            if (og + 1u == (tg + 1u) * nx) xb_add(&bar[XB_TOPGEN], 1u);
            else XB_SPIN(xb_ld(&bar[XB_TOPGEN]) == tg, bar);
            __builtin_amdgcn_fence(__ATOMIC_ACQUIRE, "agent");
            xb_add(&bar[XB_XGEN(b.x)], 1u);
            asm volatile("s_waitcnt vmcnt(0)" ::: "memory");
        } else {
            XB_SPIN(xb_ld(&bar[XB_XGEN(b.x)]) == gen, bar);
            __builtin_amdgcn_fence(__ATOMIC_ACQUIRE, "agent");
            asm volatile("s_waitcnt vmcnt(0)" ::: "memory");
        }
    }
    __syncthreads();
}


typedef pg8::StaticOrder SO;
#define GEMM(EpiT, A_, Bt_, M_, N_, K_, E_) do { pg8::Gemm g_{(const bf16_t*)(A_), (const bf16_t*)(Bt_), (M_), (N_), (K_)}; SO S_; S_.init((M_), (N_), (int)gridDim.x, (int)blockIdx.x); \
        pg8::gemm_phase<EpiT, SO, true, true>(lds, g_, S_, (E_)); } while (0)

__global__ void __launch_bounds__(512, 2) trunk_fwd(Params P) {
    extern __shared__ __attribute__((aligned(16))) unsigned char lds_raw[];
    LAS unsigned char* lds = (LAS unsigned char*)lds_raw;
    cg::grid_group grid = cg::this_grid();
#define RUN true
#ifdef PROBE_SEL
    unsigned long long tacc = 0, tlast = __builtin_amdgcn_s_memrealtime(); int curcat = 0;
#define TSWITCH(c) do { const unsigned long long tn_ = __builtin_amdgcn_s_memrealtime(); if (curcat == PROBE_SEL) tacc += tn_ - tlast; tlast = tn_; curcat = (c); } while (0)
#define RUNT(c) ({ TSWITCH(c); RUN; })
#else
#define TSWITCH(c) do { } while (0)
#define RUNT(c) RUN
#endif
#ifndef ONLY
#define EN(k) true
#else
#define EN(k) ((k) == ONLY)
#endif
#define SEAM() do { TSWITCH(5); { XcdBarrier b_; b_.bar = (unsigned*)(PWS + WS_BAR); b_.x = xb_xcc_id(); b_.st = (volatile LAS unsigned*)(lds + LDS_BYTES - 64); xcd_barrier(b_); } TSWITCH(6); } while (0)
#define WB ((bf16_t*)(PWS + WS_W))
#define HBA ((bf16_t*)(PWS + WS_HBA))
#define HBB ((bf16_t*)(PWS + WS_HBB))
#define SSQ0 ((float*)(PWS + WS_SSQ))
#define SSQ1 ((float*)(PWS + WS_SSQ) + (size_t)MT * 4)
#define HRES (POUT + O_Y)
#define ROPE_ ((const float*)(PWS + WS_ROPE))
#define ROPEM_ ((const float*)(PWS + WS_ROPEM))
    LAS float* xr = (LAS float*)(lds + XR_OFF);
    volatile LAS unsigned* bst = (volatile LAS unsigned*)(lds + LDS_BYTES - 64);
    if (threadIdx.x < 2) bst[threadIdx.x] = 0u;
    __syncthreads();
#define SSQ_P(p) ((((layer) ^ (p)) & 1) ? SSQ1 : SSQ0)

    if (blockIdx.x == 0) { unsigned* bw = (unsigned*)(PWS + WS_BAR); for (int i = threadIdx.x; i < XCD_BAR_WORDS; i += 512) __hip_atomic_store(bw + i, 0u, __ATOMIC_RELAXED, __HIP_MEMORY_SCOPE_AGENT); }
    if (EN(1) && RUNT(4)) phase_prologue(lds);
    TSWITCH(5); grid.sync(); (void)xcd_barrier_post((unsigned*)(PWS + WS_BAR), bst); TSWITCH(6);

    for (int layer = 0; layer < 4; ++layer) {
        const int kind = layer % 3, j = layer / 3;
        if (kind == 0) {
            bf16_t* proj = (bf16_t*)(PWS + PL_RPROJ); bf16_t* obuf = (bf16_t*)(PWS + PL_ROBUF);
            if (EN(2) && RUNT(1)) { EpiRetIn E{SSQ_P(0), proj, ROPE_}; GEMM(EpiRetIn, HBB, WB + W_RI + j * SZ_RI, MT, 6144, 1024, E); }
            SEAM();
            if (EN(3) && RUNT(3)) {
                for (int u = blockIdx.x; u < 512; u += gridDim.x) { const int grp = u >> 8, c = u & 255, b = c >> 4, h = (c >> 2) & 3, sl = c & 3;
                    const size_t so = ((size_t)(j * 16 + b) * 4 + h) * 131072;
                    if (!grp) ret_unit(lds, proj, obuf, b * SEQ, 64, 32, h, sl, nullptr, POUT + O_RSP + so);
                    else ret_unit(lds, proj, obuf, MP + b * DEC, 32, 1, h, sl, PIN(2) + so, POUT + O_RSS + so);
                    lds_barrier(); }
            }
            SEAM();
            if (EN(4) && RUNT(3)) phase_ret_ln(j);
            SEAM();
            if (EN(5) && RUNT(1)) { sample_gemm<0>(lds, obuf, WB + W_RO + j * SZ_RO, 2048, HBB, HBA, SSQ_P(1), nullptr, nullptr, nullptr); EpiRes E{HBB, HBA, SSQ_P(1), xr}; GEMM(EpiRes, obuf, WB + W_RO + j * SZ_RO, MP, 1024, 2048, E); }
            SEAM();
        } else if (kind == 1) {
            bf16_t* cqb = (bf16_t*)(PWS + PL_CQB); float* cqss = (float*)(PWS + WS_CQSS); bf16_t* latb = (bf16_t*)(PWS + PL_LATB); bf16_t* krb = (bf16_t*)(PWS + PL_KRB);
            bf16_t* mq = (bf16_t*)(POUT + O_FKP); bf16_t* kvh = (bf16_t*)(PWS + PL_KVH); bf16_t* mo = (bf16_t*)(PWS + PL_MO);
            if (EN(6) && RUNT(1)) {
                cvt_cache<256>(PIN(3), latb + (size_t)MP * 256); cvt_cache<64>(PIN(4), krb + (size_t)MP * 64);
                EpiMlaIn E{SSQ_P(0), PWS, POUT, PIN(19), PIN(25), xr}; GEMM(EpiMlaIn, HBB, WB + W_MI, MT, 1024, 1024, E); }
            SEAM();
            for (int hh = 0; hh < 2; ++hh) {
                if (EN(7) && RUNT(1)) {
                    if (hh == 0) { EpiPlain E{mq, 3072, cqss, 1.f / 512.f}; GEMM(EpiPlain, cqb, WB + W_QB, MT, 3072, 512, E); }
                    EpiKV E2{kvh, xr}; GEMM(EpiKV, latb, WB + W_KVB + (size_t)hh * 2048 * 256, KVR, 2048, 256, E2); }
                SEAM();
                if (EN(8) && RUNT(2)) {
                    const MlaQ q4{PIN(22), PIN(24), PIN(23), ROPEM_};
                    for (int u = blockIdx.x; u < 6 * 256; u += gridDim.x) { const int i = u >> 8, c = u & 255;
                        const int qb = c < 128 ? (i == 0 ? -1 : (i == 1 ? 7 : (i == 2 ? 5 : -2))) : (i == 0 ? 6 : (i == 1 ? 4 : 5 - i));
                        if (qb > -2) { const int bh = c & 127, b = bh >> 3, hl = bh & 7, hd = hh * 8 + hl; const bool pr = qb >= 0;
                            const size_t rq = pr ? (size_t)b * SEQ : (size_t)MP + (size_t)b * DEC, rk = pr ? (size_t)b * SEQ : (size_t)MP + (size_t)b * TKS; AU a;
                            a.Q = mq + rq * 3072 + hd * 192; a.qs = 3072; a.K1 = kvh + rk * 2048 + hl * 256; a.k1s = 2048; a.K2 = krb + rk * 64; a.k2s = 64; a.V = kvh + rk * 2048 + hl * 256 + 128; a.vs = 2048;
                            a.O = mo + rq * 2048 + hd * 128; a.os = 2048; a.G = nullptr; a.gs = 0; a.Fk = nullptr; a.q0 = pr ? qb * 256 : 0; a.nq = pr ? 256 : DEC; a.off = pr ? 0 : SEQ; a.Tk = pr ? SEQ : TKS;
                            attn_unit<192, 128, 0>(lds, a, q4); } }

                    lds_barrier();
                }
                SEAM();
            }
            if (EN(9) && RUNT(1)) { sample_gemm<0>(lds, mo, WB + W_MO, 2048, HBB, HBA, SSQ_P(1), nullptr, nullptr, nullptr); EpiRes E{HBB, HBA, SSQ_P(1), xr}; GEMM(EpiRes, mo, WB + W_MO, MP, 1024, 2048, E); }
            SEAM();
        } else {
            bf16_t* proj = (bf16_t*)(PWS + PL_FPROJ); bf16_t* kall = (bf16_t*)(PWS + PL_FKALL); bf16_t* vall = (bf16_t*)(PWS + PL_FVALL); bf16_t* fo = (bf16_t*)(PWS + PL_FO);
            if (EN(10) && RUNT(1)) {
                cvt_cache<1024>(PIN(5), kall); cvt_cache<1024>(PIN(6), vall);
                EpiFoxIn E{SSQ_P(0), PWS, POUT, PIN(29), PIN(30), PIN(28), xr}; GEMM(EpiFoxIn, HBB, WB + W_FI, MT, 4352, 1024, E); }
            SEAM();
            if (EN(11) && RUNT(6)) phase_fox_scan();
            SEAM();
            if (EN(12) && RUNT(2)) {
                const MlaQ q4{nullptr, nullptr, nullptr, nullptr};
                for (int u = blockIdx.x; u < 2048 + 256; u += gridDim.x) { AU a; a.K2 = nullptr; a.k2s = 0;
                    if (u < 2048) { const int qb = u >> 8, bh = u & 255, b = bh >> 4, hd = bh & 15; const size_t r0 = (size_t)b * SEQ;
                        a.Q = proj + r0 * 4096 + hd * 64; a.qs = 4096; a.K1 = proj + r0 * 4096 + 1024 + hd * 64; a.k1s = 4096; a.V = proj + r0 * 4096 + 2048 + hd * 64; a.vs = 4096;
                        a.O = fo + r0 * 1024 + hd * 64; a.os = 1024; a.G = proj + r0 * 4096 + 3072 + hd * 64; a.gs = 4096; a.Fk = (const float*)(PWS + WS_FP) + (size_t)bh * SEQ; a.q0 = qb * 256; a.nq = 256; a.off = 0; a.Tk = SEQ; }
                    else { const int bh = u - 2048, b = bh >> 4, hd = bh & 15; const size_t rq = (size_t)MP + (size_t)b * DEC, rk = (size_t)b * TKS;
                        a.Q = proj + rq * 4096 + hd * 64; a.qs = 4096; a.K1 = kall + rk * 1024 + hd * 64; a.k1s = 1024; a.V = vall + rk * 1024 + hd * 64; a.vs = 1024;
                        a.O = fo + rq * 1024 + hd * 64; a.os = 1024; a.G = proj + rq * 4096 + 3072 + hd * 64; a.gs = 4096; a.Fk = (const float*)(PWS + WS_FS) + (size_t)bh * TKS; a.q0 = 0; a.nq = DEC; a.off = SEQ; a.Tk = TKS; }
                    attn_unit<64, 64, 1>(lds, a, q4); }
                lds_barrier();
            }
            SEAM();
            if (EN(13) && RUNT(1)) { sample_gemm<0>(lds, fo, WB + W_FO, 1024, HBB, HBA, SSQ_P(1), nullptr, nullptr, nullptr); EpiRes E{HBB, HBA, SSQ_P(1), xr}; GEMM(EpiRes, fo, WB + W_FO, MP, 1024, 1024, E); }
            SEAM();
        }
        bf16_t* act = (bf16_t*)(PWS + PL_ACT); bf16_t* pb = (bf16_t*)(PWS + PL_PB); bf16_t* pp = (bf16_t*)(PWS + PL_PP);
        if (EN(14) && RUNT(1)) {
            cvt_chunks(PIN(8) + (size_t)layer * MP * 256, pb, (size_t)MP * 32); cvt_chunks(PIN(9) + (size_t)layer * MS * 256, pb + (size_t)MP * 256, (size_t)MS * 32);
            EpiGU E{SSQ_P(1), act}; GEMM(EpiGU, HBA, WB + W_GU + layer * SZ_GU, MT, 5632, 1024, E); }
        SEAM();
        if (EN(15) && RUNT(1)) {
            sample_gemm<0>(lds, act, WB + W_DN + layer * SZ_DN, DFF, HBA, HBA, SSQ_P(0), nullptr, nullptr, nullptr);
            sample_gemm<2>(lds, pb, WB + W_PP + layer * SZ_PP, 256, nullptr, nullptr, nullptr, nullptr, nullptr, pp);
            { EpiRes E{HBA, HBA, SSQ_P(0), xr}; GEMM(EpiRes, act, WB + W_DN + layer * SZ_DN, MP, 1024, DFF, E); }
            { EpiPlain E{pp, 1024, nullptr, 0.f}; GEMM(EpiPlain, pb, WB + W_PP + layer * SZ_PP, MP, 1024, 256, E); } }
        SEAM();
        if (EN(16) && RUNT(1)) { sample_gemm<1>(lds, HBA, WB + W_PG + layer * SZ_PG, 1024, HBA, HBB, SSQ_P(1), SSQ_P(0), pp, nullptr); EpiPE E{HBA, pp, HBB, SSQ_P(0), SSQ_P(1), xr}; GEMM(EpiPE, HBA, WB + W_PG + layer * SZ_PG, MP, 1024, 1024, E); }
        SEAM();
    }
    if (EN(17) && RUNT(6)) phase_final();
#ifdef PROBE_SEL
    TSWITCH(0);
    if (blockIdx.x == 0 && threadIdx.x == 0) { asm volatile("s_waitcnt vmcnt(0)" ::: "memory"); POUT[0] += (float)tacc * 1e-5f; }
#endif
}

extern "C" void kernel_launch(void* const* d_in, const int* in_sizes, int n_in, void* d_out, int out_size, void* d_ws, size_t ws_size, hipStream_t stream) {
    static int grid = 0;
    if (grid == 0) {
        if (n_in != 37 || (size_t)out_size != O_END || ws_size < WS_NEED) { fprintf(stderr, "kernel_launch: unexpected sizes n_in %d out %d ws %zu (need %zu)\n", n_in, out_size, ws_size, (size_t)WS_NEED); grid = -1; return; }
        int dev = 0, cus = 0, per_cu = 0;
        if (hipGetDevice(&dev) != hipSuccess || hipDeviceGetAttribute(&cus, hipDeviceAttributeMultiprocessorCount, dev) != hipSuccess) { grid = -1; return; }
        if (hipFuncSetAttribute((const void*)trunk_fwd, hipFuncAttributeMaxDynamicSharedMemorySize, LDS_BYTES) != hipSuccess) { fprintf(stderr, "kernel_launch: hipFuncSetAttribute failed\n"); grid = -1; return; }
        if (hipOccupancyMaxActiveBlocksPerMultiprocessor(&per_cu, (const void*)trunk_fwd, 512, LDS_BYTES) != hipSuccess || per_cu < 1) { fprintf(stderr, "kernel_launch: occupancy query says %d\n", per_cu); per_cu = 1; }
        (void)hipGetLastError();
        grid = cus * per_cu;
    }
    if (grid < 0) return;
    Params p{};
    for (int i = 0; i < 37; ++i) p.in[i] = (const float*)d_in[i];
    p.out = (float*)d_out; p.ws = (unsigned char*)d_ws; p.ph_lo = 0; p.ph_hi = 1000;
    void* args[] = {&p};
    hipError_t e = hipLaunchCooperativeKernel((const void*)trunk_fwd, dim3(grid), dim3(512), args, LDS_BYTES, stream);
    if (e != hipSuccess) fprintf(stderr, "cooperative launch failed: %s (grid %d)\n", hipGetErrorString(e), grid);
}
```

```cpp
#include <hip/hip_runtime.h>
#include <hip/hip_cooperative_groups.h>
#include <cstdio>
#include <cstdint>
namespace cg = cooperative_groups;
namespace pg8 {
#define PG8_LAS __attribute__((address_space(3)))
typedef unsigned short bf16_t;
typedef short bf16x8 __attribute__((ext_vector_type(8)));
typedef float f32x4 __attribute__((ext_vector_type(4)));
typedef unsigned u32x4 __attribute__((ext_vector_type(4)));
constexpr int BM = 256, BK = 64, HALF = 128, HTB = HALF * BK * 2  , STAGE_BYTES = 8 * HTB, NXCD = 8, WGM = 8;

__host__ __device__ __forceinline__ int lds_byte(int r, int c) { const int st = (r >> 4) * 2 + (c >> 5), rr = r & 15, cc = c & 31, ob = rr * 64 + cc * 2; return st * 1024 + (ob ^ (((ob >> 9) & 1) << 5)); }
__host__ __device__ __forceinline__ void stage_rc(int b, int& R, int& C) { const int st = b / 1024, sb = b % 1024, swz = sb ^ (((sb >> 9) & 1) << 5); R = (st >> 1) * 16 + swz / 64; C = (st & 1) * 32 + (swz % 64) / 2; }
__host__ __device__ __forceinline__ int perm32(int rho) { const int n = rho >> 4, i = rho & 15; return 8 * (i >> 2) + 4 * n + (i & 3); }

struct Unit { int pm, pn; };
struct Gemm { const bf16_t* A; const bf16_t* Bt; int M, N, K; };

struct StaticOrder {
    int nM, nN, nwg, G, c;
    __host__ __device__ void init(int M, int N, int G_, int c_) { nM = M / BM; nN = N / BM; nwg = nM * nN; G = G_; c = c_; }
    __host__ __device__ bool next(int i, Unit& u) const {
        const long L = (long)i * G + c; if (L >= nwg) return false;
        int wgid = (int)L; { const int q = nwg / NXCD, r = nwg % NXCD, xcd = wgid % NXCD, off = wgid / NXCD; wgid = (xcd < r ? xcd * (q + 1) : r * (q + 1) + (xcd - r) * q) + off; }
        const int nig = WGM * nN, gid = wgid / nig, fm = gid * WGM, gsz = (nM - fm) < WGM ? (nM - fm) : WGM;
        u.pm = fm + ((wgid % nig) % gsz); u.pn = (wgid % nig) / gsz; return true;
    }
    __device__ __forceinline__ void a_ready(const Unit&) const {}
    __device__ __forceinline__ void done(const Unit&) const {}
};

typedef float f32x2 __attribute__((ext_vector_type(2)));
template <class Epi, class Sched, bool ALIGN_EPI = false, bool SP2 = false>
__device__ __forceinline__ void gemm_phase(PG8_LAS unsigned char* lds, const Gemm g, const Sched& S, const Epi& E) {
    int tid_o = threadIdx.x; asm volatile("" : "+v"(tid_o)); const int tid = tid_o, wid = __builtin_amdgcn_readfirstlane(tid >> 6), lane = tid & 63, wr = wid >> 2, wc = wid & 3, fr = lane & 15, fq = lane >> 4;
    const int K = g.K, nt = K / BK;
    unsigned voffA[2], voffB[2];
#pragma unroll
    for (int i = 0; i < 2; ++i) { int R, C; stage_rc(tid * 16 + i * 8192, R, C); const int Rb = Epi::PERM ? ((R & ~31) + perm32(R & 31)) : R;
        voffA[i] = (unsigned)(R * K + C) * 2u; voffB[i] = (unsigned)(Rb * K + C) * 2u; }
    const size_t kstep = (size_t)(BK * 2);
    const size_t hstep = (size_t)HALF * K * 2;
    const size_t tstep = 2 * hstep;
    const unsigned ldsw = (unsigned)wid * 1024u;
    const int aoff = lds_byte(wr * 64 + fr, fq * 8), boff = lds_byte(wc * 32 + fr, fq * 8);
#define PG8_SA(b, h) (((b) * 2 + (h)) * HTB)
#define PG8_SB(b, h) ((4 + (b) * 2 + (h)) * HTB)
#define PG8_STAGE(bufoff, gbase, voff) do { _Pragma("unroll") for (int _i = 0; _i < 2; ++_i) \
        __builtin_amdgcn_global_load_lds((const unsigned*)((const char*)(gbase) + (voff)[_i]), (PG8_LAS unsigned*)(lds + (bufoff) + ldsw + _i * 8192), 16, 0, 0); } while (0)
#define PG8_LDA(dst, b, h) do { _Pragma("unroll") for (int m = 0; m < 4; ++m) _Pragma("unroll") for (int k = 0; k < 2; ++k) dst[m][k] = *(const PG8_LAS bf16x8*)(lds + PG8_SA(b, h) + aoff + m * 2048 + k * 1024); } while (0)
#define PG8_LDB(dst, b, h) do { _Pragma("unroll") for (int n = 0; n < 2; ++n) _Pragma("unroll") for (int k = 0; k < 2; ++k) dst[n][k] = *(const PG8_LAS bf16x8*)(lds + PG8_SB(b, h) + boff + n * 2048 + k * 1024); } while (0)
#define PG8_MMA(ai, bj, At, Bt) do { __builtin_amdgcn_s_setprio(1); _Pragma("unroll") for (int m = 0; m < 4; ++m) _Pragma("unroll") for (int n = 0; n < 2; ++n) _Pragma("unroll") for (int k = 0; k < 2; ++k) \
        acc[ai][bj][m][n] = __builtin_amdgcn_mfma_f32_16x16x32_bf16(Bt[n][k], At[m][k], acc[ai][bj][m][n], 0, 0, 0); __builtin_amdgcn_s_setprio(0); } while (0)
#define PG8_WAIT_V(n) asm volatile("s_waitcnt vmcnt(" #n ")" ::: "memory")
#define PG8_WAIT_L(n) asm volatile("s_waitcnt lgkmcnt(" #n ")" ::: "memory")
#define PG8_BAR __builtin_amdgcn_s_barrier()
#define PG8_SCHED __builtin_amdgcn_sched_barrier(0)
    Unit cur, nxt; int ui = 0;
    if (!S.next(0, cur)) return;
    f32x4 acc[2][2][4][2];
#pragma unroll
    for (int a = 0; a < 2; ++a)
#pragma unroll
        for (int b = 0; b < 2; ++b)
#pragma unroll
            for (int m = 0; m < 4; ++m)
#pragma unroll
                for (int n = 0; n < 2; ++n) acc[a][b][m][n] = (f32x4){0.f, 0.f, 0.f, 0.f};
    bf16x8 At[4][2], B0[2][2], B1[2][2];
    const char* cA = (const char*)g.A + (size_t)cur.pm * tstep; const char* cB = (const char*)g.Bt + (size_t)cur.pn * tstep;
    S.a_ready(cur);
    if constexpr (SP2) {
        PG8_STAGE(PG8_SB(0, 0), cB, voffB); PG8_STAGE(PG8_SB(0, 1), cB + hstep, voffB); PG8_STAGE(PG8_SA(0, 0), cA, voffA); PG8_STAGE(PG8_SA(0, 1), cA + hstep, voffA);
        if (wr == 1) PG8_BAR;
        PG8_WAIT_V(2); PG8_BAR;
        PG8_STAGE(PG8_SB(1, 0), cB + kstep, voffB); PG8_STAGE(PG8_SA(1, 0), cA + kstep, voffA); PG8_STAGE(PG8_SB(1, 1), cB + hstep + kstep, voffB);
        PG8_WAIT_V(6); PG8_BAR;
    } else {
        PG8_STAGE(PG8_SB(0, 0), cB, voffB); PG8_STAGE(PG8_SA(0, 0), cA, voffA); PG8_STAGE(PG8_SB(0, 1), cB + hstep, voffB); PG8_STAGE(PG8_SA(0, 1), cA + hstep, voffA);
        if (wr == 1) PG8_BAR;
        PG8_WAIT_V(4); PG8_BAR;
        PG8_STAGE(PG8_SB(1, 0), cB + kstep, voffB); PG8_STAGE(PG8_SA(1, 0), cA + kstep, voffA); PG8_STAGE(PG8_SB(1, 1), cB + hstep + kstep, voffB);
        PG8_WAIT_V(6); PG8_BAR;
    }
    for (;;) {
        const bool has_next = S.next(ui + 1, nxt);
        const char* nA = has_next ? (const char*)g.A + (size_t)nxt.pm * tstep : cA; const char* nB = has_next ? (const char*)g.Bt + (size_t)nxt.pn * tstep : cB;
        for (int t = 0; t < nt; t += 2) {
            const bool last = (t == nt - 2);
            const char* a1 = cA + (size_t)(t + 1) * kstep;
            const char* a2 = last ? nA : cA + (size_t)(t + 2) * kstep; const char* b2 = last ? nB : cB + (size_t)(t + 2) * kstep;
            const char* a3 = a2 + kstep; const char* b3 = b2 + kstep;
            if (last && has_next) S.a_ready(nxt);
            if constexpr (SP2) {
            PG8_LDB(B0, 0, 0); PG8_LDB(B1, 0, 1); PG8_SCHED; PG8_LDA(At, 0, 0); PG8_STAGE(PG8_SA(1, 1), a1 + hstep, voffA);
            PG8_WAIT_V(8); PG8_WAIT_L(0); PG8_BAR; PG8_MMA(0, 0, At, B0); PG8_MMA(0, 1, At, B1); PG8_BAR; PG8_SCHED;
            PG8_LDA(At, 0, 1); PG8_STAGE(PG8_SB(0, 0), b2, voffB); PG8_STAGE(PG8_SB(0, 1), b2 + hstep, voffB); PG8_STAGE(PG8_SA(0, 0), a2, voffA);
            PG8_WAIT_V(8); PG8_WAIT_L(0); PG8_BAR; PG8_MMA(1, 0, At, B0); PG8_MMA(1, 1, At, B1); PG8_BAR; PG8_SCHED;
            PG8_LDB(B0, 1, 0); PG8_LDB(B1, 1, 1); PG8_SCHED; PG8_LDA(At, 1, 0); PG8_STAGE(PG8_SA(0, 1), a2 + hstep, voffA);
            PG8_WAIT_V(8); PG8_WAIT_L(0); PG8_BAR; PG8_MMA(0, 0, At, B0); PG8_MMA(0, 1, At, B1); PG8_BAR; PG8_SCHED;
            PG8_LDA(At, 1, 1); PG8_STAGE(PG8_SB(1, 0), b3, voffB); PG8_STAGE(PG8_SB(1, 1), b3 + hstep, voffB); PG8_STAGE(PG8_SA(1, 0), a3, voffA);
            PG8_WAIT_V(8); PG8_WAIT_L(0); PG8_BAR; PG8_MMA(1, 0, At, B0); PG8_MMA(1, 1, At, B1); PG8_BAR; PG8_SCHED;
            } else {
            PG8_LDB(B0, 0, 0); PG8_SCHED; PG8_LDA(At, 0, 0); PG8_STAGE(PG8_SA(1, 1), a1 + hstep, voffA);
            PG8_WAIT_L(8); PG8_BAR; PG8_WAIT_L(0); PG8_MMA(0, 0, At, B0); PG8_BAR; PG8_SCHED;
            PG8_LDB(B1, 0, 1); PG8_STAGE(PG8_SB(0, 0), b2, voffB);
            PG8_BAR; PG8_WAIT_L(0); PG8_MMA(0, 1, At, B1); PG8_BAR;
            PG8_LDA(At, 0, 1); PG8_STAGE(PG8_SA(0, 0), a2, voffA);
            PG8_BAR; PG8_WAIT_L(0); PG8_MMA(1, 0, At, B0); PG8_BAR; PG8_SCHED;
            PG8_STAGE(PG8_SB(0, 1), b2 + hstep, voffB);
            PG8_WAIT_V(6); PG8_BAR; PG8_MMA(1, 1, At, B1); PG8_BAR;
            PG8_LDB(B0, 1, 0); PG8_SCHED; PG8_LDA(At, 1, 0); PG8_STAGE(PG8_SA(0, 1), a2 + hstep, voffA);
            PG8_WAIT_L(8); PG8_BAR; PG8_WAIT_L(0); PG8_MMA(0, 0, At, B0); PG8_BAR; PG8_SCHED;
            PG8_LDB(B1, 1, 1); PG8_STAGE(PG8_SB(1, 0), b3, voffB);
            PG8_BAR; PG8_WAIT_L(0); PG8_MMA(0, 1, At, B1); PG8_BAR;
            PG8_LDA(At, 1, 1); PG8_STAGE(PG8_SA(1, 0), a3, voffA);
            PG8_BAR; PG8_WAIT_L(0); PG8_MMA(1, 0, At, B0); PG8_BAR; PG8_SCHED;
            PG8_STAGE(PG8_SB(1, 1), b3 + hstep, voffB);
            PG8_WAIT_V(6); PG8_BAR; PG8_MMA(1, 1, At, B1); PG8_BAR;
            }
        }
        if constexpr (ALIGN_EPI) { if (wr == 0) PG8_BAR; }
        if constexpr (!Epi::AFTER_DRAIN) { E(acc, cur, wr, wc, fr, fq); S.done(cur); }
        if (!has_next) break;
#pragma unroll
        for (int a = 0; a < 2; ++a)
#pragma unroll
            for (int b = 0; b < 2; ++b)
#pragma unroll
                for (int m = 0; m < 4; ++m)
#pragma unroll
                    for (int n = 0; n < 2; ++n) acc[a][b][m][n] = (f32x4){0.f, 0.f, 0.f, 0.f};
        cur = nxt; cA = nA; cB = nB; ++ui;
        if constexpr (ALIGN_EPI) { if (wr == 1) PG8_BAR; }
    }
    PG8_WAIT_V(0);
    if constexpr (!ALIGN_EPI) { if (wr == 0) PG8_BAR; }
    PG8_BAR;
    if constexpr (Epi::AFTER_DRAIN) { E.fused(acc, cur, wr, wc, fr, fq, lds, wid, lane); S.done(cur); }
#undef PG8_SA
#undef PG8_SB
#undef PG8_STAGE
#undef PG8_LDA
#undef PG8_LDB
#undef PG8_MMA
#undef PG8_WAIT_V
#undef PG8_WAIT_L
#undef PG8_BAR
#undef PG8_SCHED
}
}

using pg8::bf16_t; using pg8::bf16x8; using pg8::f32x4; using pg8::u32x4; using pg8::Unit;
#define LAS __attribute__((address_space(3)))
typedef unsigned u32x2 __attribute__((ext_vector_type(2)));
typedef short s16x4 __attribute__((ext_vector_type(4)));

constexpr float EPS = 1e-6f;
constexpr float LOG2E = 1.4426950408889634f;
constexpr int D = 1024, MP = 32768, MS = 512, MT = 33280, SEQ = 2048, DEC = 32, TKS = 2080, KVR = 66048, DFF = 2816;
constexpr size_t O_Y = 0;
constexpr size_t O_RSP = (size_t)MT * D;
constexpr size_t RS_ONE = (size_t)16 * 4 * 256 * 512;
constexpr size_t O_RSS = O_RSP + 2 * RS_ONE;
constexpr size_t O_LATP = O_RSS + 2 * RS_ONE;
constexpr size_t O_KRP = O_LATP + (size_t)MP * 256;
constexpr size_t O_LATS = O_KRP + (size_t)MP * 64;
constexpr size_t O_KRS = O_LATS + (size_t)MS * 256;
constexpr size_t O_FKP = O_KRS + (size_t)MS * 64;
constexpr size_t O_FVP = O_FKP + (size_t)MP * 1024;
constexpr size_t O_FLP = O_FVP + (size_t)MP * 1024;
constexpr size_t O_FKS = O_FLP + (size_t)MP * 16;
constexpr size_t O_FVS = O_FKS + (size_t)MS * 1024;
constexpr size_t O_FLS = O_FVS + (size_t)MS * 1024;
constexpr size_t O_END = O_FLS + (size_t)MS * 16;
constexpr size_t MiB = (size_t)1 << 20;
constexpr size_t WS_W = 0, WS_HBA = 140 * MiB, WS_SSQ = 206 * MiB, WS_CQSS = 211 * MiB, WS_ROPE = 213 * MiB, WS_ROPEM = 216 * MiB, WS_FP = 217 * MiB, WS_FS = 219 * MiB + 512 * 1024, WS_POOL = 222 * MiB;
constexpr size_t WS_HBB = WS_POOL + 400 * MiB;
constexpr size_t WS_BAR = 212 * MiB;
constexpr size_t WS_NEED = WS_POOL + 628 * MiB;
constexpr size_t PL_RPROJ = WS_POOL, PL_ROBUF = WS_POOL + 470 * MiB;
constexpr size_t PL_ACT = WS_POOL, PL_PB = WS_POOL + 180 * MiB, PL_PP = WS_POOL + 200 * MiB;
constexpr size_t PL_LATB = WS_POOL, PL_KRB = WS_POOL + 33 * MiB, PL_CQB = WS_POOL + 42 * MiB, PL_KVH = WS_POOL + 76 * MiB, PL_MO = WS_POOL + 470 * MiB;
constexpr size_t PL_FPROJ = WS_POOL, PL_FKALL = WS_POOL + 260 * MiB, PL_FVALL = WS_POOL + 325 * MiB, PL_FO = WS_POOL + 470 * MiB;
constexpr size_t W_RI = 0, SZ_RI = (size_t)6144 * 1024;
constexpr size_t W_RO = W_RI + 2 * SZ_RI, SZ_RO = (size_t)1024 * 2048;
constexpr size_t W_MI = W_RO + 2 * SZ_RO;
constexpr size_t W_QB = W_MI + (size_t)1024 * 1024;
constexpr size_t W_KVB = W_QB + (size_t)3072 * 512;
constexpr size_t W_MO = W_KVB + (size_t)4096 * 256;
constexpr size_t W_FI = W_MO + (size_t)1024 * 2048;
constexpr size_t W_FO = W_FI + (size_t)4352 * 1024;
constexpr size_t W_GU = W_FO + (size_t)1024 * 1024, SZ_GU = (size_t)5632 * 1024;
constexpr size_t W_DN = W_GU + 4 * SZ_GU, SZ_DN = (size_t)1024 * 2816;
constexpr size_t W_PG = W_DN + 4 * SZ_DN, SZ_PG = (size_t)1024 * 1024;
constexpr size_t W_PP = W_PG + 4 * SZ_PG, SZ_PP = (size_t)1024 * 256;
constexpr size_t W_END = W_PP + 4 * SZ_PP;
static_assert(W_END * 2 <= 140 * MiB, "weights region");
constexpr int LDS_BYTES = 163840;
constexpr int XR_OFF = 131072;

struct Params { const float* in[37]; float* out; unsigned char* ws; int ph_lo, ph_hi; };
typedef const __attribute__((address_space(4))) Params* KP;
__device__ __forceinline__ KP kp() { KP p = (KP)__builtin_amdgcn_kernarg_segment_ptr(); asm volatile("" : "+s"(p)); return p; }
#define PIN(k) (kp()->in[k])
#define POUT (kp()->out)
#define PWS (kp()->ws)

typedef float f32x2 __attribute__((ext_vector_type(2)));
typedef __bf16 bf16x2n __attribute__((ext_vector_type(2)));
__device__ __forceinline__ unsigned pk2(float lo, float hi) { const f32x2 v = {lo, hi}; return __builtin_bit_cast(unsigned, __builtin_convertvector(v, bf16x2n)); }
__device__ __forceinline__ unsigned f2bf(float f) { return pk2(f, 0.f) & 0xffffu; }
__device__ __forceinline__ float bf2f(unsigned short h) { return __builtin_bit_cast(float, (unsigned)h << 16); }
__device__ __forceinline__ float bflo(unsigned u) { return __builtin_bit_cast(float, u << 16); }
__device__ __forceinline__ float bfhi(unsigned u) { return __builtin_bit_cast(float, u & 0xffff0000u); }
__device__ __forceinline__ u32x2 pk4(f32x4 v) { u32x2 r; r.x = pk2(v[0], v[1]); r.y = pk2(v[2], v[3]); return r; }
__device__ __forceinline__ f32x4 up4(u32x2 w) { return (f32x4){bflo(w.x), bfhi(w.x), bflo(w.y), bfhi(w.y)}; }
__device__ __forceinline__ float wave_sum(float v) {
#pragma unroll
    for (int o = 1; o < 64; o <<= 1) v += __shfl_xor(v, o);
    return v;
}
__device__ __forceinline__ float fq_sum(float v) { v += __shfl_xor(v, 16); v += __shfl_xor(v, 32); return v; }
__device__ __forceinline__ float sigmoidf_(float x) { return __builtin_amdgcn_rcpf(1.f + __expf(-x)); }
__device__ __forceinline__ float dot4(f32x4 v) { return (v[0] * v[0] + v[1] * v[1]) + (v[2] * v[2] + v[3] * v[3]); }
__device__ __forceinline__ void lds_barrier() { asm volatile("s_waitcnt lgkmcnt(0)" ::: "memory"); __builtin_amdgcn_s_barrier(); asm volatile("" ::: "memory"); }
__device__ __forceinline__ int tok_pos(int r) { return r < MP ? (r & (SEQ - 1)) : SEQ + ((r - MP) & (DEC - 1)); }
__device__ __forceinline__ int kv_row(int r) { return r < MP ? r : MP + ((r - MP) >> 5) * TKS + SEQ + ((r - MP) & 31); }
__device__ __forceinline__ float row_rstd(const float* ssq, int row, float invdim) {
    const f32x4 v = *(const f32x4*)(ssq + (size_t)row * 4);
    return rsqrtf(((v[0] + v[1]) + (v[2] + v[3])) * invdim + EPS);
}
#define EROW(u, ai, wr, m, fr) ((u).pm * 256 + (ai) * 128 + (wr) * 64 + (m) * 16 + (fr))
#define LROW(ai, wr, m, fr) ((ai) * 128 + (wr) * 64 + (m) * 16 + (fr))
#define ECOL(bj, wc, n, fq) ((bj) * 128 + (wc) * 32 + (n) * 16 + (fq) * 4)
typedef const f32x4 (&AccRef)[2][2][4][2];
#define EFENCE asm volatile("" ::: "memory")
#define RSV(ai, m) row_rstd(ssq, EROW(u, ai, wr, m, fr), 1.f / 1024.f)

struct EpiRetIn {
    static constexpr bool PERM = false, AFTER_DRAIN = false;
    const float* ssq; bf16_t* proj; const float* rope;
    __device__ __forceinline__ void operator()(AccRef acc, const Unit& u, int wr, int wc, int fr, int fq) const {
        float rs8[2][4];
#pragma unroll
        for (int ai = 0; ai < 2; ++ai)
#pragma unroll
            for (int m = 0; m < 4; ++m) rs8[ai][m] = row_rstd(ssq, EROW(u, ai, wr, m, fr), 1.f / 1024.f);
        const int pn = u.pn;
#pragma unroll
        for (int ai = 0; ai < 2; ++ai)
#pragma unroll
            for (int m = 0; m < 4; ++m) {
                const int r = EROW(u, ai, wr, m, fr); const float rs = rs8[ai][m];
                bf16_t* orow = proj + (size_t)r * 6144 + pn * 256 + wc * 32 + fq * 4;
                if (pn < 8) {
                    const float* tb = rope + (size_t)tok_pos(r) * 256 + wc * 32 + fq * 4; const float sc = pn >= 4 ? 0.0625f : 1.f;
#pragma unroll
                    for (int n = 0; n < 2; ++n) { const f32x4 c = *(const f32x4*)(tb + n * 16), s = *(const f32x4*)(tb + 128 + n * 16);
                        const f32x4 x1 = acc[ai][0][m][n] * rs, x2 = acc[ai][1][m][n] * rs;
                        *(u32x2*)(orow + n * 16) = pk4((x1 * c - x2 * s) * sc); *(u32x2*)(orow + 128 + n * 16) = pk4((x2 * c + x1 * s) * sc); }
                } else {
#pragma unroll
                    for (int bj = 0; bj < 2; ++bj)
#pragma unroll
                        for (int n = 0; n < 2; ++n) { f32x4 v = acc[ai][bj][m][n] * rs;
                            if (pn >= 16) { v[0] *= sigmoidf_(v[0]); v[1] *= sigmoidf_(v[1]); v[2] *= sigmoidf_(v[2]); v[3] *= sigmoidf_(v[3]); }
                            *(u32x2*)(orow + bj * 128 + n * 16) = pk4(v); }
                }
            }
    }
};
struct EpiRes {
    static constexpr bool PERM = false, AFTER_DRAIN = false;
    const bf16_t* hin; bf16_t* hout; float* ssqw; LAS float* xr;
    __device__ __forceinline__ void operator()(AccRef acc, const Unit& u, int wr, int wc, int fr, int fq) const {
        LAS float* const xq = xr + (wr * 64 + fr) * 4; LAS float* const xw = xq + wc;
#pragma unroll
        for (int ai = 0; ai < 2; ++ai) {
            u32x2 hv[4][2][2];
#pragma unroll
            for (int m = 0; m < 4; ++m) { const size_t off = (size_t)EROW(u, ai, wr, m, fr) * D + u.pn * 256 + wc * 32 + fq * 4;
#pragma unroll
                for (int bj = 0; bj < 2; ++bj)
#pragma unroll
                    for (int n = 0; n < 2; ++n) hv[m][bj][n] = *(const u32x2*)(hin + off + bj * 128 + n * 16); }
#pragma unroll
            for (int m = 0; m < 4; ++m) {
                const int r = EROW(u, ai, wr, m, fr); const size_t off = (size_t)r * D + u.pn * 256 + wc * 32 + fq * 4; float ss = 0.f;
#pragma unroll
                for (int bj = 0; bj < 2; ++bj)
#pragma unroll
                    for (int n = 0; n < 2; ++n) { const size_t o = off + bj * 128 + n * 16; const f32x4 v = up4(hv[m][bj][n]) + acc[ai][bj][m][n];
                        const u32x2 pw = pk4(v); *(u32x2*)(hout + o) = pw; ss += dot4(up4(pw)); }
                ss = fq_sum(ss); if (fq == 0) xw[(ai * 128 + m * 16) * 4] = ss; EFENCE;
            }
        }
        lds_barrier();
        if (wc == 0 && fq == 0) {
#pragma unroll
            for (int ai = 0; ai < 2; ++ai)
#pragma unroll
                for (int m = 0; m < 4; ++m) { const f32x4 t = *(const LAS f32x4*)(xq + (ai * 128 + m * 16) * 4); ssqw[(size_t)EROW(u, ai, wr, m, fr) * 4 + u.pn] = (t[0] + t[1]) + (t[2] + t[3]); }
        }
    }
};
struct EpiGU {
    static constexpr bool PERM = false, AFTER_DRAIN = false;
    const float* ssq; bf16_t* act;
    __device__ __forceinline__ void operator()(AccRef acc, const Unit& u, int wr, int wc, int fr, int fq) const {
        float rs8[2][4];
#pragma unroll
        for (int ai = 0; ai < 2; ++ai)
#pragma unroll
            for (int m = 0; m < 4; ++m) rs8[ai][m] = row_rstd(ssq, EROW(u, ai, wr, m, fr), 1.f / 1024.f);
#pragma unroll
        for (int ai = 0; ai < 2; ++ai)
#pragma unroll
            for (int m = 0; m < 4; ++m) {
                const int r = EROW(u, ai, wr, m, fr); const float rs = rs8[ai][m];
                bf16_t* orow = act + (size_t)r * DFF + u.pn * 128 + wc * 32 + fq * 4;
#pragma unroll
                for (int n = 0; n < 2; ++n) { const f32x4 g = acc[ai][0][m][n] * rs, up = acc[ai][1][m][n] * rs; f32x4 v;
                    v[0] = g[0] * sigmoidf_(g[0]) * up[0]; v[1] = g[1] * sigmoidf_(g[1]) * up[1]; v[2] = g[2] * sigmoidf_(g[2]) * up[2]; v[3] = g[3] * sigmoidf_(g[3]) * up[3];
                    *(u32x2*)(orow + n * 16) = pk4(v); }
            }
    }
};
struct EpiPlain {
    static constexpr bool PERM = false, AFTER_DRAIN = false;
    bf16_t* out; int ldc; const float* ssq; float invdim;
    __device__ __forceinline__ void operator()(AccRef acc, const Unit& u, int wr, int wc, int fr, int fq) const {
#pragma unroll
        for (int ai = 0; ai < 2; ++ai)
#pragma unroll
            for (int m = 0; m < 4; ++m) {
                const int r = EROW(u, ai, wr, m, fr); const float rs = ssq ? row_rstd(ssq, r, invdim) : 1.f;
                bf16_t* orow = out + (size_t)r * ldc + u.pn * 256 + wc * 32 + fq * 4;
#pragma unroll
                for (int bj = 0; bj < 2; ++bj)
#pragma unroll
                    for (int n = 0; n < 2; ++n) *(u32x2*)(orow + bj * 128 + n * 16) = pk4(acc[ai][bj][m][n] * rs);
            }
    }
};
struct EpiPE {
    static constexpr bool PERM = false, AFTER_DRAIN = false;
    const bf16_t* hin; const bf16_t* pp; bf16_t* hout; const float* ssq; float* ssqw; LAS float* xr;
    __device__ __forceinline__ void operator()(AccRef acc, const Unit& u, int wr, int wc, int fr, int fq) const {
        float rs8[2][4];
#pragma unroll
        for (int ai = 0; ai < 2; ++ai)
#pragma unroll
            for (int m = 0; m < 4; ++m) rs8[ai][m] = row_rstd(ssq, EROW(u, ai, wr, m, fr), 1.f / 1024.f);
        LAS float* const xq = xr + (wr * 64 + fr) * 4; LAS float* const xw = xq + wc;
#pragma unroll
        for (int ai = 0; ai < 2; ++ai)
#pragma unroll
            for (int m = 0; m < 4; ++m) {
                const int r = EROW(u, ai, wr, m, fr); const float rs = rs8[ai][m];
                const size_t off = (size_t)r * D + u.pn * 256 + wc * 32 + fq * 4; float ss = 0.f;
#pragma unroll
                for (int bj = 0; bj < 2; ++bj)
#pragma unroll
                    for (int n = 0; n < 2; ++n) { const size_t o = off + bj * 128 + n * 16; const f32x4 a = acc[ai][bj][m][n] * rs; const u32x2 pw = *(const u32x2*)(pp + o);
                        f32x4 v = up4(*(const u32x2*)(hin + o));
                        v[0] += sigmoidf_(a[0]) * bflo(pw.x); v[1] += sigmoidf_(a[1]) * bfhi(pw.x); v[2] += sigmoidf_(a[2]) * bflo(pw.y); v[3] += sigmoidf_(a[3]) * bfhi(pw.y);
                        const u32x2 ow = pk4(v); *(u32x2*)(hout + o) = ow; ss += dot4(up4(ow)); }
                ss = fq_sum(ss); if (fq == 0) xw[(ai * 128 + m * 16) * 4] = ss;
            }
        lds_barrier();
        if (wc == 0 && fq == 0) {
#pragma unroll
            for (int ai = 0; ai < 2; ++ai)
#pragma unroll
                for (int m = 0; m < 4; ++m) { const f32x4 t = *(const LAS f32x4*)(xq + (ai * 128 + m * 16) * 4); ssqw[(size_t)EROW(u, ai, wr, m, fr) * 4 + u.pn] = (t[0] + t[1]) + (t[2] + t[3]); }
        }
    }
};
struct EpiMlaIn {
    static constexpr bool PERM = false, AFTER_DRAIN = false;
    const float* ssq; unsigned char* ws; float* out; const float* kvn; const float* gkr; LAS float* xr;
    __device__ __forceinline__ void operator()(AccRef acc, const Unit& u, int wr, int wc, int fr, int fq) const {
        LAS float* const xq = xr + (wr * 64 + fr) * 4; LAS float* const xw = xq + wc;
        const int pn = u.pn;
        bf16_t* const cqb = (bf16_t*)(ws + PL_CQB); float* const cqss = (float*)(ws + WS_CQSS); bf16_t* const latb = (bf16_t*)(ws + PL_LATB); bf16_t* const krb = (bf16_t*)(ws + PL_KRB); const float* const ropem = (const float*)(ws + WS_ROPEM);
        if (pn < 2) {
#pragma unroll
            for (int ai = 0; ai < 2; ++ai)
#pragma unroll
                for (int m = 0; m < 4; ++m) { const int r = EROW(u, ai, wr, m, fr); bf16_t* orow = cqb + (size_t)r * 512 + pn * 256 + wc * 32 + fq * 4; float ss = 0.f;
#pragma unroll
                    for (int bj = 0; bj < 2; ++bj)
#pragma unroll
                        for (int n = 0; n < 2; ++n) { const f32x4 v = acc[ai][bj][m][n] * RSV(ai, m); ss += dot4(v); *(u32x2*)(orow + bj * 128 + n * 16) = pk4(v); }
                    ss = fq_sum(ss); if (fq == 0) xw[(ai * 128 + m * 16) * 4] = ss; EFENCE; }
            lds_barrier();
            if (wc == 0 && fq == 0) {
#pragma unroll
                for (int ai = 0; ai < 2; ++ai)
#pragma unroll
                    for (int m = 0; m < 4; ++m) { const f32x4 t = *(const LAS f32x4*)(xq + (ai * 128 + m * 16) * 4); float* cp = cqss + (size_t)EROW(u, ai, wr, m, fr) * 4; cp[pn] = (t[0] + t[1]) + (t[2] + t[3]); cp[2 + pn] = 0.f; }
            }
        } else if (pn == 2) {
#pragma unroll
            for (int ai = 0; ai < 2; ++ai)
#pragma unroll
                for (int m = 0; m < 4; ++m) { float ss = 0.f;
#pragma unroll
                    for (int bj = 0; bj < 2; ++bj)
#pragma unroll
                        for (int n = 0; n < 2; ++n) ss += dot4(acc[ai][bj][m][n] * RSV(ai, m));
                    ss = fq_sum(ss); if (fq == 0) xw[(ai * 128 + m * 16) * 4] = ss; EFENCE; }
            lds_barrier();
#pragma unroll
            for (int ai = 0; ai < 2; ++ai)
#pragma unroll
                for (int m = 0; m < 4; ++m) { const int r = EROW(u, ai, wr, m, fr); const f32x4 t = *(const LAS f32x4*)(xq + (ai * 128 + m * 16) * 4);
                    const float rk = rsqrtf(((t[0] + t[1]) + (t[2] + t[3])) * (1.f / 256.f) + EPS) * RSV(ai, m);
                    float* o32 = (r < MP ? out + O_LATP + (size_t)r * 256 : out + O_LATS + (size_t)(r - MP) * 256) + wc * 32 + fq * 4;
                    bf16_t* o16 = latb + (size_t)kv_row(r) * 256 + wc * 32 + fq * 4;
#pragma unroll
                    for (int bj = 0; bj < 2; ++bj)
#pragma unroll
                        for (int n = 0; n < 2; ++n) { const f32x4 g = *(const f32x4*)(kvn + ECOL(bj, wc, n, fq)); const f32x4 v = acc[ai][bj][m][n] * rk * g;
                            *(f32x4*)(o32 + bj * 128 + n * 16) = v; *(u32x2*)(o16 + bj * 128 + n * 16) = pk4(v); } EFENCE; }
        } else if (wc == 0) {
#pragma unroll
            for (int ai = 0; ai < 2; ++ai)
#pragma unroll
                for (int m = 0; m < 4; ++m) { const int r = EROW(u, ai, wr, m, fr); float ss = 0.f;
#pragma unroll
                    for (int n = 0; n < 2; ++n) ss += dot4(acc[ai][0][m][n] * RSV(ai, m)) + dot4(acc[ai][1][m][n] * RSV(ai, m));
                    ss = fq_sum(ss); const float rk = rsqrtf(ss * (1.f / 64.f) + EPS) * RSV(ai, m);
                    const float* tb = ropem + (size_t)tok_pos(r) * 64 + fq * 4;
                    float* o32 = (r < MP ? out + O_KRP + (size_t)r * 64 : out + O_KRS + (size_t)(r - MP) * 64) + fq * 4;
                    bf16_t* o16 = krb + (size_t)kv_row(r) * 64 + fq * 4;
#pragma unroll
                    for (int n = 0; n < 2; ++n) { const f32x4 g1 = *(const f32x4*)(gkr + n * 16 + fq * 4), g2 = *(const f32x4*)(gkr + 32 + n * 16 + fq * 4);
                        const f32x4 c = *(const f32x4*)(tb + n * 16), s = *(const f32x4*)(tb + 32 + n * 16);
                        const f32x4 y1 = acc[ai][0][m][n] * rk * g1, y2 = acc[ai][1][m][n] * rk * g2; const f32x4 z1 = y1 * c - y2 * s, z2 = y2 * c + y1 * s;
                        *(f32x4*)(o32 + n * 16) = z1; *(f32x4*)(o32 + 32 + n * 16) = z2; *(u32x2*)(o16 + n * 16) = pk4(z1); *(u32x2*)(o16 + 32 + n * 16) = pk4(z2); } EFENCE; }
        }
    }
};
struct EpiKV {
    static constexpr bool PERM = false, AFTER_DRAIN = false;
    bf16_t* kvh; LAS float* xr;
    __device__ __forceinline__ void operator()(AccRef acc, const Unit& u, int wr, int wc, int fr, int fq) const {
        LAS float* const xq = xr + (wr * 64 + fr) * 4; LAS float* const xw = xq + wc;
#pragma unroll
        for (int ai = 0; ai < 2; ++ai)
#pragma unroll
            for (int m = 0; m < 4; ++m) { float ss = dot4(acc[ai][0][m][0]) + dot4(acc[ai][0][m][1]); ss = fq_sum(ss); if (fq == 0) xw[(ai * 128 + m * 16) * 4] = ss; EFENCE; }
        lds_barrier();
#pragma unroll
        for (int ai = 0; ai < 2; ++ai)
#pragma unroll
            for (int m = 0; m < 4; ++m) { const int r = EROW(u, ai, wr, m, fr); const f32x4 t = *(const LAS f32x4*)(xq + (ai * 128 + m * 16) * 4);
                const float rk = rsqrtf(((t[0] + t[1]) + (t[2] + t[3])) * (1.f / 128.f) + EPS);
                bf16_t* orow = kvh + (size_t)r * 2048 + u.pn * 256 + wc * 32 + fq * 4;
#pragma unroll
                for (int n = 0; n < 2; ++n) { *(u32x2*)(orow + n * 16) = pk4(acc[ai][0][m][n] * rk); *(u32x2*)(orow + 128 + n * 16) = pk4(acc[ai][1][m][n]); } }
    }
};
struct EpiFoxIn {
    static constexpr bool PERM = false, AFTER_DRAIN = false;
    const float* ssq; unsigned char* ws; float* out; const float* gq; const float* gk; const float* bf; LAS float* xr;
    __device__ __forceinline__ void operator()(AccRef acc, const Unit& u, int wr, int wc, int fr, int fq) const {
        LAS float* const xq = xr + (wr * 64 + fr) * 4; LAS float* const xw = xq + wc;
        const int pn = u.pn;
        bf16_t* const proj = (bf16_t*)(ws + PL_FPROJ); bf16_t* const kall = (bf16_t*)(ws + PL_FKALL); bf16_t* const vall = (bf16_t*)(ws + PL_FVALL);
        if (pn < 8) {
#pragma unroll
            for (int ai = 0; ai < 2; ++ai)
#pragma unroll
                for (int m = 0; m < 4; ++m)
#pragma unroll
                    for (int bj = 0; bj < 2; ++bj) { float ss = dot4(acc[ai][bj][m][0] * RSV(ai, m)) + dot4(acc[ai][bj][m][1] * RSV(ai, m)); ss = fq_sum(ss);
                        if (fq == 0) xw[bj * 1024 + (ai * 128 + m * 16) * 4] = ss; EFENCE; }
            lds_barrier();
            const float* gg = pn < 4 ? gq : gk;
#pragma unroll
            for (int ai = 0; ai < 2; ++ai)
#pragma unroll
                for (int m = 0; m < 4; ++m) { const int r = EROW(u, ai, wr, m, fr);
#pragma unroll
                    for (int bj = 0; bj < 2; ++bj) { const f32x4 t = *(const LAS f32x4*)(xq + bj * 1024 + (ai * 128 + m * 16) * 4);
                        const float hs = wc < 2 ? t[0] + t[1] : t[2] + t[3]; const float rk = rsqrtf(hs * (1.f / 64.f) + EPS) * RSV(ai, m);
#pragma unroll
                        for (int n = 0; n < 2; ++n) { const f32x4 g = *(const f32x4*)(gg + (wc & 1) * 32 + n * 16 + fq * 4); const f32x4 v = acc[ai][bj][m][n] * rk * g;
                            const int ct = pn * 256 + ECOL(bj, wc, n, fq);
                            if (pn < 4) *(u32x2*)(proj + (size_t)r * 4096 + ct) = pk4(v);
                            else { const int ck = ct - 1024;
                                if (r < MP) { *(f32x4*)(out + O_FKP + (size_t)r * 1024 + ck) = v; *(u32x2*)(proj + (size_t)r * 4096 + ct) = pk4(v); }
                                else { const int rsm = r - MP; *(f32x4*)(out + O_FKS + (size_t)rsm * 1024 + ck) = v; *(u32x2*)(kall + ((size_t)(rsm >> 5) * TKS + SEQ + (rsm & 31)) * 1024 + ck) = pk4(v); } } } EFENCE; } }
        } else if (pn < 16) {
#pragma unroll
            for (int ai = 0; ai < 2; ++ai)
#pragma unroll
                for (int m = 0; m < 4; ++m) { const int r = EROW(u, ai, wr, m, fr);
#pragma unroll
                    for (int bj = 0; bj < 2; ++bj)
#pragma unroll
                        for (int n = 0; n < 2; ++n) { f32x4 v = acc[ai][bj][m][n] * RSV(ai, m); const int ct = pn * 256 + ECOL(bj, wc, n, fq);
                            if (pn < 12) { const int cv = ct - 2048;
                                if (r < MP) { *(f32x4*)(out + O_FVP + (size_t)r * 1024 + cv) = v; *(u32x2*)(proj + (size_t)r * 4096 + ct) = pk4(v); }
                                else { const int rsm = r - MP; *(f32x4*)(out + O_FVS + (size_t)rsm * 1024 + cv) = v; *(u32x2*)(vall + ((size_t)(rsm >> 5) * TKS + SEQ + (rsm & 31)) * 1024 + cv) = pk4(v); } }
                            else { v[0] = sigmoidf_(v[0]); v[1] = sigmoidf_(v[1]); v[2] = sigmoidf_(v[2]); v[3] = sigmoidf_(v[3]); *(u32x2*)(proj + (size_t)r * 4096 + ct) = pk4(v); } } EFENCE; }
        } else if (wc == 0) {
            const f32x4 b = *(const f32x4*)(bf + fq * 4);
#pragma unroll
            for (int ai = 0; ai < 2; ++ai)
#pragma unroll
                for (int m = 0; m < 4; ++m) { const int r = EROW(u, ai, wr, m, fr); const f32x4 x = acc[ai][0][m][0] * RSV(ai, m) + b; f32x4 v;
#pragma unroll
                    for (int e = 0; e < 4; ++e) v[e] = fminf(x[e], 0.f) - log1pf(__expf(-fabsf(x[e])));
                    float* o = (r < MP ? out + O_FLP + (size_t)r * 16 : out + O_FLS + (size_t)(r - MP) * 16) + fq * 4; *(f32x4*)o = v; }
        }
    }
};

struct WJob { const float* src; const float* src2; const float* gain; bf16_t* dst; int K, Nsrc, Ndst, map; };
__device__ __forceinline__ WJob get_job(int j) {
    bf16_t* W = (bf16_t*)(PWS + WS_W); WJob J; J.src2 = nullptr; J.gain = nullptr; J.map = 0;
    if (j < 2)       { J.src = PIN(14) + (size_t)j * 1024 * 6144; J.gain = PIN(10) + (size_t)(3 * j) * 1024; J.K = 1024; J.Nsrc = 6144; J.Ndst = 6144; J.dst = W + W_RI + j * SZ_RI; }
    else if (j < 4)  { const int i = j - 2; J.src = PIN(16) + (size_t)i * 2048 * 1024; J.K = 2048; J.Nsrc = 1024; J.Ndst = 1024; J.dst = W + W_RO + i * SZ_RO; }
    else if (j == 4) { J.src = PIN(17); J.gain = PIN(10) + 1024; J.K = 1024; J.Nsrc = 832; J.Ndst = 1024; J.map = 1; J.dst = W + W_MI; }
    else if (j == 5) { J.src = PIN(20); J.gain = PIN(18); J.K = 512; J.Nsrc = 3072; J.Ndst = 3072; J.dst = W + W_QB; }
    else if (j == 6) { J.src = PIN(21); J.K = 256; J.Nsrc = 4096; J.Ndst = 4096; J.dst = W + W_KVB; }
    else if (j == 7) { J.src = PIN(26); J.K = 2048; J.Nsrc = 1024; J.Ndst = 1024; J.dst = W + W_MO; }
    else if (j == 8) { J.src = PIN(27); J.gain = PIN(10) + 2048; J.K = 1024; J.Nsrc = 4112; J.Ndst = 4352; J.dst = W + W_FI; }
    else if (j == 9) { J.src = PIN(31); J.K = 1024; J.Nsrc = 1024; J.Ndst = 1024; J.dst = W + W_FO; }
    else if (j < 14) { const int i = j - 10; J.src = PIN(32) + (size_t)i * 1024 * DFF; J.src2 = PIN(33) + (size_t)i * 1024 * DFF; J.gain = PIN(11) + (size_t)i * 1024; J.K = 1024; J.Nsrc = DFF; J.Ndst = 5632; J.map = 2; J.dst = W + W_GU + i * SZ_GU; }
    else if (j < 18) { const int i = j - 14; J.src = PIN(34) + (size_t)i * DFF * 1024; J.K = DFF; J.Nsrc = 1024; J.Ndst = 1024; J.dst = W + W_DN + i * SZ_DN; }
    else if (j < 22) { const int i = j - 18; J.src = PIN(36) + (size_t)i * 1024 * 1024; J.gain = PIN(12) + (size_t)i * 1024; J.K = 1024; J.Nsrc = 1024; J.Ndst = 1024; J.dst = W + W_PG + i * SZ_PG; }
    else             { const int i = j - 22; J.src = PIN(35) + (size_t)i * 256 * 1024; J.K = 256; J.Nsrc = 1024; J.Ndst = 1024; J.dst = W + W_PP + i * SZ_PP; }
    return J;
}
__device__ __forceinline__ void wt_item2(const WJob& J, LAS float* scr, int itemA, int itemB, bool hasB, int lane) {
    const int nblk = J.Ndst / 32; int k0[2], n0[2]; const float* sp[2]; int col[2];
#pragma unroll
    for (int q = 0; q < 2; ++q) { const int item = q ? (hasB ? itemB : itemA) : itemA; const int kb = item / nblk, nb = item % nblk; k0[q] = 64 * kb; n0[q] = 32 * nb;
        const int n = n0[q] + (lane & 31); sp[q] = nullptr; col[q] = 0;
        if (J.map == 0) { if (n < J.Nsrc) { sp[q] = J.src; col[q] = n; } }
        else if (J.map == 1) { if (n < 768) { sp[q] = J.src; col[q] = n; } else { const int c = n - 768; if (c < 32) { sp[q] = J.src; col[q] = 768 + c; } else if (c >= 128 && c < 160) { sp[q] = J.src; col[q] = 800 + (c - 128); } } }
        else { const int pn = n >> 8, c = n & 255; if (c < 128) { sp[q] = J.src; col[q] = pn * 128 + c; } else { sp[q] = J.src2; col[q] = pn * 128 + c - 128; } } }
    float v[2][32];
#pragma unroll
    for (int q = 0; q < 2; ++q)
#pragma unroll
        for (int i = 0; i < 32; ++i) { const int kk = 2 * i + (lane >> 5); float x = sp[q] ? sp[q][(size_t)(k0[q] + kk) * J.Nsrc + col[q]] : 0.f; if (J.gain) x *= J.gain[k0[q] + kk]; v[q][i] = x; }
#pragma unroll
    for (int q = 0; q < 2; ++q)
#pragma unroll
        for (int i = 0; i < 32; ++i) { const int kk = 2 * i + (lane >> 5); scr[q * 2112 + kk * 33 + (lane & 31)] = v[q][i]; }
    asm volatile("s_waitcnt lgkmcnt(0)" ::: "memory");
    const int c = lane & 7;
#pragma unroll
    for (int q = 0; q < 2; ++q) { if (q == 0 || hasB) {
#pragma unroll
        for (int j = 0; j < 4; ++j) { const int nn = (lane >> 3) + 8 * j; const LAS float* s = scr + q * 2112 + (8 * c) * 33 + nn;
            u32x4 o; o.x = pk2(s[0 * 33], s[1 * 33]); o.y = pk2(s[2 * 33], s[3 * 33]); o.z = pk2(s[4 * 33], s[5 * 33]); o.w = pk2(s[6 * 33], s[7 * 33]);
            *(u32x4*)(J.dst + (size_t)(n0[q] + nn) * J.K + k0[q] + 8 * c) = o; } } }
    asm volatile("s_waitcnt lgkmcnt(0)" ::: "memory");
}
__device__ __forceinline__ void phase_prologue(LAS unsigned char* lds) {
    int tid_o = threadIdx.x; asm volatile("" : "+v"(tid_o)); const int tid = tid_o, lane = tid & 63, wave = __builtin_amdgcn_readfirstlane(tid >> 6);
    const int gw = blockIdx.x * 8 + wave, NGW = gridDim.x * 8;
    LAS float* scr = (LAS float*)(lds + wave * 17408);
    int base = 0;
    for (int j = 0; j < 26; ++j) { const WJob J = get_job(j); const int cnt = (J.K / 64) * (J.Ndst / 32);
        int first = (gw - base) % NGW; if (first < 0) first += NGW;
        for (int it = first; it < cnt; it += 2 * NGW) wt_item2(J, scr, it, it + NGW, it + NGW < cnt, lane);
        base += cnt; }
    { float* tr = (float*)(PWS + WS_ROPE); float* tm = (float*)(PWS + WS_ROPEM); const int gt = blockIdx.x * 512 + tid, NT = gridDim.x * 512;
        for (int i = gt; i < TKS * 128 + TKS * 32; i += NT) {
            int pos, j, half; if (i < TKS * 128) { pos = i >> 7; j = i & 127; half = 128; } else { const int k = i - TKS * 128; pos = k >> 5; j = k & 31; half = 32; }
            const float inv = exp2f(-(float)j / (float)half * 13.287712379549449f);
            const float ang = (float)pos * inv; double rev = (double)ang * 0.15915494309189535; rev -= floor(rev); const float rf = (float)rev;
            const float c = __builtin_amdgcn_cosf(rf), s = __builtin_amdgcn_sinf(rf);
            if (half == 128) { tr[(size_t)pos * 256 + j] = c; tr[(size_t)pos * 256 + 128 + j] = s; } else { tm[(size_t)pos * 64 + j] = c; tm[(size_t)pos * 64 + 32 + j] = s; } } }
    { bf16_t* hb = (bf16_t*)(PWS + WS_HBB); float* ssq = (float*)(PWS + WS_SSQ);
        for (int r = gw; r < MT; r += NGW) { const float* x = r < MP ? PIN(0) + (size_t)r * D : PIN(1) + (size_t)(r - MP) * D; float s = 0.f;
#pragma unroll
            for (int j = 0; j < 4; ++j) { const f32x4 v = *(const f32x4*)(x + (lane + 64 * j) * 4); const u32x2 pw = pk4(v); *(u32x2*)(hb + (size_t)r * D + (lane + 64 * j) * 4) = pw; s += dot4(up4(pw)); }
            s = wave_sum(s); if (lane < 4) ssq[(size_t)r * 4 + lane] = lane == 0 ? s : 0.f; } }
}
__device__ __forceinline__ void cvt_chunks(const float* __restrict__ src, bf16_t* __restrict__ dst, size_t n8) {
    int tid_o = threadIdx.x; asm volatile("" : "+v"(tid_o)); const size_t gt = (size_t)blockIdx.x * 512 + tid_o, NT = (size_t)gridDim.x * 512;

    for (size_t i = gt; i < n8; i += NT) { const f32x4 a = *(const f32x4*)(src + i * 8), b = *(const f32x4*)(src + i * 8 + 4); u32x4 o; o.x = pk2(a[0], a[1]); o.y = pk2(a[2], a[3]); o.z = pk2(b[0], b[1]); o.w = pk2(b[2], b[3]); *(u32x4*)(dst + i * 8) = o; }
}
template <int width> __device__ __forceinline__ void cvt_cache(const float* __restrict__ src, bf16_t* __restrict__ dst) {
    constexpr int cpr = width / 8; const size_t n8 = (size_t)16 * 2048 * cpr;
    int tid_o = threadIdx.x; asm volatile("" : "+v"(tid_o)); const size_t gt = (size_t)blockIdx.x * 512 + tid_o, NT = (size_t)gridDim.x * 512;

    for (size_t i = gt; i < n8; i += NT) { const size_t row = i / cpr; const int ch = (int)(i % cpr); const size_t b = row >> 11, t = row & 2047;
        const float* s = src + row * width + ch * 8; const f32x4 a = *(const f32x4*)s, c = *(const f32x4*)(s + 4); u32x4 o; o.x = pk2(a[0], a[1]); o.y = pk2(a[2], a[3]); o.z = pk2(c[0], c[1]); o.w = pk2(c[2], c[3]);
        *(u32x4*)(dst + (b * TKS + t) * width + ch * 8) = o; }
}

struct AU { const bf16_t* Q; int qs; const bf16_t* K1; int k1s; const bf16_t* K2; int k2s; const bf16_t* V; int vs; bf16_t* O; int os; const bf16_t* G; int gs; const float* Fk;
            int q0, nq, off, Tk; };
struct MlaQ { const float* gqn; const float* gkn; const float* gqr; const float* ropem; };
template <int DK, int DV, int MODE>
__device__ __forceinline__ void attn_unit(LAS unsigned char* lds, const AU& a, const MlaQ& mq) {
    constexpr int KS = (DK + 8) * 2, VS = (DV + 16) * 2  , NS = DK / 32, NDB = DV / 16, KC = DK / 8, VC = DV / 8, KCH = 64 * KC / 512, VCH = 64 * VC / 512;
    constexpr int VOFF = 64 * KS, FOFF = VOFF + 64 * VS;
    int tid_o = threadIdx.x; asm volatile("" : "+v"(tid_o)); const int tid = tid_o, w = __builtin_amdgcn_readfirstlane(tid >> 6), lane = tid & 63, li = lane & 15, g = lane >> 4;
    const float cs = (MODE == 0 ? 0.07216878364870322f : 0.125f) * LOG2E;
    const bool active = 32 * w < a.nq;
    const int wq0 = a.q0 + 32 * w, rmax = a.q0 + a.nq - 1;
    bf16x8 qf[2][NS];
#pragma unroll
    for (int blk = 0; blk < 2; ++blk) { int row = wq0 + 16 * blk + li; row = row < rmax ? row : rmax; const bf16_t* qp = a.Q + (size_t)row * a.qs + 8 * g;
#pragma unroll
        for (int s = 0; s < NS; ++s) qf[blk][s] = *(const bf16x8*)(qp + 32 * s);
        if (MODE == 0) {
            float x[NS][8];
#pragma unroll
            for (int s = 0; s < NS; ++s)
#pragma unroll
                for (int j = 0; j < 8; ++j) x[s][j] = bf2f((unsigned short)qf[blk][s][j]);
            float ss = 0.f;
#pragma unroll
            for (int s = 0; s < 4; ++s)
#pragma unroll
                for (int j = 0; j < 8; ++j) ss += x[s][j] * x[s][j];
            ss = fq_sum(ss); const float rn = rsqrtf(ss * (1.f / 128.f) + EPS);
#pragma unroll
            for (int s = 0; s < 4; ++s)
{ const f32x4 ga = *(const f32x4*)(mq.gqn + 32 * s + 8 * g), gb = *(const f32x4*)(mq.gqn + 32 * s + 8 * g + 4), ha = *(const f32x4*)(mq.gkn + 32 * s + 8 * g), hb_ = *(const f32x4*)(mq.gkn + 32 * s + 8 * g + 4);
#pragma unroll
                  for (int j = 0; j < 4; ++j) { x[s][j] *= rn * ga[j] * ha[j]; x[s][4 + j] *= rn * gb[j] * hb_[j]; } }
            float sr = 0.f;
#pragma unroll
            for (int j = 0; j < 8; ++j) sr += x[4][j] * x[4][j] + x[5][j] * x[5][j];
            sr = fq_sum(sr); const float rr = rsqrtf(sr * (1.f / 64.f) + EPS);
            const float* tb = mq.ropem + (size_t)(a.off + row) * 64;
#pragma unroll
            for (int j = 0; j < 8; ++j) { const int dj = 8 * g + j; const float y1 = x[4][j] * rr * mq.gqr[dj], y2 = x[5][j] * rr * mq.gqr[32 + dj]; const float c = tb[dj], s = tb[32 + dj];
                x[4][j] = y1 * c - y2 * s; x[5][j] = y2 * c + y1 * s; }
#pragma unroll
            for (int s = 0; s < NS; ++s)
#pragma unroll
                for (int j = 0; j < 8; ++j) qf[blk][s][j] = (short)f2bf(x[s][j]);
        }
    }
    constexpr int QOFF = ((FOFF + 256 + 15) / 16) * 16;
    LAS unsigned char* qlds = lds + QOFF + w * (2 * NS * 1024) + lane * 16;
    if (MODE == 0) {
#pragma unroll
        for (int blk = 0; blk < 2; ++blk)
#pragma unroll
            for (int s = 0; s < NS; ++s) *(LAS bf16x8*)(qlds + (blk * NS + s) * 1024) = qf[blk][s];
    }
    const int last_pos = a.off + a.q0 + a.nq - 1;
    const int kend = MODE == 0 ? (((last_pos >> 6) + 1) * 64 < a.Tk ? ((last_pos >> 6) + 1) * 64 : a.Tk) : last_pos + 1;
    const int nt = (kend + 63) >> 6;
    f32x4 o[2][NDB]; float mrow[2], lrow[2];
#pragma unroll
    for (int blk = 0; blk < 2; ++blk) { mrow[blk] = -INFINITY; lrow[blk] = 0.f;
#pragma unroll
        for (int db = 0; db < NDB; ++db) o[blk][db] = (f32x4){0.f, 0.f, 0.f, 0.f}; }
    u32x4 kreg[2][KCH], vreg[2][VCH]; float freg[2] = {0.f, 0.f};
#define ATT_PREFETCH(t, P_) do { \
        _Pragma("unroll") for (int c_ = 0; c_ < KCH; ++c_) { const int id = tid + 512 * c_, key = id / KC, ch = id % KC; int kr_ = 64 * (t) + key; kr_ = kr_ < a.Tk ? kr_ : a.Tk - 1; \
            const bf16_t* p_ = (MODE == 0 && ch >= 16) ? a.K2 + (size_t)kr_ * a.k2s + (ch - 16) * 8 : a.K1 + (size_t)kr_ * a.k1s + ch * 8; kreg[P_][c_] = *(const u32x4*)p_; } \
        _Pragma("unroll") for (int c_ = 0; c_ < VCH; ++c_) { const int id = tid + 512 * c_, key = id / VC, ch = id % VC; int kr_ = 64 * (t) + key; kr_ = kr_ < a.Tk ? kr_ : a.Tk - 1; \
            vreg[P_][c_] = *(const u32x4*)(a.V + (size_t)kr_ * a.vs + ch * 8); } \
        if (MODE == 1) { int kr_ = 64 * (t) + (tid & 63); kr_ = kr_ < a.Tk ? kr_ : a.Tk - 1; freg[P_] = a.Fk[kr_]; } } while (0)
    ATT_PREFETCH(0, 0); if (nt > 1) ATT_PREFETCH(1, 1);
    const int wlo = a.off + wq0, whi = wlo + 31;
    for (int t0 = 0; t0 < nt; t0 += 2) {
#pragma unroll
      for (int P = 0; P < 2; ++P) { const int t = t0 + P; if (t < nt) {
        lds_barrier();
#pragma unroll
        for (int c_ = 0; c_ < KCH; ++c_) { const int id = tid + 512 * c_, key = id / KC, ch = id % KC; *(LAS u32x4*)(lds + key * KS + ch * 16) = kreg[P][c_]; }
#pragma unroll
        for (int c_ = 0; c_ < VCH; ++c_) { const int id = tid + 512 * c_, key = id / VC, ch = id % VC; *(LAS u32x4*)(lds + VOFF + key * VS + ch * 16) = vreg[P][c_]; }
        if (MODE == 1 && tid < 64) *(LAS float*)(lds + FOFF + tid * 4) = freg[P];
        lds_barrier();
        if (t + 2 < nt) ATT_PREFETCH(t + 2, P);
        const bool skip = !active || (MODE == 0 ? (t > (whi >> 6)) : (64 * t > whi));
        if (!skip) {
            const bool needmask = __builtin_amdgcn_readfirstlane((int)((MODE == 1 && 64 * t + 63 > wlo) || (64 * t + 63 >= a.Tk))) != 0;
            f32x4 sa[2][4];
#pragma unroll
            for (int blk = 0; blk < 2; ++blk)
#pragma unroll
                for (int kb = 0; kb < 4; ++kb) sa[blk][kb] = (f32x4){0.f, 0.f, 0.f, 0.f};
            if (MODE == 0) {
#pragma unroll
                for (int s = 0; s < NS; ++s) { const bf16x8 q0 = *(const LAS bf16x8*)(qlds + s * 1024), q1 = *(const LAS bf16x8*)(qlds + (NS + s) * 1024);
#pragma unroll
                    for (int kb = 0; kb < 4; ++kb) { const bf16x8 kf = *(const LAS bf16x8*)(lds + (16 * kb + li) * KS + (32 * s + 8 * g) * 2);
                        sa[0][kb] = __builtin_amdgcn_mfma_f32_16x16x32_bf16(kf, q0, sa[0][kb], 0, 0, 0);
                        sa[1][kb] = __builtin_amdgcn_mfma_f32_16x16x32_bf16(kf, q1, sa[1][kb], 0, 0, 0); }
                    }
            } else {
#pragma unroll
                for (int kb = 0; kb < 4; ++kb)
#pragma unroll
                    for (int s = 0; s < NS; ++s) { const bf16x8 kf = *(const LAS bf16x8*)(lds + (16 * kb + li) * KS + (32 * s + 8 * g) * 2);
                        sa[0][kb] = __builtin_amdgcn_mfma_f32_16x16x32_bf16(kf, qf[0][s], sa[0][kb], 0, 0, 0);
                        sa[1][kb] = __builtin_amdgcn_mfma_f32_16x16x32_bf16(kf, qf[1][s], sa[1][kb], 0, 0, 0); }
            }
            bf16x8 pf[2][2];
#pragma unroll
            for (int kb = 0; kb < 4; ++kb) { f32x4 fk = (f32x4){0.f, 0.f, 0.f, 0.f}; if (MODE == 1) fk = *(const LAS f32x4*)(lds + FOFF + (16 * kb + 4 * g) * 4);
                sa[0][kb] = sa[0][kb] * cs - fk; sa[1][kb] = sa[1][kb] * cs - fk; }
            if (needmask) {
#pragma unroll
                for (int blk = 0; blk < 2; ++blk) { const int pos = wlo + 16 * blk + li;
#pragma unroll
                    for (int kb = 0; kb < 4; ++kb)
#pragma unroll
                        for (int i = 0; i < 4; ++i) { const int key = 64 * t + 16 * kb + 4 * g + i; const bool ok = key < a.Tk && (MODE == 0 ? ((key >> 6) <= (pos >> 6)) : (key <= pos)); sa[blk][kb][i] = ok ? sa[blk][kb][i] : -INFINITY; } }
            }
#pragma unroll
            for (int blk = 0; blk < 2; ++blk) {
                float mx = -INFINITY;
#pragma unroll
                for (int kb = 0; kb < 4; ++kb)
#pragma unroll
                    for (int i = 0; i < 4; ++i) mx = fmaxf(mx, sa[blk][kb][i]);
                mx = fmaxf(mx, __shfl_xor(mx, 16)); mx = fmaxf(mx, __shfl_xor(mx, 32));
                const float mnew = (mx > mrow[blk] + 8.f) ? mx : mrow[blk]; float rsum = 0.f;
                if (__builtin_amdgcn_ballot_w64(mnew > mrow[blk]) != 0ull) {
                    const float alpha = __builtin_amdgcn_exp2f(mrow[blk] - mnew); mrow[blk] = mnew; lrow[blk] *= alpha;
#pragma unroll
                    for (int db = 0; db < NDB; ++db) o[blk][db] = o[blk][db] * alpha;
                }
#pragma unroll
                for (int kb = 0; kb < 4; ++kb)
#pragma unroll
                    for (int i = 0; i < 4; ++i) { const float p = __builtin_amdgcn_exp2f(sa[blk][kb][i] - mnew); sa[blk][kb][i] = p; rsum += p; }
                lrow[blk] += rsum;
#pragma unroll
                for (int kk = 0; kk < 2; ++kk) { const f32x4 p0 = sa[blk][2 * kk], p1 = sa[blk][2 * kk + 1]; u32x4 pw; pw.x = pk2(p0[0], p0[1]); pw.y = pk2(p0[2], p0[3]); pw.z = pk2(p1[0], p1[1]); pw.w = pk2(p1[2], p1[3]);
                    pf[blk][kk] = __builtin_bit_cast(bf16x8, pw); }
            }
#pragma unroll
            for (int kk = 0; kk < 2; ++kk)
#pragma unroll
                for (int db = 0; db < NDB; ++db) {
                    const unsigned ad = VOFF + (32 * kk + 4 * g + (li >> 2)) * VS + (16 * db + 4 * (li & 3)) * 2;
                    const s16x4 v0 = __builtin_amdgcn_ds_read_tr16_b64_v4i16((LAS s16x4*)(lds + ad)), v1 = __builtin_amdgcn_ds_read_tr16_b64_v4i16((LAS s16x4*)(lds + ad + 16 * VS));
                    bf16x8 vf; vf[0] = v0[0]; vf[1] = v0[1]; vf[2] = v0[2]; vf[3] = v0[3]; vf[4] = v1[0]; vf[5] = v1[1]; vf[6] = v1[2]; vf[7] = v1[3];
                    o[0][db] = __builtin_amdgcn_mfma_f32_16x16x32_bf16(vf, pf[0][kk], o[0][db], 0, 0, 0);
                    o[1][db] = __builtin_amdgcn_mfma_f32_16x16x32_bf16(vf, pf[1][kk], o[1][db], 0, 0, 0);  }
        }
      } }
    }
#undef ATT_PREFETCH
    if (active) {
#pragma unroll
        for (int blk = 0; blk < 2; ++blk) { const int rl = 32 * w + 16 * blk + li; const float inv = 1.f / fq_sum(lrow[blk]);
            if (rl < a.nq) { const size_t row = (size_t)(a.q0 + rl);
#pragma unroll
                for (int db = 0; db < NDB; ++db) { f32x4 v = o[blk][db] * inv;
                    if (MODE == 1) { const u32x2 gw = *(const u32x2*)(a.G + row * a.gs + 16 * db + 4 * g); v[0] *= bflo(gw.x); v[1] *= bfhi(gw.x); v[2] *= bflo(gw.y); v[3] *= bfhi(gw.y); }
                    *(u32x2*)(a.O + row * a.os + 16 * db + 4 * g) = pk4(v); } } }
    }
}

constexpr int R_QS = 528, R_VS = 272, R_AS = 144, R_SS = 528;
constexpr int R_QOFF = 0, R_KOFF = 64 * R_QS, R_VOFF = 2 * 64 * R_QS, R_AOFF = R_VOFF + 64 * R_VS, R_SOFF = R_AOFF + 64 * R_AS, R_END = R_SOFF + 8 * 16 * R_SS;
static_assert(R_END <= LDS_BYTES, "retention LDS");
__device__ __forceinline__ void ret_unit(LAS unsigned char* lds, const bf16_t* proj, bf16_t* obuf, int row0, int L, int nchunks, int h, int sl, const float* s0, float* sout) {
    int tid_o = threadIdx.x; asm volatile("" : "+v"(tid_o)); const int tid = tid_o, w = __builtin_amdgcn_readfirstlane(tid >> 6), lane = tid & 63, li = lane & 15, g = lane >> 4;
    const int NLB = L >> 4, KM = L >> 5;
    const float lg2 = log2f(1.f - exp2f(-5.f - (float)h));
    const float cdec = exp2f(lg2 * (float)L);
    LAS unsigned char* sst = lds + R_SOFF + w * (16 * R_SS);
    f32x4 S[16];
#pragma unroll
    for (int blk = 0; blk < 16; ++blk) {
        if (s0) {
#pragma unroll
            for (int i = 0; i < 4; ++i) S[blk][i] = s0[(size_t)(16 * blk + 4 * g + i) * 512 + sl * 128 + 16 * w + li];
        } else S[blk] = (f32x4){0.f, 0.f, 0.f, 0.f};
        *(LAS u32x2*)(sst + li * R_SS + (16 * blk + 4 * g) * 2) = pk4(S[blk]);
    }
    const bf16_t* qb = proj + (size_t)row0 * 6144 + h * 256, *kb = qb + 1024, *vb = proj + (size_t)row0 * 6144 + 2048 + h * 512 + sl * 128;
    u32x4 qr[4], kr[4], vr[2];
#define RET_PREFETCH(c) do { const size_t rb = (size_t)(c) * L; \
        _Pragma("unroll") for (int i_ = 0; i_ < 4; ++i_) { const int id = tid + 512 * i_, r_ = id >> 5, ch = id & 31; const int rr = r_ < L ? r_ : L - 1; \
            qr[i_] = *(const u32x4*)(qb + (rb + rr) * 6144 + ch * 8); kr[i_] = *(const u32x4*)(kb + (rb + rr) * 6144 + ch * 8); } \
        _Pragma("unroll") for (int i_ = 0; i_ < 2; ++i_) { const int id = tid + 512 * i_, r_ = id >> 4, ch = id & 15; const int rr = r_ < L ? r_ : L - 1; \
            vr[i_] = *(const u32x4*)(vb + (rb + rr) * 6144 + ch * 8); } } while (0)
    RET_PREFETCH(0);
    for (int c = 0; c < nchunks; ++c) {
        lds_barrier();
#pragma unroll
        for (int i_ = 0; i_ < 4; ++i_) { const int id = tid + 512 * i_, r_ = id >> 5, ch = id & 31; *(LAS u32x4*)(lds + R_QOFF + r_ * R_QS + ch * 16) = qr[i_]; *(LAS u32x4*)(lds + R_KOFF + r_ * R_QS + ch * 16) = kr[i_]; }
#pragma unroll
        for (int i_ = 0; i_ < 2; ++i_) { const int id = tid + 512 * i_, r_ = id >> 4, ch = id & 15; *(LAS u32x4*)(lds + R_VOFF + r_ * R_VS + ch * 16) = vr[i_]; }
        lds_barrier();
        if (c + 1 < nchunks) RET_PREFETCH(c + 1);
        { const int lb = w >> 1;
#pragma unroll
            for (int mbi = 0; mbi < 2; ++mbi) { const int mb = 2 * (w & 1) + mbi;
                if (lb < NLB && mb < NLB) { f32x4 av = (f32x4){0.f, 0.f, 0.f, 0.f};
                    if (mb <= lb) {
#pragma unroll
                        for (int s = 0; s < 8; ++s) { const bf16x8 af = *(const LAS bf16x8*)(lds + R_QOFF + (16 * lb + li) * R_QS + (32 * s + 8 * g) * 2), bf = *(const LAS bf16x8*)(lds + R_KOFF + (16 * mb + li) * R_QS + (32 * s + 8 * g) * 2);
                            av = __builtin_amdgcn_mfma_f32_16x16x32_bf16(af, bf, av, 0, 0, 0); }
                    }
#pragma unroll
                    for (int i = 0; i < 4; ++i) { const int l = 16 * lb + 4 * g + i, mm = 16 * mb + li; const float dm = l >= mm ? __builtin_amdgcn_exp2f(lg2 * (float)(l - mm)) : 0.f;
                        *(LAS unsigned short*)(lds + R_AOFF + l * R_AS + mm * 2) = (unsigned short)f2bf(av[i] * dm); } } } }
        lds_barrier();
        __builtin_amdgcn_sched_barrier(0);
        bf16x8 vf[2];
#pragma unroll
        for (int kk = 0; kk < 2; ++kk) { if (kk < KM) { const unsigned ad = R_VOFF + (32 * kk + 4 * g + (li >> 2)) * R_VS + (16 * w + 4 * (li & 3)) * 2;
                const s16x4 v0 = __builtin_amdgcn_ds_read_tr16_b64_v4i16((LAS s16x4*)(lds + ad)), v1 = __builtin_amdgcn_ds_read_tr16_b64_v4i16((LAS s16x4*)(lds + ad + 16 * R_VS));
                vf[kk][0] = v0[0]; vf[kk][1] = v0[1]; vf[kk][2] = v0[2]; vf[kk][3] = v0[3]; vf[kk][4] = v1[0]; vf[kk][5] = v1[1]; vf[kk][6] = v1[2]; vf[kk][7] = v1[3]; }
            else vf[kk] = (bf16x8){0, 0, 0, 0, 0, 0, 0, 0}; }
        f32x4 a1[4], a2[4];
#pragma unroll
        for (int lb = 0; lb < 4; ++lb) { a1[lb] = (f32x4){0.f, 0.f, 0.f, 0.f}; a2[lb] = (f32x4){0.f, 0.f, 0.f, 0.f}; }
#pragma unroll
        for (int kk = 0; kk < 2; ++kk) if (kk < KM) {
#pragma unroll
            for (int lb = 0; lb < 4; ++lb) if (lb < NLB) { const LAS unsigned char* ap = lds + R_AOFF + (16 * lb + li) * R_AS + (32 * kk + 4 * g) * 2;
                const u32x2 t0 = *(const LAS u32x2*)ap, t1 = *(const LAS u32x2*)(ap + 32); u32x4 tw; tw.x = t0.x; tw.y = t0.y; tw.z = t1.x; tw.w = t1.y;
                a1[lb] = __builtin_amdgcn_mfma_f32_16x16x32_bf16(vf[kk], __builtin_bit_cast(bf16x8, tw), a1[lb], 0, 0, 0); } }
#pragma unroll
        for (int s = 0; s < 8; ++s) { const bf16x8 sfr = *(const LAS bf16x8*)(sst + li * R_SS + (32 * s + 8 * g) * 2);
#pragma unroll
            for (int lb = 0; lb < 4; ++lb) if (lb < NLB) { const bf16x8 qf = *(const LAS bf16x8*)(lds + R_QOFF + (16 * lb + li) * R_QS + (32 * s + 8 * g) * 2);
                a2[lb] = __builtin_amdgcn_mfma_f32_16x16x32_bf16(sfr, qf, a2[lb], 0, 0, 0); } }
#pragma unroll
        for (int lb = 0; lb < 4; ++lb) if (lb < NLB) { const int l = 16 * lb + li; const float qd = __builtin_amdgcn_exp2f(lg2 * (float)(l + 1));
            *(u32x2*)(obuf + ((size_t)row0 + (size_t)c * L + l) * 2048 + h * 512 + sl * 128 + 16 * w + 4 * g) = pk4(a1[lb] + a2[lb] * qd); }
        __builtin_amdgcn_sched_barrier(0);
        bf16x8 vd[2];
#pragma unroll
        for (int kk = 0; kk < 2; ++kk) {
#pragma unroll
            for (int j = 0; j < 8; ++j) { const int mm = 32 * kk + (j < 4 ? 4 * g + j : 16 + 4 * g + (j - 4)); const float kd = __builtin_amdgcn_exp2f(lg2 * (float)(L - 1 - mm));
                vd[kk][j] = (short)f2bf(bf2f((unsigned short)vf[kk][j]) * kd); } }
#pragma unroll
        for (int blk = 0; blk < 16; ++blk) { f32x4 sv = S[blk] * cdec;
#pragma unroll
            for (int kk = 0; kk < 2; ++kk) if (kk < KM) { const unsigned ad = R_KOFF + (32 * kk + 4 * g + (li >> 2)) * R_QS + (16 * blk + 4 * (li & 3)) * 2;
                const s16x4 k0 = __builtin_amdgcn_ds_read_tr16_b64_v4i16((LAS s16x4*)(lds + ad)), k1 = __builtin_amdgcn_ds_read_tr16_b64_v4i16((LAS s16x4*)(lds + ad + 16 * R_QS));
                bf16x8 kf; kf[0] = k0[0]; kf[1] = k0[1]; kf[2] = k0[2]; kf[3] = k0[3]; kf[4] = k1[0]; kf[5] = k1[1]; kf[6] = k1[2]; kf[7] = k1[3];
                sv = __builtin_amdgcn_mfma_f32_16x16x32_bf16(kf, vd[kk], sv, 0, 0, 0); }
            S[blk] = sv;
            *(LAS u32x2*)(sst + li * R_SS + (16 * blk + 4 * g) * 2) = pk4(sv);
            if ((blk & 3) == 3) __builtin_amdgcn_sched_barrier(0); }
    }
#undef RET_PREFETCH
#pragma unroll
    for (int blk = 0; blk < 16; ++blk)
#pragma unroll
        for (int i = 0; i < 4; ++i) sout[(size_t)(16 * blk + 4 * g + i) * 512 + sl * 128 + 16 * w + li] = S[blk][i];
}
__device__ __forceinline__ void phase_ret_ln(int j) {
    int tid_o = threadIdx.x; asm volatile("" : "+v"(tid_o)); const int tid = tid_o, lane = tid & 63, wave = tid >> 6, gw = blockIdx.x * 8 + wave, NGW = gridDim.x * 8;
    bf16_t* obuf = (bf16_t*)(PWS + PL_ROBUF); const bf16_t* proj = (const bf16_t*)(PWS + PL_RPROJ); const float* gn = PIN(15) + (size_t)j * 2048;
    for (int it0 = gw; it0 < MT * 4; it0 += 2 * NGW) {
        u32x4 ow[2], gwd[2]; f32x4 g0[2], g1[2]; bf16_t* op[2]; bool ok[2];
#pragma unroll
        for (int q = 0; q < 2; ++q) { int it = it0 + q * NGW; ok[q] = it < MT * 4; it = ok[q] ? it : it0; const int r = it >> 2, h = it & 3; op[q] = obuf + (size_t)r * 2048 + h * 512 + lane * 8;
            ow[q] = *(const u32x4*)op[q]; gwd[q] = *(const u32x4*)(proj + (size_t)r * 6144 + 4096 + h * 512 + lane * 8);
            g0[q] = *(const f32x4*)(gn + h * 512 + lane * 8); g1[q] = *(const f32x4*)(gn + h * 512 + lane * 8 + 4); }
#pragma unroll
        for (int q = 0; q < 2; ++q) {
            float x[8] = {bflo(ow[q].x), bfhi(ow[q].x), bflo(ow[q].y), bfhi(ow[q].y), bflo(ow[q].z), bfhi(ow[q].z), bflo(ow[q].w), bfhi(ow[q].w)};
            const float sg[8] = {bflo(gwd[q].x), bfhi(gwd[q].x), bflo(gwd[q].y), bfhi(gwd[q].y), bflo(gwd[q].z), bfhi(gwd[q].z), bflo(gwd[q].w), bfhi(gwd[q].w)};
            float sm = 0.f;
#pragma unroll
            for (int e = 0; e < 8; ++e) sm += x[e];
            const float mu = wave_sum(sm) * (1.f / 512.f); float qv = 0.f;
#pragma unroll
            for (int e = 0; e < 8; ++e) { x[e] -= mu; qv += x[e] * x[e]; }
            const float rstd = rsqrtf(wave_sum(qv) * (1.f / 512.f) + EPS);
            u32x4 o; o.x = pk2(x[0] * rstd * g0[q][0] * sg[0], x[1] * rstd * g0[q][1] * sg[1]); o.y = pk2(x[2] * rstd * g0[q][2] * sg[2], x[3] * rstd * g0[q][3] * sg[3]);
            o.z = pk2(x[4] * rstd * g1[q][0] * sg[4], x[5] * rstd * g1[q][1] * sg[5]); o.w = pk2(x[6] * rstd * g1[q][2] * sg[6], x[7] * rstd * g1[q][3] * sg[7]);
            if (ok[q]) *(u32x4*)op[q] = o; } }
}
__device__ __forceinline__ void phase_fox_scan() {
    int tid_o = threadIdx.x; asm volatile("" : "+v"(tid_o)); const int tid = tid_o, lane = tid & 63, wave = tid >> 6, gw = blockIdx.x * 8 + wave, NGW = gridDim.x * 8;
    for (int it = gw; it < 512; it += NGW) { const int grp = it >> 8, bh = it & 255, b = bh >> 4, h = bh & 15; const int T = grp ? TKS : SEQ, per = grp ? 33 : 32;
        float* F = grp ? (float*)(PWS + WS_FS) + (size_t)bh * TKS : (float*)(PWS + WS_FP) + (size_t)bh * SEQ;
        const float* srcA = grp ? PIN(7) + (size_t)b * SEQ * 16 + h : POUT + O_FLP + (size_t)b * SEQ * 16 + h;
        const float* srcB = POUT + O_FLS + (size_t)b * DEC * 16 + h;
        const int t0 = lane * per; float v[33]; float s = 0.f;
#pragma unroll
        for (int e = 0; e < 33; ++e) { const int t = t0 + e; v[e] = (e < per && t < T) ? (t < SEQ ? srcA[(size_t)t * 16] : srcB[(size_t)(t - SEQ) * 16]) : 0.f; }
#pragma unroll
        for (int e = 0; e < 33; ++e) s += v[e];
        float inc = s;
#pragma unroll
        for (int o = 1; o < 64; o <<= 1) { const float n = __shfl_up(inc, o); if (lane >= o) inc += n; }
        float run = inc - s;
#pragma unroll
        for (int e = 0; e < 33; ++e) { const int t = t0 + e; run += v[e]; if (e < per && t < T) F[t] = run * LOG2E; } }
}
__device__ __forceinline__ void phase_final() {
    int tid_o = threadIdx.x; asm volatile("" : "+v"(tid_o)); const int tid = tid_o, lane = tid & 63, wave = tid >> 6, gw = blockIdx.x * 8 + wave, NGW = gridDim.x * 8; const float* gf = PIN(13);
    const bf16_t* hb = (const bf16_t*)(PWS + WS_HBB);
    for (int r = gw; r < MT; r += NGW) { float* y = POUT + O_Y + (size_t)r * D; f32x4 v[4]; float s = 0.f;
#pragma unroll
        for (int j = 0; j < 4; ++j) { v[j] = up4(*(const u32x2*)(hb + (size_t)r * D + (lane + 64 * j) * 4)); s += dot4(v[j]); }
        const float rstd = rsqrtf(wave_sum(s) * (1.f / 1024.f) + EPS);
#pragma unroll
        for (int j = 0; j < 4; ++j) *(f32x4*)(y + (lane + 64 * j) * 4) = v[j] * rstd * *(const f32x4*)(gf + (lane + 64 * j) * 4); }
}

template <int EPI>
__device__ __forceinline__ void sample_gemm(LAS unsigned char* lds, const bf16_t* A, const bf16_t* Bt, int K, const bf16_t* hin, bf16_t* hout, float* ssqw, const float* ssqr, const bf16_t* pp, bf16_t* outp) {
    int tid_o = threadIdx.x; asm volatile("" : "+v"(tid_o)); const int tid = tid_o, w = __builtin_amdgcn_readfirstlane(tid >> 6), lane = tid & 63, li = lane & 15, g = lane >> 4;
    LAS float* xs = (LAS float*)(lds + XR_OFF);
    for (int mu = blockIdx.x; mu < 128; mu += gridDim.x) {
        const int rsb = mu >> 2, pn = mu & 3, row = MP + 16 * rsb + li, kw = K >> 3;
        f32x4 acc[16];
#pragma unroll
        for (int cb = 0; cb < 16; ++cb) acc[cb] = (f32x4){0.f, 0.f, 0.f, 0.f};
        const bf16_t* ap = A + (size_t)row * K + w * kw + 8 * g;
        const bf16_t* bp = Bt + (size_t)(pn * 256 + li) * K + w * kw + 8 * g;
        bf16x8 a0 = *(const bf16x8*)ap, b0[16], a1, b1[16];
#pragma unroll
        for (int cb = 0; cb < 16; ++cb) b0[cb] = *(const bf16x8*)(bp + (size_t)cb * 16 * K);
        for (int ks = 0; ks < kw; ks += 64) {
            const bool h1 = ks + 32 < kw, h2 = ks + 64 < kw;
            if (h1) { a1 = *(const bf16x8*)(ap + ks + 32);
#pragma unroll
                for (int cb = 0; cb < 16; ++cb) b1[cb] = *(const bf16x8*)(bp + (size_t)cb * 16 * K + ks + 32); }
#pragma unroll
            for (int cb = 0; cb < 16; ++cb) acc[cb] = __builtin_amdgcn_mfma_f32_16x16x32_bf16(b0[cb], a0, acc[cb], 0, 0, 0);
            if (h2) { a0 = *(const bf16x8*)(ap + ks + 64);
#pragma unroll
                for (int cb = 0; cb < 16; ++cb) b0[cb] = *(const bf16x8*)(bp + (size_t)cb * 16 * K + ks + 64); }
            if (h1) {
#pragma unroll
                for (int cb = 0; cb < 16; ++cb) acc[cb] = __builtin_amdgcn_mfma_f32_16x16x32_bf16(b1[cb], a1, acc[cb], 0, 0, 0); }
        }
        lds_barrier();
#pragma unroll
        for (int cb = 0; cb < 16; ++cb) *(LAS f32x4*)(lds + ((w * 16 + cb) * 64 + lane) * 16) = acc[cb];
        lds_barrier();
        f32x4 v[2];
#pragma unroll
        for (int e = 0; e < 2; ++e) { v[e] = (f32x4){0.f, 0.f, 0.f, 0.f};
#pragma unroll
            for (int ww = 0; ww < 8; ++ww) v[e] += *(const LAS f32x4*)(lds + ((ww * 16 + 2 * w + e) * 64 + lane) * 16); }
        const size_t off = (size_t)row * D + pn * 256 + 32 * w + 4 * g;
        if (EPI == 2) {
#pragma unroll
            for (int e = 0; e < 2; ++e) *(u32x2*)(outp + off + 16 * e) = pk4(v[e]);
        } else {
            float ss = 0.f; float rs = 1.f; if (EPI == 1) rs = row_rstd(ssqr, row, 1.f / 1024.f);
#pragma unroll
            for (int e = 0; e < 2; ++e) { f32x4 o = up4(*(const u32x2*)(hin + off + 16 * e));
                if (EPI == 0) o += v[e];
                else { const u32x2 pw = *(const u32x2*)(pp + off + 16 * e); const f32x4 a = v[e] * rs;
                    o[0] += sigmoidf_(a[0]) * bflo(pw.x); o[1] += sigmoidf_(a[1]) * bfhi(pw.x); o[2] += sigmoidf_(a[2]) * bflo(pw.y); o[3] += sigmoidf_(a[3]) * bfhi(pw.y); }
                const u32x2 ow = pk4(o); *(u32x2*)(hout + off + 16 * e) = ow; ss += dot4(up4(ow)); }
            ss = fq_sum(ss); if (g == 0) xs[li * 8 + w] = ss;
            lds_barrier();
            if (w == 0 && g == 0) { const f32x4 t0 = *(const LAS f32x4*)(xs + li * 8), t1 = *(const LAS f32x4*)(xs + li * 8 + 4); ssqw[(size_t)row * 4 + pn] = ((t0[0] + t0[1]) + (t0[2] + t0[3])) + ((t1[0] + t1[1]) + (t1[2] + t1[3])); }
        }
    }
    lds_barrier();
}

#define XB_TMO      128
#define XB_XCNT(j)  (256  + 64 * (j))
#define XB_XSUB(j)  (1280 + 64 * (j))
#define XB_XGEN(j)  (2304 + 64 * (j))
#define XB_TOP      3328
#define XB_TOPGEN   3392
#define XCD_BAR_WORDS 3456
#define XB_SPIN_CAP (1u << 18)

__device__ __forceinline__ unsigned xb_ld(unsigned* p)              { return __hip_atomic_load(p, __ATOMIC_RELAXED, __HIP_MEMORY_SCOPE_AGENT); }
__device__ __forceinline__ unsigned xb_add(unsigned* p, unsigned v) { return __hip_atomic_fetch_add(p, v, __ATOMIC_RELAXED, __HIP_MEMORY_SCOPE_AGENT); }
__device__ __forceinline__ unsigned xb_xcc_id() { return (unsigned)__builtin_amdgcn_s_getreg((3 << 11) | 20) & 0xFu; }
#define XB_SPIN(cond, bar) do { unsigned _sp = 0; while (cond) { __builtin_amdgcn_s_sleep(1); \
    if ((++_sp & 255u) == 0u) { if (xb_ld(&(bar)[XB_TMO])) break; if (_sp > XB_SPIN_CAP) { atomicAdd(&(bar)[XB_TMO], 1u); break; } } } } while (0)

struct XcdBarrier {
    unsigned* bar; unsigned x;
    volatile LAS unsigned* st;
};

__device__ __forceinline__ XcdBarrier xcd_barrier_post(unsigned* bar, volatile LAS unsigned* st) {
    XcdBarrier b; b.bar = bar; b.x = xb_xcc_id(); b.st = st;
    if (threadIdx.x == 0) (void)xb_add(&bar[XB_XCNT(b.x)], 1u);
    return b;
}
__device__ __forceinline__ void xcd_barrier_complete(unsigned* bar, unsigned x, unsigned& nloc, unsigned& nx) {
    const unsigned G = gridDim.x * gridDim.y * gridDim.z;
    unsigned sum, cnt, mine, sp = 0u;
    for (;;) {
        sum = 0u; cnt = 0u; mine = 0u;
#pragma unroll
        for (unsigned j = 0; j < 16; ++j) { const unsigned c = xb_ld(&bar[XB_XCNT(j)]); sum += c; cnt += (c > 0u) ? 1u : 0u; mine = (j == x) ? c : mine; }
        if (sum == G) break;
        __builtin_amdgcn_s_sleep(1);
        if ((++sp & 255u) == 0u) { if (xb_ld(&bar[XB_TMO])) break; if (sp > XB_SPIN_CAP) { atomicAdd(&bar[XB_TMO], 1u); break; } }
    }
    nloc = mine > 0u ? mine : 1u; nx = cnt > 0u ? cnt : 1u;
}

__device__ __forceinline__ void xcd_barrier(const XcdBarrier& b) {
    asm volatile("s_waitcnt vmcnt(0)" ::: "memory");
    __syncthreads();
    if (threadIdx.x == 0) {
        unsigned* bar = b.bar;
        __builtin_amdgcn_s_waitcnt(0);
        unsigned nloc = b.st[0], nx = b.st[1];
        if (nloc == 0u) { xcd_barrier_complete(bar, b.x, nloc, nx); b.st[0] = nloc; b.st[1] = nx; }
        const unsigned old = xb_add(&bar[XB_XSUB(b.x)], 1u);
        const unsigned gen = old / nloc;
        if (old + 1u == (gen + 1u) * nloc) {
            __builtin_amdgcn_fence(__ATOMIC_RELEASE, "agent");
            asm volatile("s_waitcnt vmcnt(0)" ::: "memory");
            const unsigned og = xb_add(&bar[XB_TOP], 1u);
            const unsigned tg = og / nx;
            if (og + 1u == (tg + 1u) * nx) xb_add(&bar[XB_TOPGEN], 1u);
            else XB_SPIN(xb_ld(&bar[XB_TOPGEN]) == tg, bar);
            __builtin_amdgcn_fence(__ATOMIC_ACQUIRE, "agent");
            xb_add(&bar[XB_XGEN(b.x)], 1u);
            asm volatile("s_waitcnt vmcnt(0)" ::: "memory");
        } else {
            XB_SPIN(xb_ld(&bar[XB_XGEN(b.x)]) == gen, bar);
            __builtin_amdgcn_fence(__ATOMIC_ACQUIRE, "agent");
            asm volatile("s_waitcnt vmcnt(0)" ::: "memory");
        }
    }
    __syncthreads();
}


typedef pg8::StaticOrder SO;
#define GEMM(EpiT, A_, Bt_, M_, N_, K_, E_) do { pg8::Gemm g_{(const bf16_t*)(A_), (const bf16_t*)(Bt_), (M_), (N_), (K_)}; SO S_; S_.init((M_), (N_), (int)gridDim.x, (int)blockIdx.x); \
        pg8::gemm_phase<EpiT, SO, true, true>(lds, g_, S_, (E_)); } while (0)

__global__ void __launch_bounds__(512, 2) trunk_fwd(Params P) {
    extern __shared__ __attribute__((aligned(16))) unsigned char lds_raw[];
    LAS unsigned char* lds = (LAS unsigned char*)lds_raw;
    cg::grid_group grid = cg::this_grid();
#define RUN true
#ifdef PROBE_SEL
    unsigned long long tacc = 0, tlast = __builtin_amdgcn_s_memrealtime(); int curcat = 0;
#define TSWITCH(c) do { const unsigned long long tn_ = __builtin_amdgcn_s_memrealtime(); if (curcat == PROBE_SEL) tacc += tn_ - tlast; tlast = tn_; curcat = (c); } while (0)
#define RUNT(c) ({ TSWITCH(c); RUN; })
#else
#define TSWITCH(c) do { } while (0)
#define RUNT(c) RUN
#endif
#ifndef ONLY
#define EN(k) true
#else
#define EN(k) ((k) == ONLY)
#endif
#define SEAM() do { TSWITCH(5); { XcdBarrier b_; b_.bar = (unsigned*)(PWS + WS_BAR); b_.x = xb_xcc_id(); b_.st = (volatile LAS unsigned*)(lds + LDS_BYTES - 64); xcd_barrier(b_); } TSWITCH(6); } while (0)
#define WB ((bf16_t*)(PWS + WS_W))
#define HBA ((bf16_t*)(PWS + WS_HBA))
#define HBB ((bf16_t*)(PWS + WS_HBB))
#define SSQ0 ((float*)(PWS + WS_SSQ))
#define SSQ1 ((float*)(PWS + WS_SSQ) + (size_t)MT * 4)
#define HRES (POUT + O_Y)
#define ROPE_ ((const float*)(PWS + WS_ROPE))
#define ROPEM_ ((const float*)(PWS + WS_ROPEM))
    LAS float* xr = (LAS float*)(lds + XR_OFF);
    volatile LAS unsigned* bst = (volatile LAS unsigned*)(lds + LDS_BYTES - 64);
    if (threadIdx.x < 2) bst[threadIdx.x] = 0u;
    __syncthreads();
#define SSQ_P(p) ((((layer) ^ (p)) & 1) ? SSQ1 : SSQ0)

    if (blockIdx.x == 0) { unsigned* bw = (unsigned*)(PWS + WS_BAR); for (int i = threadIdx.x; i < XCD_BAR_WORDS; i += 512) __hip_atomic_store(bw + i, 0u, __ATOMIC_RELAXED, __HIP_MEMORY_SCOPE_AGENT); }
    if (EN(1) && RUNT(4)) phase_prologue(lds);
    TSWITCH(5); grid.sync(); (void)xcd_barrier_post((unsigned*)(PWS + WS_BAR), bst); TSWITCH(6);

    for (int layer = 0; layer < 4; ++layer) {
        const int kind = layer % 3, j = layer / 3;
        if (kind == 0) {
            bf16_t* proj = (bf16_t*)(PWS + PL_RPROJ); bf16_t* obuf = (bf16_t*)(PWS + PL_ROBUF);
            if (EN(2) && RUNT(1)) { EpiRetIn E{SSQ_P(0), proj, ROPE_}; GEMM(EpiRetIn, HBB, WB + W_RI + j * SZ_RI, MT, 6144, 1024, E); }
            SEAM();
            if (EN(3) && RUNT(3)) {
                for (int u = blockIdx.x; u < 512; u += gridDim.x) { const int grp = u >> 8, c = u & 255, b = c >> 4, h = (c >> 2) & 3, sl = c & 3;
                    const size_t so = ((size_t)(j * 16 + b) * 4 + h) * 131072;
                    if (!grp) ret_unit(lds, proj, obuf, b * SEQ, 64, 32, h, sl, nullptr, POUT + O_RSP + so);
                    else ret_unit(lds, proj, obuf, MP + b * DEC, 32, 1, h, sl, PIN(2) + so, POUT + O_RSS + so);
                    lds_barrier(); }
            }
            SEAM();
            if (EN(4) && RUNT(3)) phase_ret_ln(j);
            SEAM();
            if (EN(5) && RUNT(1)) { sample_gemm<0>(lds, obuf, WB + W_RO + j * SZ_RO, 2048, HBB, HBA, SSQ_P(1), nullptr, nullptr, nullptr); EpiRes E{HBB, HBA, SSQ_P(1), xr}; GEMM(EpiRes, obuf, WB + W_RO + j * SZ_RO, MP, 1024, 2048, E); }
            SEAM();
        } else if (kind == 1) {
            bf16_t* cqb = (bf16_t*)(PWS + PL_CQB); float* cqss = (float*)(PWS + WS_CQSS); bf16_t* latb = (bf16_t*)(PWS + PL_LATB); bf16_t* krb = (bf16_t*)(PWS + PL_KRB);
            bf16_t* mq = (bf16_t*)(POUT + O_FKP); bf16_t* kvh = (bf16_t*)(PWS + PL_KVH); bf16_t* mo = (bf16_t*)(PWS + PL_MO);
            if (EN(6) && RUNT(1)) {
                cvt_cache<256>(PIN(3), latb + (size_t)MP * 256); cvt_cache<64>(PIN(4), krb + (size_t)MP * 64);
                EpiMlaIn E{SSQ_P(0), PWS, POUT, PIN(19), PIN(25), xr}; GEMM(EpiMlaIn, HBB, WB + W_MI, MT, 1024, 1024, E); }
            SEAM();
            for (int hh = 0; hh < 2; ++hh) {
                if (EN(7) && RUNT(1)) {
                    if (hh == 0) { EpiPlain E{mq, 3072, cqss, 1.f / 512.f}; GEMM(EpiPlain, cqb, WB + W_QB, MT, 3072, 512, E); }
                    EpiKV E2{kvh, xr}; GEMM(EpiKV, latb, WB + W_KVB + (size_t)hh * 2048 * 256, KVR, 2048, 256, E2); }
                SEAM();
                if (EN(8) && RUNT(2)) {
                    const MlaQ q4{PIN(22), PIN(24), PIN(23), ROPEM_};
                    for (int u = blockIdx.x; u < 6 * 256; u += gridDim.x) { const int i = u >> 8, c = u & 255;
                        const int qb = c < 128 ? (i == 0 ? -1 : (i == 1 ? 7 : (i == 2 ? 5 : -2))) : (i == 0 ? 6 : (i == 1 ? 4 : 5 - i));
                        if (qb > -2) { const int bh = c & 127, b = bh >> 3, hl = bh & 7, hd = hh * 8 + hl; const bool pr = qb >= 0;
                            const size_t rq = pr ? (size_t)b * SEQ : (size_t)MP + (size_t)b * DEC, rk = pr ? (size_t)b * SEQ : (size_t)MP + (size_t)b * TKS; AU a;
                            a.Q = mq + rq * 3072 + hd * 192; a.qs = 3072; a.K1 = kvh + rk * 2048 + hl * 256; a.k1s = 2048; a.K2 = krb + rk * 64; a.k2s = 64; a.V = kvh + rk * 2048 + hl * 256 + 128; a.vs = 2048;
                            a.O = mo + rq * 2048 + hd * 128; a.os = 2048; a.G = nullptr; a.gs = 0; a.Fk = nullptr; a.q0 = pr ? qb * 256 : 0; a.nq = pr ? 256 : DEC; a.off = pr ? 0 : SEQ; a.Tk = pr ? SEQ : TKS;
                            attn_unit<192, 128, 0>(lds, a, q4); } }

                    lds_barrier();
                }
                SEAM();
            }
            if (EN(9) && RUNT(1)) { sample_gemm<0>(lds, mo, WB + W_MO, 2048, HBB, HBA, SSQ_P(1), nullptr, nullptr, nullptr); EpiRes E{HBB, HBA, SSQ_P(1), xr}; GEMM(EpiRes, mo, WB + W_MO, MP, 1024, 2048, E); }
            SEAM();
        } else {
            bf16_t* proj = (bf16_t*)(PWS + PL_FPROJ); bf16_t* kall = (bf16_t*)(PWS + PL_FKALL); bf16_t* vall = (bf16_t*)(PWS + PL_FVALL); bf16_t* fo = (bf16_t*)(PWS + PL_FO);
            if (EN(10) && RUNT(1)) {
                cvt_cache<1024>(PIN(5), kall); cvt_cache<1024>(PIN(6), vall);
                EpiFoxIn E{SSQ_P(0), PWS, POUT, PIN(29), PIN(30), PIN(28), xr}; GEMM(EpiFoxIn, HBB, WB + W_FI, MT, 4352, 1024, E); }
            SEAM();
            if (EN(11) && RUNT(6)) phase_fox_scan();
            SEAM();
            if (EN(12) && RUNT(2)) {
                const MlaQ q4{nullptr, nullptr, nullptr, nullptr};
                for (int u = blockIdx.x; u < 2048 + 256; u += gridDim.x) { AU a; a.K2 = nullptr; a.k2s = 0;
                    if (u < 2048) { const int qb = u >> 8, bh = u & 255, b = bh >> 4, hd = bh & 15; const size_t r0 = (size_t)b * SEQ;
                        a.Q = proj + r0 * 4096 + hd * 64; a.qs = 4096; a.K1 = proj + r0 * 4096 + 1024 + hd * 64; a.k1s = 4096; a.V = proj + r0 * 4096 + 2048 + hd * 64; a.vs = 4096;
                        a.O = fo + r0 * 1024 + hd * 64; a.os = 1024; a.G = proj + r0 * 4096 + 3072 + hd * 64; a.gs = 4096; a.Fk = (const float*)(PWS + WS_FP) + (size_t)bh * SEQ; a.q0 = qb * 256; a.nq = 256; a.off = 0; a.Tk = SEQ; }
                    else { const int bh = u - 2048, b = bh >> 4, hd = bh & 15; const size_t rq = (size_t)MP + (size_t)b * DEC, rk = (size_t)b * TKS;
                        a.Q = proj + rq * 4096 + hd * 64; a.qs = 4096; a.K1 = kall + rk * 1024 + hd * 64; a.k1s = 1024; a.V = vall + rk * 1024 + hd * 64; a.vs = 1024;
                        a.O = fo + rq * 1024 + hd * 64; a.os = 1024; a.G = proj + rq * 4096 + 3072 + hd * 64; a.gs = 4096; a.Fk = (const float*)(PWS + WS_FS) + (size_t)bh * TKS; a.q0 = 0; a.nq = DEC; a.off = SEQ; a.Tk = TKS; }
                    attn_unit<64, 64, 1>(lds, a, q4); }
                lds_barrier();
            }
            SEAM();
            if (EN(13) && RUNT(1)) { sample_gemm<0>(lds, fo, WB + W_FO, 1024, HBB, HBA, SSQ_P(1), nullptr, nullptr, nullptr); EpiRes E{HBB, HBA, SSQ_P(1), xr}; GEMM(EpiRes, fo, WB + W_FO, MP, 1024, 1024, E); }
            SEAM();
        }
        bf16_t* act = (bf16_t*)(PWS + PL_ACT); bf16_t* pb = (bf16_t*)(PWS + PL_PB); bf16_t* pp = (bf16_t*)(PWS + PL_PP);
        if (EN(14) && RUNT(1)) {
            cvt_chunks(PIN(8) + (size_t)layer * MP * 256, pb, (size_t)MP * 32); cvt_chunks(PIN(9) + (size_t)layer * MS * 256, pb + (size_t)MP * 256, (size_t)MS * 32);
            EpiGU E{SSQ_P(1), act}; GEMM(EpiGU, HBA, WB + W_GU + layer * SZ_GU, MT, 5632, 1024, E); }
        SEAM();
        if (EN(15) && RUNT(1)) {
            sample_gemm<0>(lds, act, WB + W_DN + layer * SZ_DN, DFF, HBA, HBA, SSQ_P(0), nullptr, nullptr, nullptr);
            sample_gemm<2>(lds, pb, WB + W_PP + layer * SZ_PP, 256, nullptr, nullptr, nullptr, nullptr, nullptr, pp);
            { EpiRes E{HBA, HBA, SSQ_P(0), xr}; GEMM(EpiRes, act, WB + W_DN + layer * SZ_DN, MP, 1024, DFF, E); }
            { EpiPlain E{pp, 1024, nullptr, 0.f}; GEMM(EpiPlain, pb, WB + W_PP + layer * SZ_PP, MP, 1024, 256, E); } }
        SEAM();
        if (EN(16) && RUNT(1)) { sample_gemm<1>(lds, HBA, WB + W_PG + layer * SZ_PG, 1024, HBA, HBB, SSQ_P(1), SSQ_P(0), pp, nullptr); EpiPE E{HBA, pp, HBB, SSQ_P(0), SSQ_P(1), xr}; GEMM(EpiPE, HBA, WB + W_PG + layer * SZ_PG, MP, 1024, 1024, E); }
        SEAM();
    }
    if (EN(17) && RUNT(6)) phase_final();
#ifdef PROBE_SEL
    TSWITCH(0);
    if (blockIdx.x == 0 && threadIdx.x == 0) { asm volatile("s_waitcnt vmcnt(0)" ::: "memory"); POUT[0] += (float)tacc * 1e-5f; }
#endif
}

extern "C" void kernel_launch(void* const* d_in, const int* in_sizes, int n_in, void* d_out, int out_size, void* d_ws, size_t ws_size, hipStream_t stream) {
    static int grid = 0;
    if (grid == 0) {
        if (n_in != 37 || (size_t)out_size != O_END || ws_size < WS_NEED) { fprintf(stderr, "kernel_launch: unexpected sizes n_in %d out %d ws %zu (need %zu)\n", n_in, out_size, ws_size, (size_t)WS_NEED); grid = -1; return; }
        int dev = 0, cus = 0, per_cu = 0;
        if (hipGetDevice(&dev) != hipSuccess || hipDeviceGetAttribute(&cus, hipDeviceAttributeMultiprocessorCount, dev) != hipSuccess) { grid = -1; return; }
        if (hipFuncSetAttribute((const void*)trunk_fwd, hipFuncAttributeMaxDynamicSharedMemorySize, LDS_BYTES) != hipSuccess) { fprintf(stderr, "kernel_launch: hipFuncSetAttribute failed\n"); grid = -1; return; }
        if (hipOccupancyMaxActiveBlocksPerMultiprocessor(&per_cu, (const void*)trunk_fwd, 512, LDS_BYTES) != hipSuccess || per_cu < 1) { fprintf(stderr, "kernel_launch: occupancy query says %d\n", per_cu); per_cu = 1; }
        (void)hipGetLastError();
        grid = cus * per_cu;
    }
    if (grid < 0) return;
    Params p{};
    for (int i = 0; i < 37; ++i) p.in[i] = (const float*)d_in[i];
    p.out = (float*)d_out; p.ws = (unsigned char*)d_ws; p.ph_lo = 0; p.ph_hi = 1000;
    void* args[] = {&p};
    hipError_t e = hipLaunchCooperativeKernel((const void*)trunk_fwd, dim3(grid), dim3(512), args, LDS_BYTES, stream);
    if (e != hipSuccess) fprintf(stderr, "cooperative launch failed: %s (grid %d)\n", hipGetErrorString(e), grid);
}
```
